# Optimizing an MI355X kernel written in HIP

```python
import math
import jax, jax.numpy as jnp
from jax import lax
import numpy as np

D_MODEL = 2048
BATCH = 2
SEQ = 4096
DEPTH = 2
DEC_BATCH = 4
DEC_SEQ = 2048
PAST_LEN = 128

A_HEADS = 8
A_HEAD_DIM = 128
A_WIDTH = A_HEADS * A_HEAD_DIM
A_CONV = 3
GDN_CHUNK = 64
B_WIDTH = 1024
B_CONV = 3
C_GROUPS = ((128, 1), (512, 4), (2048, 16))
C_HEADS_PER_GROUP = 4
C_HEADS = C_HEADS_PER_GROUP * 3
C_HEAD_DIM = 128
C_WIDTH = C_HEADS * C_HEAD_DIM
C_OUT = C_HEADS_PER_GROUP * C_HEAD_DIM
N_BUCKETS = 32
REL_MAX_DIST = 2048
N_BRANCHES = 3
D_FF = 4 * D_MODEL
EPS = 1e-6
NEG_INF = -1e30
SPLIT_SIZES = (3 * A_WIDTH, A_WIDTH, 2 * A_HEADS, 2 * A_HEADS, B_WIDTH, B_WIDTH, B_WIDTH, C_WIDTH, C_WIDTH, C_WIDTH, N_BRANCHES * D_MODEL)
IN_COLS = sum(SPLIT_SIZES)

kernel_name = 'hybrid_bidir_gdn_shortconv_dilated_encoder'


def rms_norm(x, w):
    x32 = x.astype(jnp.float32)
    y = x32 * lax.rsqrt(jnp.mean(x32 * x32, axis=-1, keepdims=True) + EPS)
    return (y * w.astype(jnp.float32)).astype(x.dtype)


def l2_normalize(x):
    return x * lax.rsqrt(jnp.sum(x * x, axis=-1, keepdims=True) + EPS)


def dwconv_centred(x, w):
    k = w.shape[0]
    r = k // 2
    s = x.shape[1]
    xp = jnp.pad(x, ((0, 0), (r, r), (0, 0)))
    y = xp[:, 0:s] * w[0]
    for j in range(1, k):
        y = y + xp[:, j:j + s] * w[j]
    return y


def gated_delta_rule_chunked(q, k, v, g, beta):
    b, h, s, dk = q.shape
    dv = v.shape[-1]
    c = GDN_CHUNK
    n = s // c
    q, k, v = (t.reshape(b, h, n, c, t.shape[-1]) for t in (q, k, v))
    gc = jnp.cumsum(g.reshape(b, h, n, c), axis=-1)
    beta = beta.reshape(b, h, n, c, 1)
    incl = jnp.tril(jnp.ones((c, c), dtype=bool))
    strict = jnp.tril(jnp.ones((c, c), dtype=bool), -1)
    decay = jnp.exp(jnp.where(incl, gc[..., :, None] - gc[..., None, :], -jnp.inf))
    kb = k * beta
    vb = v * beta
    lower = jnp.where(strict, jnp.einsum('bhncd,bhnsd->bhncs', kb, k) * decay, 0.0)
    t_mat = jnp.eye(c, dtype=q.dtype) + lower
    u = lax.linalg.triangular_solve(t_mat, vb, left_side=True, lower=True, unit_diagonal=True)
    w = lax.linalg.triangular_solve(t_mat, kb * jnp.exp(gc)[..., None], left_side=True, lower=True, unit_diagonal=True)
    intra = jnp.where(incl, jnp.einsum('bhncd,bhnsd->bhncs', q, k) * decay, 0.0)

    def step(state, xs):
        q_i, k_i, u_i, w_i, gc_i, a_i = xs
        v_new = u_i - jnp.einsum('bhcd,bhde->bhce', w_i, state)
        o_i = (jnp.einsum('bhcd,bhde->bhce', q_i * jnp.exp(gc_i)[..., None], state)
               + jnp.einsum('bhcs,bhse->bhce', a_i, v_new))
        g_last = gc_i[..., -1:]
        k_dec = k_i * jnp.exp(g_last - gc_i)[..., None]
        state = state * jnp.exp(g_last)[..., None] + jnp.einsum('bhcd,bhce->bhde', k_dec, v_new)
        return state, o_i

    xs = tuple(jnp.moveaxis(t, 2, 0) for t in (q, k, u, w, gc, intra))
    state0 = jnp.zeros((b, h, dk, dv), q.dtype)
    _, o = lax.scan(step, state0, xs)
    return jnp.moveaxis(o, 0, 2).reshape(b, h, s, dv)


def gdn_mixer(qkv, z, a, bt, a_log, dt_bias, head_norm):
    dtype = z.dtype
    bsz, s, _ = qkv.shape
    f32 = jnp.float32
    qkv = jax.nn.silu(qkv.astype(f32))
    q, k, v = (t.reshape(bsz, s, A_HEADS, A_HEAD_DIM).transpose(0, 2, 1, 3) for t in jnp.split(qkv, 3, axis=-1))
    q = l2_normalize(q) * (A_HEAD_DIM ** -0.5)
    k = l2_normalize(k)
    a = a.astype(f32).reshape(bsz, s, 2, A_HEADS)
    g = -jnp.exp(a_log.astype(f32)) * jax.nn.softplus(a + dt_bias.astype(f32))
    beta = jax.nn.sigmoid(bt.astype(f32).reshape(bsz, s, 2, A_HEADS))
    g = g.transpose(2, 0, 3, 1)
    beta = beta.transpose(2, 0, 3, 1)
    o_fwd = gated_delta_rule_chunked(q, k, v, g[0], beta[0])
    rev = lambda t: jnp.flip(t, axis=2)
    o_bwd = rev(gated_delta_rule_chunked(rev(q), rev(k), rev(v), rev(g[1]), rev(beta[1])))
    o = (o_fwd + o_bwd).transpose(0, 2, 1, 3)
    o = o * lax.rsqrt(jnp.mean(o * o, axis=-1, keepdims=True) + EPS) * head_norm.astype(f32)
    o = o * jax.nn.silu(z.astype(f32).reshape(bsz, s, A_HEADS, A_HEAD_DIM))
    return o.reshape(bsz, s, A_WIDTH).astype(dtype)


def t5_bucket(rel):
    half = N_BUCKETS // 2
    exact = half // 2
    ret = np.where(rel > 0, half, 0)
    n = np.abs(rel)
    large = exact + (np.log(np.maximum(n, 1) / exact) / math.log(REL_MAX_DIST / exact) * (half - exact)).astype(np.int32)
    large = np.minimum(large, half - 1)
    return (ret + np.where(n < exact, n, large)).astype(np.int32)


def banded_attention(q, k, v, bias_tab, radius, dil):
    n, l, h, dh = q.shape
    blk = radius
    nb = -(-l // blk)
    pad = nb * blk - l
    qb = jnp.pad(q, ((0, 0), (0, pad), (0, 0), (0, 0))).reshape(n, nb, blk, h, dh)

    def key_blocks(t):
        tp = jnp.pad(t, ((0, 0), (blk, pad + blk), (0, 0), (0, 0)))
        return jnp.concatenate([tp[:, j * blk:j * blk + nb * blk].reshape(n, nb, blk, h, dh) for j in range(3)], axis=2)

    kb = key_blocks(k)
    vb = key_blocks(v)
    rel0 = np.arange(3 * blk)[None, :] - blk - np.arange(blk)[:, None]
    bias = bias_tab[t5_bucket(rel0 * dil)].transpose(2, 0, 1)
    kpos = (np.arange(nb)[:, None, None] - 1) * blk + np.arange(3 * blk)[None, None, :]
    valid = (np.abs(rel0)[None] <= radius) & (kpos >= 0) & (kpos < l)
    sc = jnp.einsum('nbqhd,nbkhd->nbhqk', qb, kb) * (dh ** -0.5) + bias[None, None]
    sc = jnp.where(valid[None, :, None], sc, NEG_INF)
    m = jnp.max(sc, axis=-1, keepdims=True)
    p = jnp.exp(sc - m)
    den = jnp.sum(p, axis=-1, keepdims=True)
    o = jnp.einsum('nbhqk,nbkhd->nbqhd', p / den, vb).reshape(n, nb * blk, h, dh)[:, :l]
    lse = (m + jnp.log(den))[..., 0].transpose(0, 1, 3, 2).reshape(n, nb * blk, h)[:, :l]
    return o, lse


def dilated_mixer(q, k, v, rel_bias):
    dtype = q.dtype
    bsz, s, _ = q.shape
    shp = (bsz, s, C_HEADS, C_HEAD_DIM)
    q, k, v = (t.astype(jnp.float32).reshape(shp) for t in (q, k, v))
    outs, lses = [], []
    for gi, (window, dil) in enumerate(C_GROUPS):
        hs = slice(gi * C_HEADS_PER_GROUP, (gi + 1) * C_HEADS_PER_GROUP)
        l = s // dil

        def to_sub(t):
            return t[:, :, hs].reshape(bsz, l, dil, C_HEADS_PER_GROUP, C_HEAD_DIM).transpose(0, 2, 1, 3, 4).reshape(bsz * dil, l, C_HEADS_PER_GROUP, C_HEAD_DIM)

        o, lse = banded_attention(to_sub(q), to_sub(k), to_sub(v), rel_bias[:, hs].astype(jnp.float32), window // (2 * dil), dil)
        outs.append(o.reshape(bsz, dil, l, C_HEADS_PER_GROUP, C_HEAD_DIM).transpose(0, 2, 1, 3, 4).reshape(bsz, s, C_HEADS_PER_GROUP, C_HEAD_DIM))
        lses.append(lse.reshape(bsz, dil, l, C_HEADS_PER_GROUP).transpose(0, 2, 1, 3).reshape(bsz, s, C_HEADS_PER_GROUP))
    alpha = jax.nn.softmax(jnp.stack(lses), axis=0)
    o = jnp.einsum('gbsh,gbshd->bshd', alpha, jnp.stack(outs))
    return o.reshape(bsz, s, C_OUT).astype(dtype)


def trunk(x, rel_bias, norm_mix, w_in, conv_a, a_log, dt_bias, head_norm, conv_b,
          w_br_a, w_br_b, w_br_c, w_out, norm_mlp, w_up, w_down, norm_final):
    split_points = np.cumsum(SPLIT_SIZES)[:-1].tolist()
    h = x
    for layer in range(DEPTH):
        xn = rms_norm(h, norm_mix[layer])
        proj = xn @ w_in[layer]
        (a_qkv, a_z, a_alpha, a_beta, b_gb, b_gc, b_h, c_q, c_k, c_v, gates) = jnp.split(proj, split_points, axis=-1)
        y_a = gdn_mixer(dwconv_centred(a_qkv, conv_a[layer]), a_z, a_alpha, a_beta,
                        a_log[layer], dt_bias[layer], head_norm[layer])
        y_b = b_gb * dwconv_centred(b_gc * b_h, conv_b[layer])
        y_c = dilated_mixer(c_q, c_k, c_v, rel_bias)
        g_a, g_b, g_c = jnp.split(jax.nn.sigmoid(gates), N_BRANCHES, axis=-1)
        merged = g_a * (y_a @ w_br_a[layer]) + g_b * (y_b @ w_br_b[layer]) + g_c * (y_c @ w_br_c[layer])
        h = h + merged @ w_out[layer]
        xn = rms_norm(h, norm_mlp[layer])
        h = h + jnp.square(jax.nn.relu(xn @ w_up[layer])) @ w_down[layer]
    return rms_norm(h, norm_final)


def setup_inputs(seed: int = 0) -> dict:
    key = jax.random.key(seed)
    ks = jax.random.split(key, 20)
    f32 = jnp.float32

    def normal(k, shape, scale):
        return jax.random.normal(k, shape, f32) * scale

    def gain(k, shape):
        return 1.0 + 0.02 * jax.random.normal(k, shape, f32)

    dt = jnp.exp(jax.random.uniform(ks[6], (DEPTH, 2, A_HEADS), f32, math.log(1e-3), math.log(1e-1)))
    return {
        'x_prompt': jax.random.normal(ks[0], (BATCH, SEQ, D_MODEL), f32),
        'x_sample': jax.random.normal(ks[1], (DEC_BATCH, DEC_SEQ, D_MODEL), f32),
        'rel_bias': normal(ks[2], (N_BUCKETS, C_HEADS), 0.2),
        'norm_mix': gain(ks[3], (DEPTH, D_MODEL)),
        'w_in': normal(ks[4], (DEPTH, D_MODEL, IN_COLS), D_MODEL ** -0.5),
        'conv_a': normal(ks[5], (DEPTH, A_CONV, 3 * A_WIDTH), A_CONV ** -0.5),
        'a_log': jnp.log(jax.random.uniform(ks[7], (DEPTH, 2, A_HEADS), f32, 1.0, 16.0)),
        'dt_bias': dt + jnp.log(-jnp.expm1(-dt)),
        'head_norm': gain(ks[8], (DEPTH, A_HEAD_DIM)),
        'conv_b': normal(ks[9], (DEPTH, B_CONV, B_WIDTH), B_CONV ** -0.5),
        'w_br_a': normal(ks[10], (DEPTH, A_WIDTH, D_MODEL), A_WIDTH ** -0.5),
        'w_br_b': normal(ks[11], (DEPTH, B_WIDTH, D_MODEL), B_WIDTH ** -0.5),
        'w_br_c': normal(ks[12], (DEPTH, C_OUT, D_MODEL), C_OUT ** -0.5),
        'w_out': normal(ks[13], (DEPTH, D_MODEL, D_MODEL), D_MODEL ** -0.5),
        'norm_mlp': gain(ks[14], (DEPTH, D_MODEL)),
        'w_up': normal(ks[15], (DEPTH, D_MODEL, D_FF), D_MODEL ** -0.5),
        'w_down': normal(ks[16], (DEPTH, D_FF, D_MODEL), D_FF ** -0.5),
        'norm_final': gain(ks[17], (D_MODEL,)),
    }


def reference(x_prompt, x_sample, rel_bias, norm_mix, w_in, conv_a, a_log, dt_bias, head_norm, conv_b,
              w_br_a, w_br_b, w_br_c, w_out, norm_mlp, w_up, w_down, norm_final):
    y_prompt = trunk(x_prompt, rel_bias, norm_mix, w_in, conv_a, a_log, dt_bias, head_norm, conv_b,
                     w_br_a, w_br_b, w_br_c, w_out, norm_mlp, w_up, w_down, norm_final)
    y_sample = trunk(x_sample, rel_bias, norm_mix, w_in, conv_a, a_log, dt_bias, head_norm, conv_b,
                     w_br_a, w_br_b, w_br_c, w_out, norm_mlp, w_up, w_down, norm_final)
    return (y_prompt, y_sample)
```

```cpp
#include <cstdio>
#define MEGA 1
#include <hip/hip_runtime.h>
namespace pg8 {
#define PG8_LAS __attribute__((address_space(3)))
typedef unsigned short bf16_t;
typedef short bf16x8 __attribute__((ext_vector_type(8)));
typedef float f32x4 __attribute__((ext_vector_type(4)));
typedef unsigned u32x4 __attribute__((ext_vector_type(4)));
constexpr int BM = 256, BK = 64, HALF = 128, HTB = HALF * BK * 2  , STAGE_BYTES = 8 * HTB, NXCD = 8, WGM = 8;

__host__ __device__ __forceinline__ int lds_byte(int r, int c) { const int st = (r >> 4) * 2 + (c >> 5), rr = r & 15, cc = c & 31, ob = rr * 64 + cc * 2; return st * 1024 + (ob ^ (((ob >> 9) & 1) << 5)); }
__host__ __device__ __forceinline__ void stage_rc(int b, int& R, int& C) { const int st = b / 1024, sb = b % 1024, swz = sb ^ (((sb >> 9) & 1) << 5); R = (st >> 1) * 16 + swz / 64; C = (st & 1) * 32 + (swz % 64) / 2; }
__host__ __device__ __forceinline__ int perm32(int rho) { const int n = rho >> 4, i = rho & 15; return 8 * (i >> 2) + 4 * n + (i & 3); }

struct Unit { int pm, pn; };
struct Gemm { const bf16_t* A; const bf16_t* Bt; int M, N, K; };
struct StaticOrder {
    int nM, nN, nwg, G, c;
    __host__ __device__ void init(int M, int N, int G_, int c_) { nM = M / BM; nN = N / BM; nwg = nM * nN; G = G_; c = c_; }
    __host__ __device__ bool next(int i, Unit& u) const {
        const long L = (long)i * G + c; if (L >= nwg) return false;
        int wgid = (int)L; { const int q = nwg / NXCD, r = nwg % NXCD, xcd = wgid % NXCD, off = wgid / NXCD; wgid = (xcd < r ? xcd * (q + 1) : r * (q + 1) + (xcd - r) * q) + off; }
        const int nig = WGM * nN, gid = wgid / nig, fm = gid * WGM, gsz = (nM - fm) < WGM ? (nM - fm) : WGM;
        u.pm = fm + ((wgid % nig) % gsz); u.pn = (wgid % nig) / gsz; return true;
    }
    __device__ __forceinline__ void a_ready(const Unit&) const {}
    __device__ __forceinline__ void done(const Unit&) const {}
};
__device__ __forceinline__ unsigned cvt_pk_bf16(float lo, float hi) { unsigned r; asm volatile("v_cvt_pk_bf16_f32 %0, %1, %2" : "=v"(r) : "v"(lo), "v"(hi)); return r; }

template <class Epi, class Sched, bool STAMP = false>
__device__ __forceinline__ void gemm_phase(PG8_LAS unsigned char* lds, const Gemm g, const Sched& S, const Epi& E, unsigned long long* stamps) {
    int tid_ = threadIdx.x; asm volatile("" : "+v"(tid_)); const int tid = tid_, wid = __builtin_amdgcn_readfirstlane(tid >> 6), lane = tid & 63, wr = wid >> 2, wc = wid & 3, fr = lane & 15, fq = lane >> 4;
    const int K = g.K, nt = K / BK;
    int ts_lo = 0, ts_hi = 0, nts = 0; const unsigned long long rt_entry = STAMP ? (unsigned long long)wall_clock64() : 0ull;
#define PG8_STAMP() do { if (STAMP && wid == 0 && nts < 64) { const unsigned long long _c = (unsigned long long)clock64(); \
        ts_lo = (lane == nts) ? (int)(unsigned)_c : ts_lo; ts_hi = (lane == nts) ? (int)(unsigned)(_c >> 32) : ts_hi; ++nts; } } while (0)
    PG8_STAMP();
    unsigned voffA[2], voffB[2];
#pragma unroll
    for (int i = 0; i < 2; ++i) { int R, C; stage_rc(tid * 16 + i * 8192, R, C); const int Rb = Epi::PERM ? ((R & ~31) + perm32(R & 31)) : R;
        voffA[i] = (unsigned)(R * K + C) * 2u; voffB[i] = (unsigned)(Rb * K + C) * 2u; }
    const size_t kstep = (size_t)(BK * 2);
    const size_t hstep = (size_t)HALF * K * 2;
    const size_t tstep = 2 * hstep;
    const unsigned ldsw = (unsigned)wid * 1024u;
    const int aoff = lds_byte(wr * 64 + fr, fq * 8), boff = lds_byte(wc * 32 + fr, fq * 8);
#define PG8_SA(b, h) (((b) * 2 + (h)) * HTB)
#define PG8_SB(b, h) ((4 + (b) * 2 + (h)) * HTB)
#define PG8_STAGE(bufoff, gbase, voff) do { _Pragma("unroll") for (int _i = 0; _i < 2; ++_i) \
        __builtin_amdgcn_global_load_lds((const unsigned*)((const char*)(gbase) + (voff)[_i]), (PG8_LAS unsigned*)(lds + (bufoff) + ldsw + _i * 8192), 16, 0, 0); } while (0)
#define PG8_LDA(dst, b, h) do { _Pragma("unroll") for (int m = 0; m < 4; ++m) _Pragma("unroll") for (int k = 0; k < 2; ++k) dst[m][k] = *(const PG8_LAS bf16x8*)(lds + PG8_SA(b, h) + aoff + m * 2048 + k * 1024); } while (0)
#define PG8_LDB(dst, b, h) do { _Pragma("unroll") for (int n = 0; n < 2; ++n) _Pragma("unroll") for (int k = 0; k < 2; ++k) dst[n][k] = *(const PG8_LAS bf16x8*)(lds + PG8_SB(b, h) + boff + n * 2048 + k * 1024); } while (0)
#define PG8_MMA(ai, bj, At, Bt) do { __builtin_amdgcn_s_setprio(1); _Pragma("unroll") for (int m = 0; m < 4; ++m) _Pragma("unroll") for (int n = 0; n < 2; ++n) _Pragma("unroll") for (int k = 0; k < 2; ++k) \
        acc[ai][bj][m][n] = __builtin_amdgcn_mfma_f32_16x16x32_bf16(Bt[n][k], At[m][k], acc[ai][bj][m][n], 0, 0, 0); __builtin_amdgcn_s_setprio(0); } while (0)
#define PG8_WAIT_V(n) asm volatile("s_waitcnt vmcnt(" #n ")" ::: "memory")
#define PG8_WAIT_L(n) asm volatile("s_waitcnt lgkmcnt(" #n ")" ::: "memory")
#define PG8_BAR __builtin_amdgcn_s_barrier()
#define PG8_SCHED __builtin_amdgcn_sched_barrier(0)
    Unit cur, nxt; int ui = 0;
    if (!S.next(0, cur)) return;
    f32x4 acc[2][2][4][2];
#pragma unroll
    for (int a = 0; a < 2; ++a)
#pragma unroll
        for (int b = 0; b < 2; ++b)
#pragma unroll
            for (int m = 0; m < 4; ++m)
#pragma unroll
                for (int n = 0; n < 2; ++n) acc[a][b][m][n] = (f32x4){0.f, 0.f, 0.f, 0.f};
    bf16x8 At[4][2], B0[2][2], B1[2][2];
    const char* cA = (const char*)g.A + (size_t)cur.pm * tstep; const char* cB = (const char*)g.Bt + (size_t)cur.pn * tstep;
    S.a_ready(cur);
    PG8_STAGE(PG8_SB(0, 0), cB, voffB); PG8_STAGE(PG8_SA(0, 0), cA, voffA); PG8_STAGE(PG8_SB(0, 1), cB + hstep, voffB); PG8_STAGE(PG8_SA(0, 1), cA + hstep, voffA);
    if (wr == 1) PG8_BAR;
    PG8_WAIT_V(4); PG8_BAR;
    PG8_STAGE(PG8_SB(1, 0), cB + kstep, voffB); PG8_STAGE(PG8_SA(1, 0), cA + kstep, voffA); PG8_STAGE(PG8_SB(1, 1), cB + hstep + kstep, voffB);
    PG8_WAIT_V(6); PG8_BAR;
    PG8_STAMP();
    for (;;) {
        const bool has_next = S.next(ui + 1, nxt);
        const char* nA = has_next ? (const char*)g.A + (size_t)nxt.pm * tstep : cA; const char* nB = has_next ? (const char*)g.Bt + (size_t)nxt.pn * tstep : cB;
        for (int t = 0; t < nt; t += 2) {
            const bool last = (t == nt - 2);
            const char* a1 = cA + (size_t)(t + 1) * kstep;
            const char* a2 = last ? nA : cA + (size_t)(t + 2) * kstep; const char* b2 = last ? nB : cB + (size_t)(t + 2) * kstep;
            const char* a3 = a2 + kstep; const char* b3 = b2 + kstep;
            if (last && has_next) S.a_ready(nxt);
            PG8_LDB(B0, 0, 0); PG8_SCHED; PG8_LDA(At, 0, 0); PG8_STAGE(PG8_SA(1, 1), a1 + hstep, voffA);
            PG8_WAIT_L(8); PG8_BAR; PG8_WAIT_L(0); PG8_MMA(0, 0, At, B0); PG8_BAR; PG8_SCHED;
            PG8_LDB(B1, 0, 1); PG8_STAGE(PG8_SB(0, 0), b2, voffB);
            PG8_BAR; PG8_WAIT_L(0); PG8_MMA(0, 1, At, B1); PG8_BAR;
            PG8_LDA(At, 0, 1); PG8_STAGE(PG8_SA(0, 0), a2, voffA);
            PG8_BAR; PG8_WAIT_L(0); PG8_MMA(1, 0, At, B0); PG8_BAR; PG8_SCHED;
            PG8_STAGE(PG8_SB(0, 1), b2 + hstep, voffB);
            PG8_WAIT_V(6); PG8_BAR; PG8_MMA(1, 1, At, B1); PG8_BAR;
            PG8_LDB(B0, 1, 0); PG8_SCHED; PG8_LDA(At, 1, 0); PG8_STAGE(PG8_SA(0, 1), a2 + hstep, voffA);
            PG8_WAIT_L(8); PG8_BAR; PG8_WAIT_L(0); PG8_MMA(0, 0, At, B0); PG8_BAR; PG8_SCHED;
            PG8_LDB(B1, 1, 1); PG8_STAGE(PG8_SB(1, 0), b3, voffB);
            PG8_BAR; PG8_WAIT_L(0); PG8_MMA(0, 1, At, B1); PG8_BAR;
            PG8_LDA(At, 1, 1); PG8_STAGE(PG8_SA(1, 0), a3, voffA);
            PG8_BAR; PG8_WAIT_L(0); PG8_MMA(1, 0, At, B0); PG8_BAR; PG8_SCHED;
            PG8_STAGE(PG8_SB(1, 1), b3 + hstep, voffB);
            PG8_WAIT_V(6); PG8_BAR; PG8_MMA(1, 1, At, B1); PG8_BAR;
        }
        PG8_STAMP();
        if constexpr (!Epi::AFTER_DRAIN) { E(acc, cur, wr, wc, fr, fq); S.done(cur); }
        PG8_STAMP();
        if (!has_next) break;
#pragma unroll
        for (int a = 0; a < 2; ++a)
#pragma unroll
            for (int b = 0; b < 2; ++b)
#pragma unroll
                for (int m = 0; m < 4; ++m)
#pragma unroll
                    for (int n = 0; n < 2; ++n) acc[a][b][m][n] = (f32x4){0.f, 0.f, 0.f, 0.f};
        cur = nxt; cA = nA; cB = nB; ++ui;
    }
    PG8_WAIT_V(0);
    if (wr == 0) PG8_BAR;
    PG8_BAR;
    if constexpr (Epi::AFTER_DRAIN) { E.fused(acc, cur, wr, wc, fr, fq, lds, wid, lane); S.done(cur); }
    PG8_STAMP();
    if (STAMP && wid == 0) { stamps[lane] = lane < nts ? (((unsigned long long)(unsigned)ts_hi << 32) | (unsigned)ts_lo) : 0ull;
        if (lane == 62) stamps[62] = rt_entry; if (lane == 63) stamps[63] = (unsigned long long)wall_clock64(); }
#undef PG8_STAMP
#undef PG8_SA
#undef PG8_SB
#undef PG8_STAGE
#undef PG8_LDA
#undef PG8_LDB
#undef PG8_MMA
#undef PG8_WAIT_V
#undef PG8_WAIT_L
#undef PG8_BAR
#undef PG8_SCHED
}
}

#include <hip/hip_cooperative_groups.h>
namespace cg = cooperative_groups;
using pg8::bf16_t; using pg8::bf16x8; using pg8::f32x4; using pg8::u32x4;
typedef unsigned u32x2 __attribute__((ext_vector_type(2)));

#ifndef MEGA
#define MEGA 1
#endif

constexpr int T_ = 16384, DM = 2048, NPROJ = 18176, DFF = 8192, VTLD = T_ + 256;
constexpr size_t LDS_BYTES = 139264;

constexpr size_t SZ_WT_IN = (size_t)NPROJ * DM * 2, SZ_WT_UP = (size_t)DFF * DM * 2, SZ_WT_DOWN = SZ_WT_UP, SZ_WT_OUT = (size_t)DM * DM * 2,
                 SZ_WT_BRA = (size_t)DM * 1024 * 2, SZ_WT_BRC = (size_t)DM * 512 * 2;
constexpr size_t O_WT_IN = 0, O_WT_UP = O_WT_IN + SZ_WT_IN, O_WT_DOWN = O_WT_UP + SZ_WT_UP, O_WT_OUT = O_WT_DOWN + SZ_WT_DOWN, O_WT_BRA = O_WT_OUT + SZ_WT_OUT,
                 O_WT_BRB = O_WT_BRA + SZ_WT_BRA, O_WT_BRC = O_WT_BRB + SZ_WT_BRA, O_XN = O_WT_BRC + SZ_WT_BRC;
constexpr size_t O_VT = O_XN;
constexpr size_t O_AQKV = O_XN + (size_t)T_ * DM * 2;
constexpr size_t O_SB = O_AQKV + (size_t)T_ * 3072 * 2;
constexpr size_t O_OFWD = O_AQKV, O_OBWD = O_OFWD + (size_t)T_ * 1024 * 4, O_TINV = O_OBWD + (size_t)T_ * 1024 * 4, O_AIN = O_TINV + (size_t)4096 * 4096 * 2;
constexpr size_t O_MACC = O_OFWD;
constexpr size_t O_SZ = O_SB + (size_t)T_ * 3072 * 2;
constexpr size_t O_CQ = O_SZ + (size_t)T_ * 1024 * 2;
constexpr size_t O_CK = O_CQ + (size_t)T_ * 1536 * 2, O_CV = O_CK + (size_t)T_ * 1536 * 2;
constexpr size_t O_GATES = O_CV + (size_t)T_ * 1536 * 2;
constexpr size_t O_HID = O_CQ;
constexpr size_t O_AB = O_GATES + (size_t)T_ * 6144 * 2;
constexpr size_t O_QKV = O_AB + (size_t)T_ * 32 * 4;
constexpr size_t O_KT = O_QKV + (size_t)T_ * 3072 * 2;
constexpr size_t O_G = O_KT + (size_t)T_ * 1024 * 2;
constexpr size_t O_BETA = O_G + (size_t)T_ * 16 * 4;
constexpr size_t O_YA = O_BETA + (size_t)T_ * 16 * 4;
constexpr size_t O_YB = O_YA + (size_t)T_ * 1024 * 2;
constexpr size_t O_YC = O_YB + (size_t)T_ * 1024 * 2;
constexpr size_t O_GCP = O_YC + (size_t)T_ * 512 * 2;
constexpr size_t O_OG = O_GCP + (size_t)4096 * 64 * 4;
constexpr size_t O_LSE = O_OG + (size_t)3 * T_ * 512 * 2;
constexpr size_t WS_NEED = O_LSE + (size_t)3 * T_ * 4 * 4;
static_assert((size_t)3 * 512 * VTLD * 2 <= (size_t)T_ * DM * 2, "vT alias");
static_assert(O_AIN + (size_t)4096 * 4096 * 2 <= O_SZ, "alias AQKV|SB");
static_assert(O_HID + (size_t)T_ * DFF * 2 <= O_AB, "alias hidden");
static_assert(WS_NEED < (size_t)1176000000, "workspace");

struct Params {
    const float* x_prompt; const float* x_sample; const float* rel_bias; const float* norm_mix; const float* w_in; const float* conv_a; const float* a_log; const float* dt_bias;
    const float* head_norm; const float* conv_b; const float* w_br_a; const float* w_br_b; const float* w_br_c; const float* w_out; const float* norm_mlp; const float* w_up;
    const float* w_down; const float* norm_final; float* out; unsigned char* ws;
};

__device__ __forceinline__ float bf2f(unsigned short b) { return __uint_as_float(((unsigned)b) << 16); }
__device__ __forceinline__ float bflo(unsigned u) { return __uint_as_float(u << 16); }
__device__ __forceinline__ float bfhi(unsigned u) { return __uint_as_float(u & 0xffff0000u); }
__device__ __forceinline__ unsigned pk2(float lo, float hi) { return pg8::cvt_pk_bf16(lo, hi); }
__device__ __forceinline__ unsigned short f2bf(float f) { return (unsigned short)(pk2(f, 0.f) & 0xffffu); }
__device__ __forceinline__ float sigmoidf_(float x) { return 1.0f / (1.0f + __expf(-x)); }
__device__ __forceinline__ float siluf_(float x) { return x / (1.0f + __expf(-x)); }
__device__ __forceinline__ void seq_of(int t, int& s0, int& L) { if (t < 8192) { s0 = t & ~4095; L = 4096; } else { s0 = t & ~2047; L = 2048; } }
__device__ __forceinline__ bf16x8 mk8(u32x2 a, u32x2 b) { u32x4 w; w.x = a.x; w.y = a.y; w.z = b.x; w.w = b.y; return __builtin_bit_cast(bf16x8, w); }
__device__ __forceinline__ bf16x8 pack8(f32x4 a, f32x4 b) { u32x4 w; w.x = pk2(a[0], a[1]); w.y = pk2(a[2], a[3]); w.z = pk2(b[0], b[1]); w.w = pk2(b[2], b[3]); return __builtin_bit_cast(bf16x8, w); }
__device__ __forceinline__ int tid_l() { int t = threadIdx.x; asm volatile("" : "+v"(t)); return t; }
__device__ __forceinline__ int bid_l() { int b = blockIdx.x; asm volatile("" : "+s"(b)); return b; }
#define MFMA16(a, b, c) __builtin_amdgcn_mfma_f32_16x16x32_bf16((a), (b), (c), 0, 0, 0)
#define LDS_WAIT() asm volatile("s_waitcnt lgkmcnt(0)" ::: "memory")

__device__ void conv_tiles(const float* __restrict__ W, int K, int ldn, int ntn, bf16_t* __restrict__ Wt, int mode, float* tile) {
    const int nkt = K >> 6, total = ntn * nkt, tid = tid_l();
    for (int it = bid_l(); it < total; it += gridDim.x) {
        const int tn = it / nkt, tk = it - tn * nkt, n0 = tn * 64, k0 = tk * 64;
        int src0 = n0, nvalid = 64;
        if (mode == 1) { if (n0 >= 17920) { src0 = 4096; nvalid = 32; } else if (n0 >= 4096) src0 = n0 + 32; }
#pragma unroll
        for (int ps = 0; ps < 2; ++ps) {
            const int r = ps * 32 + (tid >> 4), c4 = (tid & 15) * 4;
            float4 v = make_float4(0.f, 0.f, 0.f, 0.f);
            if (c4 < nvalid) v = *(const float4*)(W + (size_t)(k0 + r) * ldn + src0 + c4);
            float* tp = tile + r * 65 + c4; tp[0] = v.x; tp[1] = v.y; tp[2] = v.z; tp[3] = v.w;
        }
        __syncthreads();
        { const int n = tid >> 3, kk = (tid & 7) * 8;
          if (n < nvalid) { u32x4 w; w.x = pk2(tile[(kk + 0) * 65 + n], tile[(kk + 1) * 65 + n]); w.y = pk2(tile[(kk + 2) * 65 + n], tile[(kk + 3) * 65 + n]);
              w.z = pk2(tile[(kk + 4) * 65 + n], tile[(kk + 5) * 65 + n]); w.w = pk2(tile[(kk + 6) * 65 + n], tile[(kk + 7) * 65 + n]);
              *(u32x4*)(Wt + (size_t)(n0 + n) * K + k0 + kk) = w; } }
        __syncthreads();
    }
}

__device__ void norm_rows(const Params& p, int mode, const float* __restrict__ w, bf16_t* __restrict__ xn) {
    const int tid = tid_l(), lane = tid & 63, gw = bid_l() * 8 + (tid >> 6), nw = gridDim.x * 8;
    for (int t = gw; t < T_; t += nw) {
        const float* src = (mode == 0) ? (t < 8192 ? p.x_prompt + (size_t)t * DM : p.x_sample + (size_t)(t - 8192) * DM) : p.out + (size_t)t * DM;
        float4 v[8]; float ss = 0.f;
#pragma unroll
        for (int i = 0; i < 8; ++i) { v[i] = *(const float4*)(src + i * 256 + lane * 4); ss += v[i].x * v[i].x + v[i].y * v[i].y + v[i].z * v[i].z + v[i].w * v[i].w; }
#pragma unroll
        for (int off = 32; off > 0; off >>= 1) ss += __shfl_xor(ss, off);
        const float rstd = rsqrtf(ss * (1.0f / DM) + 1e-6f);
#pragma unroll
        for (int i = 0; i < 8; ++i) {
            const float4 wv = *(const float4*)(w + i * 256 + lane * 4);
            const float a = v[i].x * rstd * wv.x, b = v[i].y * rstd * wv.y, c = v[i].z * rstd * wv.z, d = v[i].w * rstd * wv.w;
            if (mode == 2) { *(float4*)(p.out + (size_t)t * DM + i * 256 + lane * 4) = make_float4(a, b, c, d); }
            else { u32x2 o; o.x = pk2(a, b); o.y = pk2(c, d); *(u32x2*)(xn + (size_t)t * DM + i * 256 + lane * 4) = o;
                   if (mode == 0) *(float4*)(p.out + (size_t)t * DM + i * 256 + lane * 4) = v[i]; }
        }
    }
}

struct EpiProj {
    static constexpr bool PERM = true, AFTER_DRAIN = false;
    unsigned char* ws;
    __device__ __forceinline__ void operator()(const f32x4 (&acc)[2][2][4][2], const pg8::Unit& u, int wr, int wc, int fr, int fq) const {
        const int pn = u.pn, row0 = u.pm * 256 + wr * 64 + fr;
        if (pn == 70) {
            if (wc == 0) { float* ab = (float*)(ws + O_AB);
#pragma unroll
                for (int ai = 0; ai < 2; ++ai)
#pragma unroll
                    for (int m = 0; m < 4; ++m) { float* rp = ab + (size_t)(row0 + ai * 128 + m * 16) * 32 + 8 * fq; *(f32x4*)rp = acc[ai][0][m][0]; *(f32x4*)(rp + 4) = acc[ai][0][m][1]; } }
            return;
        }
        bf16_t* base; int ldc, colt;
        if (pn < 12) { base = (bf16_t*)(ws + O_AQKV); ldc = 3072; colt = pn * 256; }
        else if (pn < 16) { base = (bf16_t*)(ws + O_SZ); ldc = 1024; colt = (pn - 12) * 256; }
        else if (pn < 28) { base = (bf16_t*)(ws + O_SB); ldc = 3072; colt = (pn - 16) * 256; }
        else if (pn < 46) { const int s = (pn - 28) / 6; base = (bf16_t*)(ws + O_CQ) + (size_t)s * T_ * 1536; ldc = 1536; colt = ((pn - 28) - s * 6) * 256; }
        else { base = (bf16_t*)(ws + O_GATES); ldc = 6144; colt = (pn - 46) * 256; }
        const int col0 = colt + wc * 32 + 8 * fq;
#pragma unroll
        for (int ai = 0; ai < 2; ++ai)
#pragma unroll
            for (int m = 0; m < 4; ++m) { bf16_t* rowp = base + (size_t)(row0 + ai * 128 + m * 16) * ldc + col0;
#pragma unroll
                for (int bj = 0; bj < 2; ++bj) { const f32x4 v0 = acc[ai][bj][m][0], v1 = acc[ai][bj][m][1];
                    u32x4 w; w.x = pk2(v0[0], v0[1]); w.y = pk2(v0[2], v0[3]); w.z = pk2(v1[0], v1[1]); w.w = pk2(v1[2], v1[3]);
                    *(u32x4*)(rowp + bj * 128) = w; } }
    }
};
struct EpiUp {
    static constexpr bool PERM = true, AFTER_DRAIN = false;
    bf16_t* O;
    __device__ __forceinline__ void operator()(const f32x4 (&acc)[2][2][4][2], const pg8::Unit& u, int wr, int wc, int fr, int fq) const {
        const int row0 = u.pm * 256 + wr * 64 + fr, col0 = u.pn * 256 + wc * 32 + 8 * fq;
#pragma unroll
        for (int ai = 0; ai < 2; ++ai)
#pragma unroll
            for (int m = 0; m < 4; ++m) { bf16_t* rowp = O + (size_t)(row0 + ai * 128 + m * 16) * DFF + col0;
#pragma unroll
                for (int bj = 0; bj < 2; ++bj) { f32x4 v0 = acc[ai][bj][m][0], v1 = acc[ai][bj][m][1];
#pragma unroll
                    for (int j = 0; j < 4; ++j) { const float a = fmaxf(v0[j], 0.f), b = fmaxf(v1[j], 0.f); v0[j] = a * a; v1[j] = b * b; }
                    u32x4 w; w.x = pk2(v0[0], v0[1]); w.y = pk2(v0[2], v0[3]); w.z = pk2(v1[0], v1[1]); w.w = pk2(v1[2], v1[3]);
                    *(u32x4*)(rowp + bj * 128) = w; } }
    }
};
struct EpiResid {
    static constexpr bool PERM = false, AFTER_DRAIN = false;
    float* C;
    __device__ __forceinline__ void operator()(const f32x4 (&acc)[2][2][4][2], const pg8::Unit& u, int wr, int wc, int fr, int fq) const {
        const int row0 = u.pm * 256 + wr * 64 + fr, col0 = u.pn * 256 + wc * 32 + 4 * fq;
#pragma unroll
        for (int ai = 0; ai < 2; ++ai)
#pragma unroll
            for (int m = 0; m < 4; ++m) { float* rowp = C + (size_t)(row0 + ai * 128 + m * 16) * DM + col0;
#pragma unroll
                for (int bj = 0; bj < 2; ++bj)
#pragma unroll
                    for (int n = 0; n < 2; ++n) { f32x4* q = (f32x4*)(rowp + bj * 128 + n * 16); *q = *q + acc[ai][bj][m][n]; } }
    }
};
struct EpiBranch {
    static constexpr bool PERM = false, AFTER_DRAIN = false;
    float* macc; bf16_t* merged; const bf16_t* gates; int goff, mode;
    __device__ __forceinline__ void operator()(const f32x4 (&acc)[2][2][4][2], const pg8::Unit& u, int wr, int wc, int fr, int fq) const {
        const int row0 = u.pm * 256 + wr * 64 + fr, col0 = u.pn * 256 + wc * 32 + 4 * fq;
#pragma unroll
        for (int ai = 0; ai < 2; ++ai)
#pragma unroll
            for (int m = 0; m < 4; ++m) { const size_t row = (size_t)(row0 + ai * 128 + m * 16);
#pragma unroll
                for (int bj = 0; bj < 2; ++bj)
#pragma unroll
                    for (int n = 0; n < 2; ++n) { const int col = col0 + bj * 128 + n * 16;
                        const u32x2 gw = *(const u32x2*)(gates + row * 6144 + goff + col);
                        f32x4 v = acc[ai][bj][m][n];
                        v[0] *= sigmoidf_(bflo(gw.x)); v[1] *= sigmoidf_(bfhi(gw.x)); v[2] *= sigmoidf_(bflo(gw.y)); v[3] *= sigmoidf_(bfhi(gw.y));
                        f32x4* q = (f32x4*)(macc + row * DM + col);
                        if (mode == 0) *q = v;
                        else if (mode == 1) *q = *q + v;
                        else { v = v + *q; u32x2 o; o.x = pk2(v[0], v[1]); o.y = pk2(v[2], v[3]); *(u32x2*)(merged + row * DM + col) = o; } } }
    }
};

template <class Epi> __device__ __forceinline__ void run_gemm(unsigned char* smem, const bf16_t* A, const bf16_t* Bt, int M, int N, int K, const Epi& E) {
    pg8::Gemm g; g.A = A; g.Bt = Bt; g.M = M; g.N = N; g.K = K;
    pg8::StaticOrder S; S.init(M, N, (int)gridDim.x, bid_l());
    pg8::gemm_phase<Epi, pg8::StaticOrder, false>((PG8_LAS unsigned char*)smem, g, S, E, nullptr);
}

__device__ void prep_phase(const Params& p, int L, unsigned char* smem) {
    const int tid = tid_l(), wid = tid >> 6, lane = tid & 63, bid = bid_l();
    unsigned char* ws = p.ws;
    const bf16_t* AQ = (const bf16_t*)(ws + O_AQKV); const bf16_t* SB = (const bf16_t*)(ws + O_SB);
    bf16_t* QKV = (bf16_t*)(ws + O_QKV); bf16_t* KT = (bf16_t*)(ws + O_KT); bf16_t* YB = (bf16_t*)(ws + O_YB);
    unsigned short* kl = (unsigned short*)smem;
    const float* ca = p.conv_a + (size_t)L * 3 * 3072; const float* cb = p.conv_b + (size_t)L * 3 * 1024;
    for (int it = bid; it < 2048; it += gridDim.x) {
        const int ch = it >> 3, h = it & 7, t0 = ch * 64;
        for (int i = 0; i < 8; ++i) {
            const int r = wid * 8 + i, t = t0 + r; int s0, Ls; seq_of(t, s0, Ls);
            const bool hp = t > s0, hn = t < s0 + Ls - 1;
            float qv[3][2];
#pragma unroll
            for (int part = 0; part < 3; ++part) {
                const int col = part * 1024 + h * 128 + 2 * lane;
                const unsigned x1 = *(const unsigned*)(AQ + (size_t)t * 3072 + col);
                const unsigned x0 = hp ? *(const unsigned*)(AQ + (size_t)(t - 1) * 3072 + col) : 0u;
                const unsigned x2 = hn ? *(const unsigned*)(AQ + (size_t)(t + 1) * 3072 + col) : 0u;
                const float2 w0 = *(const float2*)(ca + col), w1 = *(const float2*)(ca + 3072 + col), w2 = *(const float2*)(ca + 6144 + col);
                qv[part][0] = siluf_(w0.x * bflo(x0) + w1.x * bflo(x1) + w2.x * bflo(x2));
                qv[part][1] = siluf_(w0.y * bfhi(x0) + w1.y * bfhi(x1) + w2.y * bfhi(x2));
            }
            float sq = qv[0][0] * qv[0][0] + qv[0][1] * qv[0][1], sk = qv[1][0] * qv[1][0] + qv[1][1] * qv[1][1];
#pragma unroll
            for (int off = 32; off > 0; off >>= 1) { sq += __shfl_xor(sq, off); sk += __shfl_xor(sk, off); }
            const float rq = rsqrtf(sq + 1e-6f) * 0.08838834764831845f, rk = rsqrtf(sk + 1e-6f);
            const unsigned qo = pk2(qv[0][0] * rq, qv[0][1] * rq), ko = pk2(qv[1][0] * rk, qv[1][1] * rk), vo = pk2(qv[2][0], qv[2][1]);
            bf16_t* orow = QKV + (size_t)t * 3072 + h * 128 + 2 * lane;
            *(unsigned*)(orow) = qo; *(unsigned*)(orow + 1024) = ko; *(unsigned*)(orow + 2048) = vo;
            *(unsigned*)(kl + r * 130 + 2 * lane) = ko;
            { const int cbn = h * 128 + 2 * lane;
              const bf16_t* r1 = SB + (size_t)t * 3072 + cbn;
              const unsigned gb = *(const unsigned*)r1, c1 = *(const unsigned*)(r1 + 1024), h1 = *(const unsigned*)(r1 + 2048);
              unsigned c0 = 0u, h0 = 0u, c2 = 0u, h2 = 0u;
              if (hp) { c0 = *(const unsigned*)(r1 - 3072 + 1024); h0 = *(const unsigned*)(r1 - 3072 + 2048); }
              if (hn) { c2 = *(const unsigned*)(r1 + 3072 + 1024); h2 = *(const unsigned*)(r1 + 3072 + 2048); }
              const float2 w0 = *(const float2*)(cb + cbn), w1 = *(const float2*)(cb + 1024 + cbn), w2 = *(const float2*)(cb + 2048 + cbn);
              const float ya = bflo(gb) * (w0.x * (bflo(c0) * bflo(h0)) + w1.x * (bflo(c1) * bflo(h1)) + w2.x * (bflo(c2) * bflo(h2)));
              const float yb = bfhi(gb) * (w0.y * (bfhi(c0) * bfhi(h0)) + w1.y * (bfhi(c1) * bfhi(h1)) + w2.y * (bfhi(c2) * bfhi(h2)));
              *(unsigned*)(YB + (size_t)t * 1024 + cbn) = pk2(ya, yb); }
        }
        if (h == 0) {
            const float* AB = (const float*)(ws + O_AB); float* G = (float*)(ws + O_G); float* BT = (float*)(ws + O_BETA);
#pragma unroll
            for (int rep = 0; rep < 2; ++rep) { const int idx = tid + rep * 512, tok = t0 + (idx >> 4), dh = idx & 15;
                const float a = AB[(size_t)tok * 32 + dh] + p.dt_bias[L * 16 + dh];
                const float sp = fmaxf(a, 0.f) + log1pf(__expf(-fabsf(a)));
                G[(size_t)tok * 16 + dh] = -__expf(p.a_log[L * 16 + dh]) * sp;
                BT[(size_t)tok * 16 + dh] = sigmoidf_(AB[(size_t)tok * 32 + 16 + dh]); }
        }
        __syncthreads();
        { const int d = tid >> 2, cs = (tid & 3) * 16; unsigned w[8];
#pragma unroll
          for (int j = 0; j < 8; ++j) w[j] = (unsigned)kl[(cs + 2 * j) * 130 + d] | ((unsigned)kl[(cs + 2 * j + 1) * 130 + d] << 16);
          bf16_t* dst = KT + ((size_t)(ch * 8 + h) * 128 + d) * 64 + cs;
          u32x4 a, b; a.x = w[0]; a.y = w[1]; a.z = w[2]; a.w = w[3]; b.x = w[4]; b.y = w[5]; b.z = w[6]; b.w = w[7];
          *(u32x4*)dst = a; *(u32x4*)(dst + 8) = b; }
        __syncthreads();
    }
    const bf16_t* CV = (const bf16_t*)(ws + O_CV); bf16_t* VT = (bf16_t*)(ws + O_VT);
    for (int it = bid; it < 3072; it += gridDim.x) {
        const int ch = it / 12, hc = it - ch * 12, g = hc >> 2, hq = hc & 3, t0 = ch * 64, D = (g == 0) ? 1 : (g == 1 ? 4 : 16);
        int s0, Ls; seq_of(t0, s0, Ls); const int l = Ls / D;
        { const int row = tid >> 3, seg = (tid & 7) * 16;
          const u32x4 a = *(const u32x4*)(CV + (size_t)(t0 + row) * 1536 + hc * 128 + seg), b = *(const u32x4*)(CV + (size_t)(t0 + row) * 1536 + hc * 128 + seg + 8);
          unsigned* dp = (unsigned*)(kl + row * 130 + seg);
          dp[0] = a.x; dp[1] = a.y; dp[2] = a.z; dp[3] = a.w; dp[4] = b.x; dp[5] = b.y; dp[6] = b.z; dp[7] = b.w; }
        __syncthreads();
        bf16_t* vtg = VT + (size_t)g * 512 * VTLD;
        const int nper = 64 / D, upr = nper >> 2;
#pragma unroll
        for (int rep = 0; rep < 4; ++rep) { const int pid = tid + rep * 512, d = pid & 127, uu = pid >> 7;
            const int r = uu / upr, m0 = (uu - r * upr) * 4;
            const int col = s0 + r * l + (t0 - s0) / D + m0;
            const unsigned e0 = kl[((m0 + 0) * D + r) * 130 + d], e1 = kl[((m0 + 1) * D + r) * 130 + d], e2 = kl[((m0 + 2) * D + r) * 130 + d], e3 = kl[((m0 + 3) * D + r) * 130 + d];
            u32x2 o; o.x = e0 | (e1 << 16); o.y = e2 | (e3 << 16);
            *(u32x2*)(vtg + (size_t)(hq * 128 + d) * VTLD + 128 + col) = o; }
        if (ch == 0) {
            const int d = tid >> 2, q4 = (tid & 3) * 32; bf16_t* rowp = vtg + (size_t)(hq * 128 + d) * VTLD; const u32x4 z = {0u, 0u, 0u, 0u};
#pragma unroll
            for (int j = 0; j < 4; ++j) { *(u32x4*)(rowp + q4 + j * 8) = z; *(u32x4*)(rowp + 128 + T_ + q4 + j * 8) = z; }
        }
        __syncthreads();
    }
}

__device__ void gdn_local(const Params& p, unsigned char* smem) {
    const int tid = tid_l(), wid = tid >> 6, lane = tid & 63, fr = lane & 15, fq = lane >> 4;
    unsigned char* ws = p.ws;
    float* Lm = (float*)(smem + wid * 16384);
    float* gcs = (float*)(smem + 131072 + wid * 512); float* bts = gcs + 64;
    const float* G = (const float*)(ws + O_G); const float* BT = (const float*)(ws + O_BETA); const bf16_t* QKV = (const bf16_t*)(ws + O_QKV);
    float* GCP = (float*)(ws + O_GCP); bf16_t* TG = (bf16_t*)(ws + O_TINV); bf16_t* AG = (bf16_t*)(ws + O_AIN);
    for (int item = bid_l() * 8 + wid; item < 4096; item += gridDim.x * 8) {
        const int dir = item & 1, h = (item >> 1) & 7, ch = item >> 4, t0 = ch * 64;
        const int pl = dir ? 63 - lane : lane;
        float gc = G[(size_t)(t0 + pl) * 16 + dir * 8 + h];
        const float bt = BT[(size_t)(t0 + pl) * 16 + dir * 8 + h];
#pragma unroll
        for (int off = 1; off < 64; off <<= 1) { const float v = __shfl_up(gc, off); if (lane >= off) gc += v; }
        LDS_WAIT();
        gcs[lane] = gc; bts[lane] = bt;
        GCP[(size_t)item * 64 + pl] = gc;
        LDS_WAIT();
        {
            bf16x8 kf[4][4];
#pragma unroll
            for (int mt = 0; mt < 4; ++mt) { const int a = mt * 16 + fr, pp = dir ? 63 - a : a;
#pragma unroll
                for (int kb = 0; kb < 4; ++kb) kf[mt][kb] = *(const bf16x8*)(QKV + (size_t)(t0 + pp) * 3072 + 1024 + h * 128 + kb * 32 + fq * 8); }
#pragma unroll
            for (int mt = 0; mt < 4; ++mt)
#pragma unroll
                for (int nt = 0; nt <= mt; ++nt) { f32x4 acc = {0.f, 0.f, 0.f, 0.f};
#pragma unroll
                    for (int kb = 0; kb < 4; ++kb) acc = MFMA16(kf[mt][kb], kf[nt][kb], acc);
                    const int b = nt * 16 + fr; const float gb = gcs[b];
#pragma unroll
                    for (int j = 0; j < 4; ++j) { const int a = mt * 16 + fq * 4 + j;
                        Lm[a * 64 + b] = (a > b) ? acc[j] * bts[a] * __expf(gcs[a] - gb) : 0.f; } }
        }
#pragma unroll 1
        for (int mt = 0; mt < 4; ++mt) { bf16x8 qf[4]; const int aq = mt * 16 + fr, pq = dir ? 63 - aq : aq;
#pragma unroll
            for (int kb = 0; kb < 4; ++kb) qf[kb] = *(const bf16x8*)(QKV + (size_t)(t0 + pq) * 3072 + h * 128 + kb * 32 + fq * 8);
#pragma unroll 1
            for (int nt = 0; nt < 4; ++nt) { f32x4 acc = {0.f, 0.f, 0.f, 0.f};
                const int b = nt * 16 + fr, pb = dir ? 63 - b : b; const float gb = gcs[b];
                if (nt <= mt) {
#pragma unroll
                    for (int kb = 0; kb < 4; ++kb) { const bf16x8 kfr = *(const bf16x8*)(QKV + (size_t)(t0 + pb) * 3072 + 1024 + h * 128 + kb * 32 + fq * 8); acc = MFMA16(qf[kb], kfr, acc); } }
#pragma unroll
                for (int j = 0; j < 4; ++j) { const int a = mt * 16 + fq * 4 + j, pa = dir ? 63 - a : a;
                    const float v = (a >= b) ? acc[j] * __expf(gcs[a] - gb) : 0.f;
                    AG[(size_t)item * 4096 + pa * 64 + pb] = f2bf(v); } } }
        LDS_WAIT();
        float x[64];
#pragma unroll
        for (int i = 0; i < 64; ++i) { int ln = lane; asm volatile("" : "+v"(ln)); float s = (i == ln) ? 1.f : 0.f;
#pragma unroll
            for (int j = 0; j < i; ++j) s -= Lm[i * 64 + j] * x[j];
            x[i] = s; asm volatile("" ::: "memory"); }
        LDS_WAIT();
        {
            unsigned short* Xs = (unsigned short*)Lm; const int idx0 = dir ? 4095 - lane : lane, st = dir ? -64 : 64;
#pragma unroll
            for (int a = 0; a < 64; a += 2) { const unsigned w = pk2(x[a], x[a + 1]); Xs[idx0 + a * st] = (unsigned short)(w & 0xffffu); Xs[idx0 + (a + 1) * st] = (unsigned short)(w >> 16); }
            LDS_WAIT();
            u32x4* dst = (u32x4*)(TG + (size_t)item * 4096);
#pragma unroll
            for (int k = 0; k < 8; ++k) dst[k * 64 + lane] = ((const u32x4*)Xs)[k * 64 + lane];
            LDS_WAIT();
        }
    }
}

__device__ void gdn_scan(const Params& p, unsigned char* smem, int chain) {
    const int tid = tid_l(), wid = tid >> 6, lane = tid & 63, fr = lane & 15, fq = lane >> 4;
    unsigned char* ws = p.ws;
    int seq, h, dir, nch, c0;
    if (chain < 32) { seq = chain >> 4; h = (chain >> 1) & 7; dir = chain & 1; nch = 64; c0 = seq * 64; }
    else { const int b = chain - 32; seq = b >> 4; h = (b >> 1) & 7; dir = b & 1; nch = 32; c0 = 128 + seq * 32; }
    unsigned char* kS = smem; unsigned char* qS = smem + 17408; unsigned char* vS = smem + 34816; unsigned char* kTS = smem + 52224;
    unsigned char* TiS = smem + 70656; unsigned char* AS = smem + 79872; float* gS = (float*)(smem + 89088); float* bS = (float*)(smem + 89344);
    const bf16_t* QKV = (const bf16_t*)(ws + O_QKV); const bf16_t* KT = (const bf16_t*)(ws + O_KT); const bf16_t* TG = (const bf16_t*)(ws + O_TINV); const bf16_t* AG = (const bf16_t*)(ws + O_AIN);
    const float* GCP = (const float*)(ws + O_GCP); const float* BT = (const float*)(ws + O_BETA);
    float* of = (float*)(ws + (dir ? O_OBWD : O_OFWD));
    f32x4 S[8];
#pragma unroll
    for (int i = 0; i < 8; ++i) S[i] = (f32x4){0.f, 0.f, 0.f, 0.f};
    const int e0 = wid * 16;
    for (int ci = 0; ci < nch; ++ci) {
        const int cg_ = c0 + (dir ? nch - 1 - ci : ci), t0 = cg_ * 64, item = (cg_ * 8 + h) * 2 + dir;
        __syncthreads();
#pragma unroll
        for (int rep = 0; rep < 2; ++rep) { const int pid = tid + rep * 512, row = pid >> 4, seg = pid & 15;
            const bf16_t* src = QKV + (size_t)(t0 + row) * 3072 + h * 128 + seg * 8;
            *(u32x4*)(qS + row * 272 + seg * 16) = *(const u32x4*)(src);
            *(u32x4*)(kS + row * 272 + seg * 16) = *(const u32x4*)(src + 1024);
            *(u32x4*)(vS + row * 272 + seg * 16) = *(const u32x4*)(src + 2048);
            const int rowt = pid >> 3, segt = pid & 7;
            *(u32x4*)(kTS + rowt * 144 + segt * 16) = *(const u32x4*)(KT + ((size_t)(cg_ * 8 + h) * 128 + rowt) * 64 + segt * 8); }
        { const int row = tid >> 3, seg = tid & 7;
          *(u32x4*)(TiS + row * 144 + seg * 16) = *(const u32x4*)(TG + (size_t)item * 4096 + row * 64 + seg * 8);
          *(u32x4*)(AS + row * 144 + seg * 16) = *(const u32x4*)(AG + (size_t)item * 4096 + row * 64 + seg * 8); }
        if (tid < 64) gS[tid] = GCP[(size_t)item * 64 + tid];
        else if (tid < 128) bS[tid - 64] = BT[(size_t)(t0 + tid - 64) * 16 + dir * 8 + h];
        __syncthreads();
        bf16x8 Sb[4];
#pragma unroll
        for (int kb = 0; kb < 4; ++kb) Sb[kb] = pack8(S[2 * kb], S[2 * kb + 1]);
        f32x4 KS[4], QS[4];
#pragma unroll
        for (int mt = 0; mt < 4; ++mt) { KS[mt] = (f32x4){0.f, 0.f, 0.f, 0.f}; QS[mt] = (f32x4){0.f, 0.f, 0.f, 0.f};
#pragma unroll
            for (int kb = 0; kb < 4; ++kb) { const int off = (mt * 16 + fr) * 272 + (kb * 32 + fq * 4) * 2;
                const bf16x8 ka = mk8(*(const u32x2*)(kS + off), *(const u32x2*)(kS + off + 32));
                const bf16x8 qa = mk8(*(const u32x2*)(qS + off), *(const u32x2*)(qS + off + 32));
                KS[mt] = MFMA16(ka, Sb[kb], KS[mt]); QS[mt] = MFMA16(qa, Sb[kb], QS[mt]); } }
        f32x4 R[4], gv[4];
#pragma unroll
        for (int mt = 0; mt < 4; ++mt) { gv[mt] = *(const f32x4*)(gS + mt * 16 + fq * 4); const f32x4 bv = *(const f32x4*)(bS + mt * 16 + fq * 4);
#pragma unroll
            for (int j = 0; j < 4; ++j) { const int c = mt * 16 + fq * 4 + j;
                const float vv = bf2f(*(const unsigned short*)(vS + c * 272 + (e0 + fr) * 2));
                R[mt][j] = bv[j] * (vv - __expf(gv[mt][j]) * KS[mt][j]); } }
        bf16x8 Rb[2]; Rb[0] = pack8(R[0], R[1]); Rb[1] = pack8(R[2], R[3]);
        f32x4 VN[4];
#pragma unroll
        for (int mt = 0; mt < 4; ++mt) { VN[mt] = (f32x4){0.f, 0.f, 0.f, 0.f};
#pragma unroll
            for (int kb = 0; kb < 2; ++kb) { const int off = (mt * 16 + fr) * 144 + (kb * 32 + fq * 4) * 2;
                VN[mt] = MFMA16(mk8(*(const u32x2*)(TiS + off), *(const u32x2*)(TiS + off + 32)), Rb[kb], VN[mt]); } }
        bf16x8 VNb[2]; VNb[0] = pack8(VN[0], VN[1]); VNb[1] = pack8(VN[2], VN[3]);
#pragma unroll
        for (int mt = 0; mt < 4; ++mt) { f32x4 oa = {0.f, 0.f, 0.f, 0.f};
#pragma unroll
            for (int kb = 0; kb < 2; ++kb) { const int off = (mt * 16 + fr) * 144 + (kb * 32 + fq * 4) * 2;
                oa = MFMA16(mk8(*(const u32x2*)(AS + off), *(const u32x2*)(AS + off + 32)), VNb[kb], oa); }
#pragma unroll
            for (int j = 0; j < 4; ++j) { const int c = mt * 16 + fq * 4 + j;
                of[(size_t)(t0 + c) * 1024 + h * 128 + e0 + fr] = __expf(gv[mt][j]) * QS[mt][j] + oa[j]; } }
        const float glast = gS[dir ? 0 : 63], eg = __expf(glast);
#pragma unroll
        for (int mt = 0; mt < 4; ++mt)
#pragma unroll
            for (int j = 0; j < 4; ++j) VN[mt][j] *= __expf(glast - gv[mt][j]);
        bf16x8 VDb[2]; VDb[0] = pack8(VN[0], VN[1]); VDb[1] = pack8(VN[2], VN[3]);
#pragma unroll
        for (int dt = 0; dt < 8; ++dt) { S[dt] = S[dt] * eg;
#pragma unroll
            for (int kb = 0; kb < 2; ++kb) { const int off = (dt * 16 + fr) * 144 + (kb * 32 + fq * 4) * 2;
                S[dt] = MFMA16(mk8(*(const u32x2*)(kTS + off), *(const u32x2*)(kTS + off + 32)), VDb[kb], S[dt]); } }
    }
}

__device__ void attn_phase(const Params& p, unsigned char* smem, int bfirst, int nw) {
    const int tid = tid_l(), wfirst = bfirst * 8 + (tid >> 6), lane = tid & 63, fr = lane & 15, fq = lane >> 4;
    unsigned char* ws = p.ws;
    float* btab = (float*)(smem + 90112);
    for (int idx = tid; idx < 3 * 4 * 129; idx += 512) { const int g = idx / 516, hq = (idx / 129) & 3, rr = idx % 129 - 64, D = (g == 0) ? 1 : (g == 1 ? 4 : 16);
        const int rel = rr * D, n = rel < 0 ? -rel : rel;
        int bk = (n < 8) ? n : min(15, 5 + (31 - __clz(n)));
        if (rel > 0) bk += 16;
        btab[idx] = p.rel_bias[bk * 12 + g * 4 + hq]; }
    __syncthreads();
    const bf16_t* CQ = (const bf16_t*)(ws + O_CQ); const bf16_t* CK = (const bf16_t*)(ws + O_CK); const bf16_t* VT = (const bf16_t*)(ws + O_VT);
    bf16_t* OG = (bf16_t*)(ws + O_OG); float* LSE = (float*)(ws + O_LSE);
    for (int item = wfirst; item < 6144; item += nw) {
        const int g = item >> 11, rem = item & 2047, hq = rem >> 9, qt = rem & 511, D = (g == 0) ? 1 : (g == 1 ? 4 : 16), hc = g * 4 + hq;
        const int col0 = qt * 32; int s0, Ls; seq_of(col0, s0, Ls); const int l = Ls / D, r = (col0 - s0) / l, i0 = (col0 - s0) - r * l;
        bf16x8 qf[2][4];
#pragma unroll
        for (int nq = 0; nq < 2; ++nq) { const size_t tq = (size_t)(s0 + (i0 + nq * 16 + fr) * D + r);
#pragma unroll
            for (int kb = 0; kb < 4; ++kb) qf[nq][kb] = *(const bf16x8*)(CQ + tq * 1536 + hc * 128 + kb * 32 + fq * 8); }
        f32x4 st[10][2];
#pragma unroll
        for (int kt = 0; kt < 10; ++kt) { int ki = i0 - 64 + kt * 16 + fr; ki = ki < 0 ? 0 : (ki > l - 1 ? l - 1 : ki);
            const size_t tk = (size_t)(s0 + ki * D + r);
            st[kt][0] = (f32x4){0.f, 0.f, 0.f, 0.f}; st[kt][1] = (f32x4){0.f, 0.f, 0.f, 0.f};
#pragma unroll
            for (int kb = 0; kb < 4; ++kb) { const bf16x8 kfr = *(const bf16x8*)(CK + tk * 1536 + hc * 128 + kb * 32 + fq * 8);
                st[kt][0] = MFMA16(kfr, qf[0][kb], st[kt][0]); st[kt][1] = MFMA16(kfr, qf[1][kb], st[kt][1]); } }
        const float* bt = btab + hc * 129 + 64;
        float mx[2] = {-1e30f, -1e30f};
#pragma unroll
        for (int kt = 0; kt < 10; ++kt)
#pragma unroll
            for (int nq = 0; nq < 2; ++nq)
#pragma unroll
                for (int j = 0; j < 4; ++j) { const int rel = -64 + kt * 16 + fq * 4 + j - nq * 16 - fr, kidx = i0 - 64 + kt * 16 + fq * 4 + j;
                    const bool valid = (rel >= -64) && (rel <= 64) && (kidx >= 0) && (kidx < l);
                    const int rc = rel < -64 ? -64 : (rel > 64 ? 64 : rel);
                    const float s = valid ? st[kt][nq][j] * 0.08838834764831845f + bt[rc] : -1e30f;
                    st[kt][nq][j] = s; mx[nq] = fmaxf(mx[nq], s); }
        float sm[2];
#pragma unroll
        for (int nq = 0; nq < 2; ++nq) { mx[nq] = fmaxf(mx[nq], __shfl_xor(mx[nq], 16)); mx[nq] = fmaxf(mx[nq], __shfl_xor(mx[nq], 32)); sm[nq] = 0.f; }
#pragma unroll
        for (int kt = 0; kt < 10; ++kt)
#pragma unroll
            for (int nq = 0; nq < 2; ++nq)
#pragma unroll
                for (int j = 0; j < 4; ++j) { const float e = __expf(st[kt][nq][j] - mx[nq]); st[kt][nq][j] = e; sm[nq] += e; }
#pragma unroll
        for (int nq = 0; nq < 2; ++nq) { sm[nq] += __shfl_xor(sm[nq], 16); sm[nq] += __shfl_xor(sm[nq], 32); }
        bf16x8 Pb[5][2];
#pragma unroll
        for (int kb = 0; kb < 5; ++kb) { Pb[kb][0] = pack8(st[2 * kb][0], st[2 * kb + 1][0]); Pb[kb][1] = pack8(st[2 * kb][1], st[2 * kb + 1][1]); }
        f32x4 ot[8][2];
#pragma unroll
        for (int dt = 0; dt < 8; ++dt) { ot[dt][0] = (f32x4){0.f, 0.f, 0.f, 0.f}; ot[dt][1] = (f32x4){0.f, 0.f, 0.f, 0.f}; }
        const bf16_t* vtg = VT + (size_t)g * 512 * VTLD + (size_t)(hq * 128 + fr) * VTLD + 128 + col0 - 64 + fq * 4;
#pragma unroll
        for (int kb = 0; kb < 5; ++kb) {
#pragma unroll
            for (int dt = 0; dt < 8; ++dt) { const bf16_t* vp = vtg + (size_t)dt * 16 * VTLD + kb * 32;
                const bf16x8 va = mk8(*(const u32x2*)vp, *(const u32x2*)(vp + 16));
                ot[dt][0] = MFMA16(va, Pb[kb][0], ot[dt][0]); ot[dt][1] = MFMA16(va, Pb[kb][1], ot[dt][1]); } }
#pragma unroll
        for (int nq = 0; nq < 2; ++nq) { const size_t tq = (size_t)(s0 + (i0 + nq * 16 + fr) * D + r); const float inv = 1.0f / sm[nq];
            bf16_t* op = OG + (size_t)g * T_ * 512 + tq * 512 + hq * 128 + fq * 4;
#pragma unroll
            for (int dt = 0; dt < 8; ++dt) { u32x2 o; o.x = pk2(ot[dt][nq][0] * inv, ot[dt][nq][1] * inv); o.y = pk2(ot[dt][nq][2] * inv, ot[dt][nq][3] * inv); *(u32x2*)(op + dt * 16) = o; }
            if (fq == 0) LSE[(size_t)g * T_ * 4 + tq * 4 + hq] = mx[nq] + __logf(sm[nq]); }
    }
}

__device__ void post_phase(const Params& p, int L) {
    const int tid = tid_l(), lane = tid & 63, gw = bid_l() * 8 + (tid >> 6), nw = gridDim.x * 8;
    unsigned char* ws = p.ws;
    const float* OF = (const float*)(ws + O_OFWD); const float* OB = (const float*)(ws + O_OBWD); const bf16_t* Z = (const bf16_t*)(ws + O_SZ);
    bf16_t* YA = (bf16_t*)(ws + O_YA); bf16_t* YC = (bf16_t*)(ws + O_YC); const bf16_t* OG = (const bf16_t*)(ws + O_OG); const float* LSE = (const float*)(ws + O_LSE);
    const float* hn = p.head_norm + L * 128 + (lane & 7) * 16;
    for (int t = gw; t < T_; t += nw) {
        float o[16]; float ss = 0.f;
#pragma unroll
        for (int i = 0; i < 4; ++i) { const float4 a = *(const float4*)(OF + (size_t)t * 1024 + lane * 16 + i * 4), b = *(const float4*)(OB + (size_t)t * 1024 + lane * 16 + i * 4);
            o[4 * i] = a.x + b.x; o[4 * i + 1] = a.y + b.y; o[4 * i + 2] = a.z + b.z; o[4 * i + 3] = a.w + b.w; }
#pragma unroll
        for (int i = 0; i < 16; ++i) ss += o[i] * o[i];
        ss += __shfl_xor(ss, 1); ss += __shfl_xor(ss, 2); ss += __shfl_xor(ss, 4);
        const float rstd = rsqrtf(ss * (1.0f / 128.0f) + 1e-6f);
        const u32x4 z0 = *(const u32x4*)(Z + (size_t)t * 1024 + lane * 16), z1 = *(const u32x4*)(Z + (size_t)t * 1024 + lane * 16 + 8);
        const unsigned zz[8] = {z0.x, z0.y, z0.z, z0.w, z1.x, z1.y, z1.z, z1.w};
        unsigned w[8];
#pragma unroll
        for (int i = 0; i < 8; ++i) { const float a = o[2 * i] * rstd * hn[2 * i] * siluf_(bflo(zz[i])), b = o[2 * i + 1] * rstd * hn[2 * i + 1] * siluf_(bfhi(zz[i])); w[i] = pk2(a, b); }
        u32x4 a, b; a.x = w[0]; a.y = w[1]; a.z = w[2]; a.w = w[3]; b.x = w[4]; b.y = w[5]; b.z = w[6]; b.w = w[7];
        *(u32x4*)(YA + (size_t)t * 1024 + lane * 16) = a; *(u32x4*)(YA + (size_t)t * 1024 + lane * 16 + 8) = b;
        const int hq = lane >> 4;
        const float l0 = LSE[(size_t)t * 4 + hq], l1 = LSE[(size_t)T_ * 4 + (size_t)t * 4 + hq], l2 = LSE[(size_t)2 * T_ * 4 + (size_t)t * 4 + hq];
        const float m = fmaxf(l0, fmaxf(l1, l2)); float a0 = __expf(l0 - m), a1 = __expf(l1 - m), a2 = __expf(l2 - m); const float inv = 1.0f / (a0 + a1 + a2); a0 *= inv; a1 *= inv; a2 *= inv;
        const u32x4 g0 = *(const u32x4*)(OG + (size_t)t * 512 + lane * 8), g1 = *(const u32x4*)(OG + (size_t)T_ * 512 + (size_t)t * 512 + lane * 8), g2 = *(const u32x4*)(OG + (size_t)2 * T_ * 512 + (size_t)t * 512 + lane * 8);
        u32x4 yo;
        yo.x = pk2(a0 * bflo(g0.x) + a1 * bflo(g1.x) + a2 * bflo(g2.x), a0 * bfhi(g0.x) + a1 * bfhi(g1.x) + a2 * bfhi(g2.x));
        yo.y = pk2(a0 * bflo(g0.y) + a1 * bflo(g1.y) + a2 * bflo(g2.y), a0 * bfhi(g0.y) + a1 * bfhi(g1.y) + a2 * bfhi(g2.y));
        yo.z = pk2(a0 * bflo(g0.z) + a1 * bflo(g1.z) + a2 * bflo(g2.z), a0 * bfhi(g0.z) + a1 * bfhi(g1.z) + a2 * bfhi(g2.z));
        yo.w = pk2(a0 * bflo(g0.w) + a1 * bflo(g1.w) + a2 * bflo(g2.w), a0 * bfhi(g0.w) + a1 * bfhi(g1.w) + a2 * bfhi(g2.w));
        *(u32x4*)(YC + (size_t)t * 512 + lane * 8) = yo;
    }
}

constexpr int NPHASE = 23;
__device__ __forceinline__ void do_phase(const Params& p, int ph, unsigned char* smem) {
    unsigned char* ws = p.ws;
    if (ph == 22) { norm_rows(p, 2, p.norm_final, nullptr); return; }
    const int L = ph / 11, k = ph - L * 11;
    switch (k) {
    case 0: {
        float* tile = (float*)smem;
        conv_tiles(p.w_in + (size_t)L * DM * 17952, DM, 17952, 281, (bf16_t*)(ws + O_WT_IN), 1, tile);
        conv_tiles(p.w_up + (size_t)L * DM * DFF, DM, DFF, 128, (bf16_t*)(ws + O_WT_UP), 0, tile);
        conv_tiles(p.w_down + (size_t)L * DFF * DM, DFF, DM, 32, (bf16_t*)(ws + O_WT_DOWN), 0, tile);
        conv_tiles(p.w_out + (size_t)L * DM * DM, DM, DM, 32, (bf16_t*)(ws + O_WT_OUT), 0, tile);
        conv_tiles(p.w_br_a + (size_t)L * 1024 * DM, 1024, DM, 32, (bf16_t*)(ws + O_WT_BRA), 0, tile);
        conv_tiles(p.w_br_b + (size_t)L * 1024 * DM, 1024, DM, 32, (bf16_t*)(ws + O_WT_BRB), 0, tile);
        conv_tiles(p.w_br_c + (size_t)L * 512 * DM, 512, DM, 32, (bf16_t*)(ws + O_WT_BRC), 0, tile);
        norm_rows(p, L == 0 ? 0 : 1, p.norm_mix + L * DM, (bf16_t*)(ws + O_XN));
    } break;
    case 1: { EpiProj E; E.ws = ws; run_gemm(smem, (const bf16_t*)(ws + O_XN), (const bf16_t*)(ws + O_WT_IN), T_, NPROJ, DM, E); } break;
    case 2: prep_phase(p, L, smem); break;
    case 3: gdn_local(p, smem); break;
    case 4: {
        const int bid = bid_l();
        if (bid < 96) gdn_scan(p, smem, bid);
        else attn_phase(p, smem, bid - 96, ((int)gridDim.x - 96) * 8);
    } break;
    case 5: post_phase(p, L); break;
    case 6: {
        EpiBranch E; E.macc = (float*)(ws + O_MACC); E.merged = (bf16_t*)(ws + O_XN); E.gates = (const bf16_t*)(ws + O_GATES);
        for (int b = 0; b < 3; ++b) { E.goff = b * DM; E.mode = b;
            const bf16_t* A = (const bf16_t*)(ws + (b == 0 ? O_YA : (b == 1 ? O_YB : O_YC))); const bf16_t* Bt = (const bf16_t*)(ws + (b == 0 ? O_WT_BRA : (b == 1 ? O_WT_BRB : O_WT_BRC)));
            run_gemm(smem, A, Bt, T_, DM, b == 2 ? 512 : 1024, E); }
    } break;
    case 7: { EpiResid E; E.C = p.out; run_gemm(smem, (const bf16_t*)(ws + O_XN), (const bf16_t*)(ws + O_WT_OUT), T_, DM, DM, E); } break;
    case 8: norm_rows(p, 1, p.norm_mlp + L * DM, (bf16_t*)(ws + O_XN)); break;
    case 9: { EpiUp E; E.O = (bf16_t*)(ws + O_HID); run_gemm(smem, (const bf16_t*)(ws + O_XN), (const bf16_t*)(ws + O_WT_UP), T_, DFF, DM, E); } break;
    case 10: { EpiResid E; E.C = p.out; run_gemm(smem, (const bf16_t*)(ws + O_HID), (const bf16_t*)(ws + O_WT_DOWN), T_, DM, DFF, E); } break;
    }
}

__device__ __forceinline__ Params load_params() {
    Params q{};
#if defined(__HIP_DEVICE_COMPILE__)
    typedef const __attribute__((address_space(4))) unsigned long long* KP;
    KP kp = (KP)__builtin_amdgcn_kernarg_segment_ptr(); asm volatile("" : "+s"(kp));
    q.x_prompt = (const float*)kp[0]; q.x_sample = (const float*)kp[1]; q.rel_bias = (const float*)kp[2]; q.norm_mix = (const float*)kp[3]; q.w_in = (const float*)kp[4];
    q.conv_a = (const float*)kp[5]; q.a_log = (const float*)kp[6]; q.dt_bias = (const float*)kp[7]; q.head_norm = (const float*)kp[8]; q.conv_b = (const float*)kp[9];
    q.w_br_a = (const float*)kp[10]; q.w_br_b = (const float*)kp[11]; q.w_br_c = (const float*)kp[12]; q.w_out = (const float*)kp[13]; q.norm_mlp = (const float*)kp[14];
    q.w_up = (const float*)kp[15]; q.w_down = (const float*)kp[16]; q.norm_final = (const float*)kp[17]; q.out = (float*)kp[18]; q.ws = (unsigned char*)kp[19];
#endif
    return q;
}
template <int PH> __device__ __forceinline__ void phase_sync(unsigned char* smem, cg::grid_group& grid) { { const Params q = load_params(); do_phase(q, PH, smem); } if (PH + 1 < NPHASE) grid.sync(); }
#if MEGA
__global__ __launch_bounds__(512, 2) void k_mega(Params p) {
    extern __shared__ __attribute__((aligned(16))) unsigned char smem[];
    cg::grid_group grid = cg::this_grid();
    phase_sync<0>(smem, grid); phase_sync<1>(smem, grid); phase_sync<2>(smem, grid); phase_sync<3>(smem, grid); phase_sync<4>(smem, grid); phase_sync<5>(smem, grid);
    phase_sync<6>(smem, grid); phase_sync<7>(smem, grid); phase_sync<8>(smem, grid); phase_sync<9>(smem, grid); phase_sync<10>(smem, grid); phase_sync<11>(smem, grid);
    phase_sync<12>(smem, grid); phase_sync<13>(smem, grid); phase_sync<14>(smem, grid); phase_sync<15>(smem, grid); phase_sync<16>(smem, grid); phase_sync<17>(smem, grid);
    phase_sync<18>(smem, grid); phase_sync<19>(smem, grid); phase_sync<20>(smem, grid); phase_sync<21>(smem, grid); phase_sync<22>(smem, grid);
}
#else
template <int PH> __global__ __launch_bounds__(512, 2) void k_ph(Params p) {
    extern __shared__ __attribute__((aligned(16))) unsigned char smem[];
    const Params q = load_params(); do_phase(q, PH, smem);
}
template <int PH> static void launch_ph(const Params& p, hipStream_t stream) {
    (void)hipFuncSetAttribute((const void*)k_ph<PH>, hipFuncAttributeMaxDynamicSharedMemorySize, (int)LDS_BYTES);
    k_ph<PH><<<256, 512, LDS_BYTES, stream>>>(p);
}
#endif

extern "C" void kernel_launch(void* const* d_in, const int* in_sizes, int n_in, void* d_out, int out_size, void* d_ws, size_t ws_size, hipStream_t stream) {
    Params p{};
    p.x_prompt = (const float*)d_in[0]; p.x_sample = (const float*)d_in[1]; p.rel_bias = (const float*)d_in[2]; p.norm_mix = (const float*)d_in[3]; p.w_in = (const float*)d_in[4];
    p.conv_a = (const float*)d_in[5]; p.a_log = (const float*)d_in[6]; p.dt_bias = (const float*)d_in[7]; p.head_norm = (const float*)d_in[8]; p.conv_b = (const float*)d_in[9];
    p.w_br_a = (const float*)d_in[10]; p.w_br_b = (const float*)d_in[11]; p.w_br_c = (const float*)d_in[12]; p.w_out = (const float*)d_in[13]; p.norm_mlp = (const float*)d_in[14];
    p.w_up = (const float*)d_in[15]; p.w_down = (const float*)d_in[16]; p.norm_final = (const float*)d_in[17]; p.out = (float*)d_out; p.ws = (unsigned char*)d_ws;
    if (ws_size < WS_NEED) { fprintf(stderr, "workspace too small: %zu < %zu\n", ws_size, (size_t)WS_NEED); return; }
#if MEGA
    static int grid_blocks = 0;
    if (!grid_blocks) { int dev = 0, cus = 0, per_cu = 0; (void)hipGetDevice(&dev); (void)hipDeviceGetAttribute(&cus, hipDeviceAttributeMultiprocessorCount, dev);
        (void)hipFuncSetAttribute((const void*)k_mega, hipFuncAttributeMaxDynamicSharedMemorySize, (int)LDS_BYTES);
        (void)hipOccupancyMaxActiveBlocksPerMultiprocessor(&per_cu, k_mega, 512, LDS_BYTES);
        if (per_cu < 1) per_cu = 1;
        grid_blocks = cus * per_cu; if (grid_blocks > 256) grid_blocks = 256; }
    void* args[] = {&p};
    hipError_t e = hipLaunchCooperativeKernel((const void*)k_mega, dim3(grid_blocks), dim3(512), args, LDS_BYTES, stream);
    if (e != hipSuccess) fprintf(stderr, "cooperative launch failed: %s (grid %d)\n", hipGetErrorString(e), grid_blocks);
#else
    launch_ph<0>(p, stream); launch_ph<1>(p, stream); launch_ph<2>(p, stream); launch_ph<3>(p, stream); launch_ph<4>(p, stream); launch_ph<5>(p, stream);
    launch_ph<6>(p, stream); launch_ph<7>(p, stream); launch_ph<8>(p, stream); launch_ph<9>(p, stream); launch_ph<10>(p, stream); launch_ph<11>(p, stream);
    launch_ph<12>(p, stream); launch_ph<13>(p, stream); launch_ph<14>(p, stream); launch_ph<15>(p, stream); launch_ph<16>(p, stream); launch_ph<17>(p, stream);
    launch_ph<18>(p, stream); launch_ph<19>(p, stream); launch_ph<20>(p, stream); launch_ph<21>(p, stream); launch_ph<22>(p, stream);
#endif
}
```

```cpp
#include <cstdio>
#define MEGA 1
#define DUP_MASK 0
#define SCAN_REP 1
#include <hip/hip_runtime.h>
namespace pg8 {
#define PG8_LAS __attribute__((address_space(3)))
typedef unsigned short bf16_t;
typedef short bf16x8 __attribute__((ext_vector_type(8)));
typedef float f32x4 __attribute__((ext_vector_type(4)));
typedef unsigned u32x4 __attribute__((ext_vector_type(4)));
constexpr int BM = 256, BK = 64, HALF = 128, HTB = HALF * BK * 2  , STAGE_BYTES = 8 * HTB, NXCD = 8, WGM = 8;

__host__ __device__ __forceinline__ int lds_byte(int r, int c) { const int st = (r >> 4) * 2 + (c >> 5), rr = r & 15, cc = c & 31, ob = rr * 64 + cc * 2; return st * 1024 + (ob ^ (((ob >> 9) & 1) << 5)); }
__host__ __device__ __forceinline__ void stage_rc(int b, int& R, int& C) { const int st = b / 1024, sb = b % 1024, swz = sb ^ (((sb >> 9) & 1) << 5); R = (st >> 1) * 16 + swz / 64; C = (st & 1) * 32 + (swz % 64) / 2; }
__host__ __device__ __forceinline__ int perm32(int rho) { const int n = rho >> 4, i = rho & 15; return 8 * (i >> 2) + 4 * n + (i & 3); }

struct Unit { int pm, pn; };
struct Gemm { const bf16_t* A; const bf16_t* Bt; int M, N, K; };
struct StaticOrder {
    int nM, nN, nwg, G, c;
    __host__ __device__ void init(int M, int N, int G_, int c_) { nM = M / BM; nN = N / BM; nwg = nM * nN; G = G_; c = c_; }
    __host__ __device__ bool next(int i, Unit& u) const {
        const long L = (long)i * G + c; if (L >= nwg) return false;
        int wgid = (int)L; { const int q = nwg / NXCD, r = nwg % NXCD, xcd = wgid % NXCD, off = wgid / NXCD; wgid = (xcd < r ? xcd * (q + 1) : r * (q + 1) + (xcd - r) * q) + off; }
        const int nig = WGM * nN, gid = wgid / nig, fm = gid * WGM, gsz = (nM - fm) < WGM ? (nM - fm) : WGM;
        u.pm = fm + ((wgid % nig) % gsz); u.pn = (wgid % nig) / gsz; return true;
    }
    __device__ __forceinline__ void a_ready(const Unit&) const {}
    __device__ __forceinline__ void done(const Unit&) const {}
};
__device__ __forceinline__ unsigned cvt_pk_bf16(float lo, float hi) { unsigned r; asm volatile("v_cvt_pk_bf16_f32 %0, %1, %2" : "=v"(r) : "v"(lo), "v"(hi)); return r; }

template <class Epi, class Sched, bool STAMP = false>
__device__ __forceinline__ void gemm_phase(PG8_LAS unsigned char* lds, const Gemm g, const Sched& S, const Epi& E, unsigned long long* stamps) {
    int tid_ = threadIdx.x; asm volatile("" : "+v"(tid_)); const int tid = tid_, wid = __builtin_amdgcn_readfirstlane(tid >> 6), lane = tid & 63, wr = wid >> 2, wc = wid & 3, fr = lane & 15, fq = lane >> 4;
    const int K = g.K, nt = K / BK;
    int ts_lo = 0, ts_hi = 0, nts = 0; const unsigned long long rt_entry = STAMP ? (unsigned long long)wall_clock64() : 0ull;
#define PG8_STAMP() do { if (STAMP && wid == 0 && nts < 64) { const unsigned long long _c = (unsigned long long)clock64(); \
        ts_lo = (lane == nts) ? (int)(unsigned)_c : ts_lo; ts_hi = (lane == nts) ? (int)(unsigned)(_c >> 32) : ts_hi; ++nts; } } while (0)
    PG8_STAMP();
    unsigned voffA[2], voffB[2], voffB1[2];
#pragma unroll
    for (int i = 0; i < 2; ++i) { int R, C; stage_rc(tid * 16 + i * 8192, R, C); const int Rb = Epi::PERM ? ((R & ~31) + perm32(R & 31)) : R;
        voffA[i] = (unsigned)(R * K + C) * 2u;
        if (Epi::PERM) { const int base = 64 * (R >> 5) + 16 * ((R & 15) >> 2) + 4 * ((R >> 4) & 1) + (R & 3); voffB[i] = (unsigned)(base * K + C) * 2u; voffB1[i] = (unsigned)((base + 8) * K + C) * 2u; }
        else { voffB[i] = (unsigned)(Rb * K + C) * 2u; voffB1[i] = voffB[i]; } }
    const size_t bh1 = Epi::PERM ? (size_t)0 : (size_t)HALF * K * 2;
    const size_t kstep = (size_t)(BK * 2);
    const size_t hstep = (size_t)HALF * K * 2;
    const size_t tstep = 2 * hstep;
    const unsigned ldsw = (unsigned)wid * 1024u;
    const int aoff = lds_byte(wr * 64 + fr, fq * 8), boff = lds_byte(wc * 32 + fr, fq * 8);
#define PG8_SA(b, h) (((b) * 2 + (h)) * HTB)
#define PG8_SB(b, h) ((4 + (b) * 2 + (h)) * HTB)
#define PG8_STAGE(bufoff, gbase, voff) do { _Pragma("unroll") for (int _i = 0; _i < 2; ++_i) \
        __builtin_amdgcn_global_load_lds((const unsigned*)((const char*)(gbase) + (voff)[_i]), (PG8_LAS unsigned*)(lds + (bufoff) + ldsw + _i * 8192), 16, 0, 0); } while (0)
#define PG8_LDA(dst, b, h) do { _Pragma("unroll") for (int m = 0; m < 4; ++m) _Pragma("unroll") for (int k = 0; k < 2; ++k) dst[m][k] = *(const PG8_LAS bf16x8*)(lds + PG8_SA(b, h) + aoff + m * 2048 + k * 1024); } while (0)
#define PG8_LDB(dst, b, h) do { _Pragma("unroll") for (int n = 0; n < 2; ++n) _Pragma("unroll") for (int k = 0; k < 2; ++k) dst[n][k] = *(const PG8_LAS bf16x8*)(lds + PG8_SB(b, h) + boff + n * 2048 + k * 1024); } while (0)
#define PG8_MMA(ai, bj, At, Bt) do { __builtin_amdgcn_s_setprio(1); _Pragma("unroll") for (int m = 0; m < 4; ++m) _Pragma("unroll") for (int n = 0; n < 2; ++n) _Pragma("unroll") for (int k = 0; k < 2; ++k) \
        acc[ai][bj][m][n] = __builtin_amdgcn_mfma_f32_16x16x32_bf16(Bt[n][k], At[m][k], acc[ai][bj][m][n], 0, 0, 0); __builtin_amdgcn_s_setprio(0); } while (0)
#define PG8_WAIT_V(n) asm volatile("s_waitcnt vmcnt(" #n ")" ::: "memory")
#define PG8_WAIT_L(n) asm volatile("s_waitcnt lgkmcnt(" #n ")" ::: "memory")
#define PG8_BAR __builtin_amdgcn_s_barrier()
#define PG8_SCHED __builtin_amdgcn_sched_barrier(0)
    Unit cur, nxt; int ui = 0;
    if (!S.next(0, cur)) return;
    f32x4 acc[2][2][4][2];
#pragma unroll
    for (int a = 0; a < 2; ++a)
#pragma unroll
        for (int b = 0; b < 2; ++b)
#pragma unroll
            for (int m = 0; m < 4; ++m)
#pragma unroll
                for (int n = 0; n < 2; ++n) acc[a][b][m][n] = (f32x4){0.f, 0.f, 0.f, 0.f};
    bf16x8 At[4][2], B0[2][2], B1[2][2];
    const char* cA = (const char*)g.A + (size_t)cur.pm * tstep; const char* cB = (const char*)g.Bt + (size_t)cur.pn * tstep;
    S.a_ready(cur);
    PG8_STAGE(PG8_SB(0, 0), cB, voffB); PG8_STAGE(PG8_SA(0, 0), cA, voffA); PG8_STAGE(PG8_SB(0, 1), cB + bh1, voffB1); PG8_STAGE(PG8_SA(0, 1), cA + hstep, voffA);
    if (wr == 1) PG8_BAR;
    PG8_WAIT_V(4); PG8_BAR;
    PG8_STAGE(PG8_SB(1, 0), cB + kstep, voffB); PG8_STAGE(PG8_SA(1, 0), cA + kstep, voffA); PG8_STAGE(PG8_SB(1, 1), cB + bh1 + kstep, voffB1);
    PG8_WAIT_V(6); PG8_BAR;
    PG8_STAMP();
    for (;;) {
        const bool has_next = S.next(ui + 1, nxt);
        const char* nA = has_next ? (const char*)g.A + (size_t)nxt.pm * tstep : cA; const char* nB = has_next ? (const char*)g.Bt + (size_t)nxt.pn * tstep : cB;
        for (int t = 0; t < nt; t += 2) {
            const bool last = (t == nt - 2);
            const char* a1 = cA + (size_t)(t + 1) * kstep;
            const char* a2 = last ? nA : cA + (size_t)(t + 2) * kstep; const char* b2 = last ? nB : cB + (size_t)(t + 2) * kstep;
            const char* a3 = a2 + kstep; const char* b3 = b2 + kstep;
            if (last && has_next) S.a_ready(nxt);
            PG8_LDB(B0, 0, 0); PG8_SCHED; PG8_LDA(At, 0, 0); PG8_STAGE(PG8_SA(1, 1), a1 + hstep, voffA);
            PG8_WAIT_L(8); PG8_BAR; PG8_WAIT_L(0); PG8_MMA(0, 0, At, B0); PG8_BAR; PG8_SCHED;
            PG8_LDB(B1, 0, 1); PG8_STAGE(PG8_SB(0, 0), b2, voffB);
            PG8_BAR; PG8_WAIT_L(0); PG8_MMA(0, 1, At, B1); PG8_BAR;
            PG8_LDA(At, 0, 1); PG8_STAGE(PG8_SA(0, 0), a2, voffA);
            PG8_BAR; PG8_WAIT_L(0); PG8_MMA(1, 0, At, B0); PG8_BAR; PG8_SCHED;
            PG8_STAGE(PG8_SB(0, 1), b2 + bh1, voffB1);
            PG8_WAIT_V(6); PG8_BAR; PG8_MMA(1, 1, At, B1); PG8_BAR;
            PG8_LDB(B0, 1, 0); PG8_SCHED; PG8_LDA(At, 1, 0); PG8_STAGE(PG8_SA(0, 1), a2 + hstep, voffA);
            PG8_WAIT_L(8); PG8_BAR; PG8_WAIT_L(0); PG8_MMA(0, 0, At, B0); PG8_BAR; PG8_SCHED;
            PG8_LDB(B1, 1, 1); PG8_STAGE(PG8_SB(1, 0), b3, voffB);
            PG8_BAR; PG8_WAIT_L(0); PG8_MMA(0, 1, At, B1); PG8_BAR;
            PG8_LDA(At, 1, 1); PG8_STAGE(PG8_SA(1, 0), a3, voffA);
            PG8_BAR; PG8_WAIT_L(0); PG8_MMA(1, 0, At, B0); PG8_BAR; PG8_SCHED;
            PG8_STAGE(PG8_SB(1, 1), b3 + bh1, voffB1);
            PG8_WAIT_V(6); PG8_BAR; PG8_MMA(1, 1, At, B1); PG8_BAR;
        }
        PG8_STAMP();
        if constexpr (!Epi::AFTER_DRAIN) { E(acc, cur, wr, wc, fr, fq); S.done(cur); }
        PG8_STAMP();
        if (!has_next) break;
#pragma unroll
        for (int a = 0; a < 2; ++a)
#pragma unroll
            for (int b = 0; b < 2; ++b)
#pragma unroll
                for (int m = 0; m < 4; ++m)
#pragma unroll
                    for (int n = 0; n < 2; ++n) acc[a][b][m][n] = (f32x4){0.f, 0.f, 0.f, 0.f};
        cur = nxt; cA = nA; cB = nB; ++ui;
    }
    PG8_WAIT_V(0);
    if (wr == 0) PG8_BAR;
    PG8_BAR;
    if constexpr (Epi::AFTER_DRAIN) { E.fused(acc, cur, wr, wc, fr, fq, lds, wid, lane); S.done(cur); }
    PG8_STAMP();
    if (STAMP && wid == 0) { stamps[lane] = lane < nts ? (((unsigned long long)(unsigned)ts_hi << 32) | (unsigned)ts_lo) : 0ull;
        if (lane == 62) stamps[62] = rt_entry; if (lane == 63) stamps[63] = (unsigned long long)wall_clock64(); }
#undef PG8_STAMP
#undef PG8_SA
#undef PG8_SB
#undef PG8_STAGE
#undef PG8_LDA
#undef PG8_LDB
#undef PG8_MMA
#undef PG8_WAIT_V
#undef PG8_WAIT_L
#undef PG8_BAR
#undef PG8_SCHED
}
}

#define XB_TMO      128
#define XB_XCNT(j)  (256  + 64 * (j))
#define XB_XSUB(j)  (1280 + 64 * (j))
#define XB_XGEN(j)  (2304 + 64 * (j))
#define XB_TOP      3328
#define XB_TOPGEN   3392
#define XCD_BAR_WORDS 3456
#define XB_SPIN_CAP (1u << 18)
#define LAS __attribute__((address_space(3)))

__device__ __forceinline__ unsigned xb_ld(unsigned* p)              { return __hip_atomic_load(p, __ATOMIC_RELAXED, __HIP_MEMORY_SCOPE_AGENT); }
__device__ __forceinline__ unsigned xb_add(unsigned* p, unsigned v) { return __hip_atomic_fetch_add(p, v, __ATOMIC_RELAXED, __HIP_MEMORY_SCOPE_AGENT); }
__device__ __forceinline__ unsigned xb_xcc_id() { return (unsigned)__builtin_amdgcn_s_getreg((3 << 11) | 20) & 0xFu; }
#define XB_SPIN(cond, bar) do { unsigned _sp = 0; while (cond) { __builtin_amdgcn_s_sleep(1); \
    if ((++_sp & 255u) == 0u) { if (xb_ld(&(bar)[XB_TMO])) break; if (_sp > XB_SPIN_CAP) { atomicAdd(&(bar)[XB_TMO], 1u); break; } } } } while (0)

struct XcdBarrier {
    unsigned* bar; unsigned x;
    volatile LAS unsigned* st;
};

__device__ __forceinline__ XcdBarrier xcd_barrier_post(unsigned* bar, volatile LAS unsigned* st) {
    XcdBarrier b; b.bar = bar; b.x = xb_xcc_id(); b.st = st;
    if (threadIdx.x == 0) (void)xb_add(&bar[XB_XCNT(b.x)], 1u);
    return b;
}
__device__ __forceinline__ void xcd_barrier_complete(unsigned* bar, unsigned x, unsigned& nloc, unsigned& nx) {
    const unsigned G = gridDim.x * gridDim.y * gridDim.z;
    unsigned sum, cnt, mine, sp = 0u;
    for (;;) {
        sum = 0u; cnt = 0u; mine = 0u;
#pragma unroll
        for (unsigned j = 0; j < 16; ++j) { const unsigned c = xb_ld(&bar[XB_XCNT(j)]); sum += c; cnt += (c > 0u) ? 1u : 0u; mine = (j == x) ? c : mine; }
        if (sum == G) break;
        __builtin_amdgcn_s_sleep(1);
        if ((++sp & 255u) == 0u) { if (xb_ld(&bar[XB_TMO])) break; if (sp > XB_SPIN_CAP) { atomicAdd(&bar[XB_TMO], 1u); break; } }
    }
    nloc = mine > 0u ? mine : 1u; nx = cnt > 0u ? cnt : 1u;
}

__device__ __forceinline__ void xcd_barrier(const XcdBarrier& b) {
    asm volatile("s_waitcnt vmcnt(0)" ::: "memory");
    __syncthreads();
    if (threadIdx.x == 0) {
        unsigned* bar = b.bar;
        __builtin_amdgcn_s_waitcnt(0);
        unsigned nloc = b.st[0], nx = b.st[1];
        if (nloc == 0u) { xcd_barrier_complete(bar, b.x, nloc, nx); b.st[0] = nloc; b.st[1] = nx; }
        const unsigned old = xb_add(&bar[XB_XSUB(b.x)], 1u);
        const unsigned gen = old / nloc;
        if (old + 1u == (gen + 1u) * nloc) {
            __builtin_amdgcn_fence(__ATOMIC_RELEASE, "agent");
            asm volatile("s_waitcnt vmcnt(0)" ::: "memory");
            const unsigned og = xb_add(&bar[XB_TOP], 1u);
            const unsigned tg = og / nx;
            if (og + 1u == (tg + 1u) * nx) xb_add(&bar[XB_TOPGEN], 1u);
            else XB_SPIN(xb_ld(&bar[XB_TOPGEN]) == tg, bar);
            __builtin_amdgcn_fence(__ATOMIC_ACQUIRE, "agent");
            xb_add(&bar[XB_XGEN(b.x)], 1u);
            asm volatile("s_waitcnt vmcnt(0)" ::: "memory");
        } else {
            XB_SPIN(xb_ld(&bar[XB_XGEN(b.x)]) == gen, bar);
            __builtin_amdgcn_fence(__ATOMIC_ACQUIRE, "agent");
            asm volatile("s_waitcnt vmcnt(0)" ::: "memory");
        }
    }
    __syncthreads();
}

#include <hip/hip_cooperative_groups.h>
namespace cg = cooperative_groups;
using pg8::bf16_t; using pg8::bf16x8; using pg8::f32x4; using pg8::u32x4;
typedef unsigned u32x2 __attribute__((ext_vector_type(2)));

#ifndef MEGA
#define MEGA 1
#endif

constexpr int T_ = 16384, DM = 2048, NPROJ = 18176, DFF = 8192, VTLD = T_ + 256;
constexpr size_t LDS_BYTES = 139264 + 16;
constexpr size_t LDS_BAR_ST = 139264;

constexpr size_t SZ_WT_IN = (size_t)NPROJ * DM * 2, SZ_WT_UP = (size_t)DFF * DM * 2, SZ_WT_DOWN = SZ_WT_UP, SZ_WT_OUT = (size_t)DM * DM * 2,
                 SZ_WT_BRA = (size_t)DM * 1024 * 2, SZ_WT_BRC = (size_t)DM * 512 * 2;
constexpr size_t O_WT_IN = 0, O_WT_UP = O_WT_IN + SZ_WT_IN, O_WT_DOWN = O_WT_UP + SZ_WT_UP, O_WT_OUT = O_WT_DOWN + SZ_WT_DOWN, O_WT_BRA = O_WT_OUT + SZ_WT_OUT,
                 O_WT_BRB = O_WT_BRA + SZ_WT_BRA, O_WT_BRC = O_WT_BRB + SZ_WT_BRA, O_XN = O_WT_BRC + SZ_WT_BRC;
constexpr size_t O_VT = O_XN;
constexpr size_t O_AQKV = O_XN + (size_t)T_ * DM * 2;
constexpr size_t O_SB = O_AQKV + (size_t)T_ * 3072 * 2;
constexpr size_t O_OFWD = O_AQKV, O_OBWD = O_OFWD + (size_t)T_ * 1024 * 4, O_TINV = O_OBWD + (size_t)T_ * 1024 * 4, O_AIN = O_TINV + (size_t)4096 * 4096 * 2;
constexpr size_t O_MACC = O_OFWD;
constexpr size_t O_SZ = O_SB + (size_t)T_ * 3072 * 2;
constexpr size_t O_CQ = O_SZ + (size_t)T_ * 1024 * 2;
constexpr size_t O_CK = O_CQ + (size_t)T_ * 1536 * 2, O_CV = O_CK + (size_t)T_ * 1536 * 2;
constexpr size_t O_GATES = O_CV + (size_t)T_ * 1536 * 2;
constexpr size_t O_HID = O_CQ;
constexpr size_t O_AB = O_GATES + (size_t)T_ * 6144 * 2;
constexpr size_t O_QKV = O_AB + (size_t)T_ * 32 * 4;
constexpr size_t O_KT = O_QKV + (size_t)T_ * 3072 * 2;
constexpr size_t O_G = O_KT + (size_t)T_ * 1024 * 2;
constexpr size_t O_BETA = O_G + (size_t)T_ * 16 * 4;
constexpr size_t O_YA = O_BETA + (size_t)T_ * 16 * 4;
constexpr size_t O_YB = O_YA + (size_t)T_ * 1024 * 2;
constexpr size_t O_YC = O_YB + (size_t)T_ * 1024 * 2;
constexpr size_t O_GCP = O_YC + (size_t)T_ * 512 * 2;
constexpr size_t O_OG = O_GCP + (size_t)4096 * 64 * 4;
constexpr size_t O_LSE = O_OG + (size_t)3 * T_ * 512 * 2;
constexpr size_t O_BAR = O_LSE + (size_t)3 * T_ * 4 * 4;
constexpr size_t O_QCTR = O_BAR + (size_t)XCD_BAR_WORDS * 4;
constexpr size_t O_SSQ = O_QCTR + 512;
constexpr size_t O_WT_UP1 = O_SSQ + (size_t)5 * T_ * 4, O_WT_DOWN1 = O_WT_UP1 + SZ_WT_UP;
constexpr size_t WS_NEED = O_WT_DOWN1 + SZ_WT_DOWN;
constexpr size_t O_HB2 = O_AQKV;
static_assert((size_t)3 * 512 * VTLD * 2 <= (size_t)T_ * DM * 2, "vT alias");
static_assert(O_AIN + (size_t)4096 * 4096 * 2 <= O_SZ, "alias AQKV|SB");
static_assert(O_HID + (size_t)T_ * DFF * 2 <= O_AB, "alias hidden");
static_assert(WS_NEED < (size_t)1176000000, "workspace");

struct Params {
    const float* x_prompt; const float* x_sample; const float* rel_bias; const float* norm_mix; const float* w_in; const float* conv_a; const float* a_log; const float* dt_bias;
    const float* head_norm; const float* conv_b; const float* w_br_a; const float* w_br_b; const float* w_br_c; const float* w_out; const float* norm_mlp; const float* w_up;
    const float* w_down; const float* norm_final; float* out; unsigned char* ws;
};

__device__ __forceinline__ float bf2f(unsigned short b) { return __uint_as_float(((unsigned)b) << 16); }
__device__ __forceinline__ float bflo(unsigned u) { return __uint_as_float(u << 16); }
__device__ __forceinline__ float bfhi(unsigned u) { return __uint_as_float(u & 0xffff0000u); }
__device__ __forceinline__ unsigned pk2(float lo, float hi) { return pg8::cvt_pk_bf16(lo, hi); }
__device__ __forceinline__ unsigned short f2bf(float f) { return (unsigned short)(pk2(f, 0.f) & 0xffffu); }
__device__ __forceinline__ float sigmoidf_(float x) { return __builtin_amdgcn_rcpf(1.0f + __expf(-x)); }
__device__ __forceinline__ float siluf_(float x) { return x * __builtin_amdgcn_rcpf(1.0f + __expf(-x)); }
__device__ __forceinline__ void seq_of(int t, int& s0, int& L) { if (t < 8192) { s0 = t & ~4095; L = 4096; } else { s0 = t & ~2047; L = 2048; } }
__device__ __forceinline__ bf16x8 mk8(u32x2 a, u32x2 b) { u32x4 w; w.x = a.x; w.y = a.y; w.z = b.x; w.w = b.y; return __builtin_bit_cast(bf16x8, w); }
__device__ __forceinline__ bf16x8 pack8(f32x4 a, f32x4 b) { u32x4 w; w.x = pk2(a[0], a[1]); w.y = pk2(a[2], a[3]); w.z = pk2(b[0], b[1]); w.w = pk2(b[2], b[3]); return __builtin_bit_cast(bf16x8, w); }
__device__ __forceinline__ int tid_l() { int t = threadIdx.x; asm volatile("" : "+v"(t)); return t; }
__device__ __forceinline__ int bid_l() { int b = blockIdx.x; asm volatile("" : "+s"(b)); return b; }
#define MFMA16(a, b, c) __builtin_amdgcn_mfma_f32_16x16x32_bf16((a), (b), (c), 0, 0, 0)
#define LDS_WAIT() asm volatile("s_waitcnt lgkmcnt(0)" ::: "memory")

__device__ void conv_tiles(const float* __restrict__ W, int K, int ldn, int ntn, bf16_t* __restrict__ Wt, int mode, const float* __restrict__ kscale) {
    const int nkt = K >> 5, total = ntn * nkt, tid = tid_l(), lane = tid & 63;
    for (int it = bid_l() * 8 + (tid >> 6); it < total; it += gridDim.x * 8) {
        const int tn = it / nkt, tk = it - tn * nkt, n0 = tn * 64, k0 = tk * 32;
        int src0 = n0, nvalid = 64;
        if (mode == 1) { if (n0 >= 17920) { src0 = 4096; nvalid = 32; } else if (n0 >= 4096) src0 = n0 + 32; }
        if (lane < nvalid) {
            const float* src = W + (size_t)k0 * ldn + src0 + lane;
            float v[32];
#pragma unroll
            for (int j = 0; j < 32; ++j) v[j] = src[(size_t)j * ldn];
            if (kscale) {
#pragma unroll
                for (int j = 0; j < 32; ++j) v[j] *= kscale[k0 + j]; }
            bf16_t* dst = Wt + (size_t)(n0 + lane) * K + k0;
#pragma unroll
            for (int q = 0; q < 4; ++q) { u32x4 w; w.x = pk2(v[8 * q], v[8 * q + 1]); w.y = pk2(v[8 * q + 2], v[8 * q + 3]); w.z = pk2(v[8 * q + 4], v[8 * q + 5]); w.w = pk2(v[8 * q + 6], v[8 * q + 7]);
                *(u32x4*)(dst + 8 * q) = w; }
        }
    }
}

__device__ void conv_queue(const float* __restrict__ W, int K, int ldn, int ntn, bf16_t* __restrict__ Wt, const float* __restrict__ kscale, unsigned* qctr, unsigned char* smem) {
    const int nkt = K >> 5, total = ntn * nkt, nbatch = (total + 63) >> 6, tid = tid_l(), lane = tid & 63, wid = tid >> 6;
    volatile LAS unsigned* slot = (volatile LAS unsigned*)(smem + LDS_BAR_ST) + 2;
    for (;;) {
        __syncthreads();
        if (tid == 0) *slot = __hip_atomic_fetch_add(qctr, 1u, __ATOMIC_RELAXED, __HIP_MEMORY_SCOPE_AGENT);
        __syncthreads();
        const int bi = (int)*slot;
        if (bi >= nbatch) break;
#pragma unroll 1
        for (int sub = 0; sub < 8; ++sub) {
            const int it = bi * 64 + sub * 8 + wid; if (it >= total) break;
            const int tn = it / nkt, tk = it - tn * nkt, n0 = tn * 64, k0 = tk * 32;
            const float* src = W + (size_t)k0 * ldn + n0 + lane;
            float v[32];
#pragma unroll
            for (int j = 0; j < 32; ++j) v[j] = src[(size_t)j * ldn];
            if (kscale) {
#pragma unroll
                for (int j = 0; j < 32; ++j) v[j] *= kscale[k0 + j]; }
            bf16_t* dst = Wt + (size_t)(n0 + lane) * K + k0;
#pragma unroll
            for (int q = 0; q < 4; ++q) { u32x4 w; w.x = pk2(v[8 * q], v[8 * q + 1]); w.y = pk2(v[8 * q + 2], v[8 * q + 3]); w.z = pk2(v[8 * q + 4], v[8 * q + 5]); w.w = pk2(v[8 * q + 6], v[8 * q + 7]);
                *(u32x4*)(dst + 8 * q) = w; }
        }
    }
}

__device__ void norm_rows(const Params& p, int mode, const float* __restrict__ w, bf16_t* __restrict__ hb) {
    const int tid = tid_l(), lane = tid & 63, gw = bid_l() * 8 + (tid >> 6), nw = gridDim.x * 8;
    float* ssq = (float*)(p.ws + O_SSQ);
    for (int t = gw; t < T_; t += nw) {
        const float* src = (mode == 0) ? (t < 8192 ? p.x_prompt + (size_t)t * DM : p.x_sample + (size_t)(t - 8192) * DM) : p.out + (size_t)t * DM;
        float4 v[8];
#pragma unroll
        for (int i = 0; i < 8; ++i) v[i] = *(const float4*)(src + i * 256 + lane * 4);
        if (mode == 0) {
            float ss = 0.f;
#pragma unroll
            for (int i = 0; i < 8; ++i) ss += v[i].x * v[i].x + v[i].y * v[i].y + v[i].z * v[i].z + v[i].w * v[i].w;
#pragma unroll
            for (int off = 32; off > 0; off >>= 1) ss += __shfl_xor(ss, off);
            if (lane < 5) ssq[(size_t)lane * T_ + t] = (lane == 0) ? ss : 0.f;
#pragma unroll
            for (int i = 0; i < 8; ++i) { u32x2 o; o.x = pk2(v[i].x, v[i].y); o.y = pk2(v[i].z, v[i].w); *(u32x2*)(hb + (size_t)t * DM + i * 256 + lane * 4) = o;
 }
        } else {
            const float rstd = rsqrtf(ssq[(size_t)4 * T_ + t] * (1.0f / DM) + 1e-6f);
#pragma unroll
            for (int i = 0; i < 8; ++i) { const float4 wv = *(const float4*)(w + i * 256 + lane * 4);
                *(float4*)(p.out + (size_t)t * DM + i * 256 + lane * 4) = make_float4(v[i].x * rstd * wv.x, v[i].y * rstd * wv.y, v[i].z * rstd * wv.z, v[i].w * rstd * wv.w); }
        }
    }
}

struct EpiProj {
    static constexpr bool PERM = true, AFTER_DRAIN = false;
    unsigned char* ws; const float* ssq;
    __device__ __forceinline__ void operator()(const f32x4 (&acc)[2][2][4][2], const pg8::Unit& u, int wr, int wc, int fr, int fq) const {
        const int pn = u.pn, row0 = u.pm * 256 + wr * 64 + fr;
        float rs[2][4];
#pragma unroll
        for (int ai = 0; ai < 2; ++ai)
#pragma unroll
            for (int m = 0; m < 4; ++m) rs[ai][m] = rsqrtf(ssq[row0 + ai * 128 + m * 16] * (1.0f / DM) + 1e-6f);
        if (pn == 70) {
            if (wc == 0 && fq < 2) { float* ab = (float*)(ws + O_AB);
#pragma unroll
                for (int ai = 0; ai < 2; ++ai)
#pragma unroll
                    for (int m = 0; m < 4; ++m)
#pragma unroll
                        for (int bj = 0; bj < 2; ++bj) { float* rp = ab + (size_t)(row0 + ai * 128 + m * 16) * 32 + 16 * fq + 8 * bj; *(f32x4*)rp = acc[ai][bj][m][0] * rs[ai][m]; *(f32x4*)(rp + 4) = acc[ai][bj][m][1] * rs[ai][m]; } }
            return;
        }
        bf16_t* base; int ldc, colt;
        if (pn < 12) { base = (bf16_t*)(ws + O_AQKV); ldc = 3072; colt = pn * 256; }
        else if (pn < 16) { base = (bf16_t*)(ws + O_SZ); ldc = 1024; colt = (pn - 12) * 256; }
        else if (pn < 28) { base = (bf16_t*)(ws + O_SB); ldc = 3072; colt = (pn - 16) * 256; }
        else if (pn < 46) { const int s = (pn - 28) / 6; base = (bf16_t*)(ws + O_CQ) + (size_t)s * T_ * 1536; ldc = 1536; colt = ((pn - 28) - s * 6) * 256; }
        else { base = (bf16_t*)(ws + O_GATES); ldc = 6144; colt = (pn - 46) * 256; }
        const int col0 = colt + wc * 64 + 16 * fq;
#pragma unroll
        for (int ai = 0; ai < 2; ++ai)
#pragma unroll
            for (int m = 0; m < 4; ++m) { bf16_t* rowp = base + (size_t)(row0 + ai * 128 + m * 16) * ldc + col0;
#pragma unroll
                for (int bj = 0; bj < 2; ++bj) { const f32x4 v0 = acc[ai][bj][m][0] * rs[ai][m], v1 = acc[ai][bj][m][1] * rs[ai][m];
                    u32x4 w; w.x = pk2(v0[0], v0[1]); w.y = pk2(v0[2], v0[3]); w.z = pk2(v1[0], v1[1]); w.w = pk2(v1[2], v1[3]);
                    *(u32x4*)(rowp + bj * 8) = w; } }
    }
};
struct EpiUp {
    static constexpr bool PERM = true, AFTER_DRAIN = false;
    bf16_t* O; const float* ssq;
    __device__ __forceinline__ void operator()(const f32x4 (&acc)[2][2][4][2], const pg8::Unit& u, int wr, int wc, int fr, int fq) const {
        const int row0 = u.pm * 256 + wr * 64 + fr, col0 = u.pn * 256 + wc * 64 + 16 * fq;
        float rs[2][4];
#pragma unroll
        for (int ai = 0; ai < 2; ++ai)
#pragma unroll
            for (int m = 0; m < 4; ++m) rs[ai][m] = rsqrtf(ssq[row0 + ai * 128 + m * 16] * (1.0f / DM) + 1e-6f);
#pragma unroll
        for (int ai = 0; ai < 2; ++ai)
#pragma unroll
            for (int m = 0; m < 4; ++m) { bf16_t* rowp = O + (size_t)(row0 + ai * 128 + m * 16) * DFF + col0;
#pragma unroll
                for (int bj = 0; bj < 2; ++bj) { f32x4 v0 = acc[ai][bj][m][0], v1 = acc[ai][bj][m][1];
#pragma unroll
                    for (int j = 0; j < 4; ++j) { const float a = fmaxf(v0[j] * rs[ai][m], 0.f), b = fmaxf(v1[j] * rs[ai][m], 0.f); v0[j] = a * a; v1[j] = b * b; }
                    u32x4 w; w.x = pk2(v0[0], v0[1]); w.y = pk2(v0[2], v0[3]); w.z = pk2(v1[0], v1[1]); w.w = pk2(v1[2], v1[3]);
                    *(u32x4*)(rowp + bj * 8) = w; } }
    }
};
struct EpiResid {
    static constexpr bool PERM = true, AFTER_DRAIN = false;
    float* C; bf16_t* hb; float* ssq; const float* xp; const float* xs;
    __device__ __forceinline__ void operator()(const f32x4 (&acc)[2][2][4][2], const pg8::Unit& u, int wr, int wc, int fr, int fq) const {
        const int row0 = u.pm * 256 + wr * 64 + fr, col0 = u.pn * 256 + wc * 64 + 16 * fq;
        const float* src = xp ? (u.pm < 32 ? xp : xs - (size_t)8192 * DM) : C;
#pragma unroll
        for (int ai = 0; ai < 2; ++ai) {
            f32x4 old[4][2][2];
#pragma unroll
            for (int m = 0; m < 4; ++m)
#pragma unroll
                for (int bj = 0; bj < 2; ++bj)
#pragma unroll
                    for (int n = 0; n < 2; ++n) old[m][bj][n] = *(const f32x4*)(src + (size_t)(row0 + ai * 128 + m * 16) * DM + col0 + bj * 8 + n * 4);
            asm volatile("" ::: "memory");
#pragma unroll
            for (int m = 0; m < 4; ++m) { const size_t row = (size_t)(row0 + ai * 128 + m * 16); float* rowp = C + row * DM + col0; bf16_t* hrow = hb + row * DM + col0; float part = 0.f;
#pragma unroll
                for (int bj = 0; bj < 2; ++bj) { const f32x4 v0 = old[m][bj][0] + acc[ai][bj][m][0], v1 = old[m][bj][1] + acc[ai][bj][m][1];
                    *(f32x4*)(rowp + bj * 8) = v0; *(f32x4*)(rowp + bj * 8 + 4) = v1;
                    u32x4 o; o.x = pk2(v0[0], v0[1]); o.y = pk2(v0[2], v0[3]); o.z = pk2(v1[0], v1[1]); o.w = pk2(v1[2], v1[3]); *(u32x4*)(hrow + bj * 8) = o;
                    part += v0[0] * v0[0] + v0[1] * v0[1] + v0[2] * v0[2] + v0[3] * v0[3] + v1[0] * v1[0] + v1[1] * v1[1] + v1[2] * v1[2] + v1[3] * v1[3]; }
                part += __shfl_xor(part, 16); part += __shfl_xor(part, 32);
                if (fq == 0) (void)__hip_atomic_fetch_add(ssq + row, part, __ATOMIC_RELAXED, __HIP_MEMORY_SCOPE_AGENT); }
        }
    }
};
struct EpiBranch {
    static constexpr bool PERM = true, AFTER_DRAIN = false;
    bf16_t* merged; const bf16_t* gates; int goff, mode;
    __device__ __forceinline__ void operator()(const f32x4 (&acc)[2][2][4][2], const pg8::Unit& u, int wr, int wc, int fr, int fq) const {
        const int row0 = u.pm * 256 + wr * 64 + fr, col0 = u.pn * 256 + wc * 64 + 16 * fq;
#pragma unroll
        for (int ai = 0; ai < 2; ++ai) {
            u32x4 gw[4][2], old[4][2];
#pragma unroll
            for (int m = 0; m < 4; ++m)
#pragma unroll
                for (int bj = 0; bj < 2; ++bj) { const size_t row = (size_t)(row0 + ai * 128 + m * 16); const int col = col0 + bj * 8;
                    gw[m][bj] = *(const u32x4*)(gates + row * 6144 + goff + col);
                    old[m][bj] = (mode != 0) ? *(const u32x4*)(merged + row * DM + col) : (u32x4){0u, 0u, 0u, 0u}; }
            asm volatile("" ::: "memory");
#pragma unroll
            for (int m = 0; m < 4; ++m)
#pragma unroll
                for (int bj = 0; bj < 2; ++bj) { const size_t row = (size_t)(row0 + ai * 128 + m * 16); const int col = col0 + bj * 8;
                    const u32x4 g = gw[m][bj], od = old[m][bj];
                    const f32x4 v0 = acc[ai][bj][m][0], v1 = acc[ai][bj][m][1];
                    u32x4 o;
                    o.x = pk2(v0[0] * sigmoidf_(bflo(g.x)) + bflo(od.x), v0[1] * sigmoidf_(bfhi(g.x)) + bfhi(od.x));
                    o.y = pk2(v0[2] * sigmoidf_(bflo(g.y)) + bflo(od.y), v0[3] * sigmoidf_(bfhi(g.y)) + bfhi(od.y));
                    o.z = pk2(v1[0] * sigmoidf_(bflo(g.z)) + bflo(od.z), v1[1] * sigmoidf_(bfhi(g.z)) + bfhi(od.z));
                    o.w = pk2(v1[2] * sigmoidf_(bflo(g.w)) + bflo(od.w), v1[3] * sigmoidf_(bfhi(g.w)) + bfhi(od.w));
                    *(u32x4*)(merged + row * DM + col) = o; }
        }
    }
};

template <class Epi> __device__ __forceinline__ void run_gemm(unsigned char* smem, const bf16_t* A, const bf16_t* Bt, int M, int N, int K, const Epi& E) {
    pg8::Gemm g; g.A = A; g.Bt = Bt; g.M = M; g.N = N; g.K = K;
    pg8::StaticOrder S; S.init(M, N, (int)gridDim.x, bid_l());
    pg8::gemm_phase<Epi, pg8::StaticOrder, false>((PG8_LAS unsigned char*)smem, g, S, E, nullptr);
}

__device__ void prep_phase(const Params& p, int L, unsigned char* smem) {
    const int tid = tid_l(), wid = tid >> 6, lane = tid & 63, gw = bid_l() * 8 + wid, nw = gridDim.x * 8;
    unsigned char* ws = p.ws;
    const bf16_t* AQ = (const bf16_t*)(ws + O_AQKV); const bf16_t* SB = (const bf16_t*)(ws + O_SB);
    bf16_t* QKV = (bf16_t*)(ws + O_QKV); bf16_t* KT = (bf16_t*)(ws + O_KT); bf16_t* YB = (bf16_t*)(ws + O_YB);
    const float* ca = p.conv_a + (size_t)L * 3 * 3072; const float* cb = p.conv_b + (size_t)L * 3 * 1024;
    for (int it = gw; it < 16384; it += nw) {
        const int h = it & 7, oct = it >> 3, tw = oct * 8, ch = tw >> 6, cloc = tw & 63;
        int s0, Ls; seq_of(tw, s0, Ls);
        const bool v0 = tw - 1 >= s0, v9 = tw + 8 < s0 + Ls;
        float qv[3][8][2];
#pragma unroll
        for (int part = 0; part < 3; ++part) {
            const int col = part * 1024 + h * 128 + 2 * lane;
            const float2 w0 = *(const float2*)(ca + col), w1 = *(const float2*)(ca + 3072 + col), w2 = *(const float2*)(ca + 6144 + col);
            unsigned x[10];
#pragma unroll
            for (int j = 0; j < 10; ++j) { const bool ok = (j == 0) ? v0 : ((j == 9) ? v9 : true); x[j] = ok ? *(const unsigned*)(AQ + (size_t)(tw - 1 + j) * 3072 + col) : 0u; }
#pragma unroll
            for (int i = 0; i < 8; ++i) {
                qv[part][i][0] = siluf_(w0.x * bflo(x[i]) + w1.x * bflo(x[i + 1]) + w2.x * bflo(x[i + 2]));
                qv[part][i][1] = siluf_(w0.y * bfhi(x[i]) + w1.y * bfhi(x[i + 1]) + w2.y * bfhi(x[i + 2])); }
        }
        const int cbn = h * 128 + 2 * lane;
        unsigned sc[10], sh[10], sg[8];
#pragma unroll
        for (int j = 0; j < 10; ++j) { const bool ok = (j == 0) ? v0 : ((j == 9) ? v9 : true);
            const bf16_t* rp = SB + (size_t)(tw - 1 + j) * 3072 + cbn;
            sc[j] = ok ? *(const unsigned*)(rp + 1024) : 0u; sh[j] = ok ? *(const unsigned*)(rp + 2048) : 0u; }
#pragma unroll
        for (int i = 0; i < 8; ++i) sg[i] = *(const unsigned*)(SB + (size_t)(tw + i) * 3072 + cbn);
        float sq[8], sk[8];
#pragma unroll
        for (int i = 0; i < 8; ++i) { sq[i] = qv[0][i][0] * qv[0][i][0] + qv[0][i][1] * qv[0][i][1]; sk[i] = qv[1][i][0] * qv[1][i][0] + qv[1][i][1] * qv[1][i][1]; }
#pragma unroll
        for (int off = 32; off > 0; off >>= 1)
#pragma unroll
            for (int i = 0; i < 8; ++i) { sq[i] += __shfl_xor(sq[i], off); sk[i] += __shfl_xor(sk[i], off); }
        unsigned klo[8], khi[8];
#pragma unroll
        for (int i = 0; i < 8; ++i) {
            const int t = tw + i;
            const float rq = rsqrtf(sq[i] + 1e-6f) * 0.08838834764831845f, rk = rsqrtf(sk[i] + 1e-6f);
            const unsigned qo = pk2(qv[0][i][0] * rq, qv[0][i][1] * rq), ko = pk2(qv[1][i][0] * rk, qv[1][i][1] * rk), vo = pk2(qv[2][i][0], qv[2][i][1]);
            bf16_t* orow = QKV + (size_t)t * 3072 + h * 128 + 2 * lane;
            *(unsigned*)(orow) = qo; *(unsigned*)(orow + 1024) = ko; *(unsigned*)(orow + 2048) = vo;
            klo[i] = ko & 0xffffu; khi[i] = ko >> 16; }
        { u32x4 a, b; a.x = klo[0] | (klo[1] << 16); a.y = klo[2] | (klo[3] << 16); a.z = klo[4] | (klo[5] << 16); a.w = klo[6] | (klo[7] << 16);
          b.x = khi[0] | (khi[1] << 16); b.y = khi[2] | (khi[3] << 16); b.z = khi[4] | (khi[5] << 16); b.w = khi[6] | (khi[7] << 16);
          bf16_t* dst = KT + ((size_t)(ch * 8 + h) * 128 + 2 * lane) * 64 + cloc;
          *(u32x4*)dst = a; *(u32x4*)(dst + 64) = b; }
        { const float2 w0 = *(const float2*)(cb + cbn), w1 = *(const float2*)(cb + 1024 + cbn), w2 = *(const float2*)(cb + 2048 + cbn);
          float u[10][2];
#pragma unroll
          for (int j = 0; j < 10; ++j) { u[j][0] = bflo(sc[j]) * bflo(sh[j]); u[j][1] = bfhi(sc[j]) * bfhi(sh[j]); }
#pragma unroll
          for (int i = 0; i < 8; ++i) {
              const float ya = bflo(sg[i]) * (w0.x * u[i][0] + w1.x * u[i + 1][0] + w2.x * u[i + 2][0]);
              const float yb = bfhi(sg[i]) * (w0.y * u[i][1] + w1.y * u[i + 1][1] + w2.y * u[i + 2][1]);
              *(unsigned*)(YB + (size_t)(tw + i) * 1024 + cbn) = pk2(ya, yb); } }
        if (h == 0 && lane < 8) {
            const float* AB = (const float*)(ws + O_AB); float* G = (float*)(ws + O_G); float* BT = (float*)(ws + O_BETA); const int tok = tw + lane;
#pragma unroll
            for (int q4 = 0; q4 < 4; ++q4) { const f32x4 a4 = *(const f32x4*)(AB + (size_t)tok * 32 + q4 * 4), b4 = *(const f32x4*)(AB + (size_t)tok * 32 + 16 + q4 * 4); f32x4 go, bo;
#pragma unroll
                for (int j = 0; j < 4; ++j) { const int dh = q4 * 4 + j; const float a = a4[j] + p.dt_bias[L * 16 + dh];
                    const float sp = fmaxf(a, 0.f) + log1pf(__expf(-fabsf(a)));
                    go[j] = -__expf(p.a_log[L * 16 + dh]) * sp; bo[j] = sigmoidf_(b4[j]); }
                *(f32x4*)(G + (size_t)tok * 16 + q4 * 4) = go; *(f32x4*)(BT + (size_t)tok * 16 + q4 * 4) = bo; }
        }
    }
    const bf16_t* CV = (const bf16_t*)(ws + O_CV); bf16_t* VT = (bf16_t*)(ws + O_VT);
    for (int it = gw; it < 6144; it += nw) {
        const int hc = it % 12, hf = it / 12, g = hc >> 2, hq = hc & 3, t0 = hf * 32, dsh = g * 2, D = 1 << dsh;
        int s0, Ls; seq_of(t0, s0, Ls); const int l = Ls >> dsh;
        unsigned xv[32];
#pragma unroll
        for (int j = 0; j < 32; ++j) xv[j] = *(const unsigned*)(CV + (size_t)(t0 + j) * 1536 + hc * 128 + 2 * lane);
        bf16_t* vrow = VT + (size_t)g * 512 * VTLD + (size_t)(hq * 128 + 2 * lane) * VTLD + 128;
        if (g == 0) {
#pragma unroll
            for (int u = 0; u < 8; ++u) { const int col = t0 + 4 * u; u32x2 lo, hi;
                lo.x = (xv[4 * u] & 0xffffu) | (xv[4 * u + 1] << 16); lo.y = (xv[4 * u + 2] & 0xffffu) | (xv[4 * u + 3] << 16);
                hi.x = (xv[4 * u] >> 16) | (xv[4 * u + 1] & 0xffff0000u); hi.y = (xv[4 * u + 2] >> 16) | (xv[4 * u + 3] & 0xffff0000u);
                *(u32x2*)(vrow + col) = lo; *(u32x2*)(vrow + VTLD + col) = hi; }
        } else if (g == 1) {
#pragma unroll
            for (int r = 0; r < 4; ++r)
#pragma unroll
                for (int m0 = 0; m0 < 8; m0 += 4) { const int col = s0 + r * l + ((t0 - s0) >> 2) + m0; u32x2 lo, hi;
                    const unsigned e0 = xv[(m0 + 0) * 4 + r], e1 = xv[(m0 + 1) * 4 + r], e2 = xv[(m0 + 2) * 4 + r], e3 = xv[(m0 + 3) * 4 + r];
                    lo.x = (e0 & 0xffffu) | (e1 << 16); lo.y = (e2 & 0xffffu) | (e3 << 16); hi.x = (e0 >> 16) | (e1 & 0xffff0000u); hi.y = (e2 >> 16) | (e3 & 0xffff0000u);
                    *(u32x2*)(vrow + col) = lo; *(u32x2*)(vrow + VTLD + col) = hi; }
        } else {
#pragma unroll
            for (int r = 0; r < 16; ++r) { const int col = s0 + r * l + ((t0 - s0) >> 4);
                const unsigned e0 = xv[r], e1 = xv[16 + r];
                *(unsigned*)(vrow + col) = (e0 & 0xffffu) | (e1 << 16); *(unsigned*)(vrow + VTLD + col) = (e0 >> 16) | (e1 & 0xffff0000u); }
        }
        if (hf == 0) {
            bf16_t* rowp = VT + (size_t)g * 512 * VTLD + (size_t)(hq * 128) * VTLD; const u32x4 z = {0u, 0u, 0u, 0u};
            for (int q = lane; q < 128 * 32; q += 64) { const int d = q >> 5, piece = q & 31; const int coff = piece < 16 ? piece * 8 : 128 + T_ + (piece - 16) * 8;
                *(u32x4*)(rowp + (size_t)d * VTLD + coff) = z; }
        }
    }
}

__device__ void gdn_local(const Params& p, unsigned char* smem) {
    const int tid = tid_l(), wid = tid >> 6, lane = tid & 63, fr = lane & 15, fq = lane >> 4;
    unsigned char* ws = p.ws;
    float* Lm = (float*)(smem + wid * 16384);
    float* gcs = (float*)(smem + 131072 + wid * 512); float* bts = gcs + 64;
    const float* G = (const float*)(ws + O_G); const float* BT = (const float*)(ws + O_BETA); const bf16_t* QKV = (const bf16_t*)(ws + O_QKV);
    float* GCP = (float*)(ws + O_GCP); bf16_t* TG = (bf16_t*)(ws + O_TINV); bf16_t* AG = (bf16_t*)(ws + O_AIN);
    for (int item = bid_l() * 8 + wid; item < 4096; item += gridDim.x * 8) {
        const int dir = item & 1, h = (item >> 1) & 7, ch = item >> 4, t0 = ch * 64;
        const int pl = dir ? 63 - lane : lane;
        float gc = G[(size_t)(t0 + pl) * 16 + dir * 8 + h];
        const float bt = BT[(size_t)(t0 + pl) * 16 + dir * 8 + h];
#pragma unroll
        for (int off = 1; off < 64; off <<= 1) { const float v = __shfl_up(gc, off); if (lane >= off) gc += v; }
        LDS_WAIT();
        gcs[lane] = gc; bts[lane] = bt;
        GCP[(size_t)item * 64 + pl] = gc;
        LDS_WAIT();
        {
            bf16x8 kf[4][4];
#pragma unroll
            for (int mt = 0; mt < 4; ++mt) { const int a = mt * 16 + fr, pp = dir ? 63 - a : a;
#pragma unroll
                for (int kb = 0; kb < 4; ++kb) kf[mt][kb] = *(const bf16x8*)(QKV + (size_t)(t0 + pp) * 3072 + 1024 + h * 128 + kb * 32 + fq * 8); }
#pragma unroll
            for (int mt = 0; mt < 4; ++mt)
#pragma unroll
                for (int nt = 0; nt <= mt; ++nt) { f32x4 acc = {0.f, 0.f, 0.f, 0.f};
#pragma unroll
                    for (int kb = 0; kb < 4; ++kb) acc = MFMA16(kf[mt][kb], kf[nt][kb], acc);
                    const int b = nt * 16 + fr; const float gb = gcs[b];
#pragma unroll
                    for (int j = 0; j < 4; ++j) { const int a = mt * 16 + fq * 4 + j;
                        Lm[a * 64 + b] = (a > b) ? acc[j] * bts[a] * __expf(gcs[a] - gb) : 0.f; } }
        }
        LDS_WAIT();
        float x[64];
#pragma unroll
        for (int i = 0; i < 64; ++i) { int ln = lane; asm volatile("" : "+v"(ln)); float s = (i == ln) ? 1.f : 0.f;
#pragma unroll
            for (int j = 0; j < i; ++j) s -= Lm[i * 64 + j] * x[j];
            x[i] = s; asm volatile("" ::: "memory"); }
        LDS_WAIT();
        {
            unsigned short* Xs = (unsigned short*)Lm; const int idx0 = dir ? 4095 - lane : lane, st = dir ? -64 : 64;
#pragma unroll
            for (int a = 0; a < 64; a += 2) { const unsigned w = pk2(x[a], x[a + 1]); Xs[idx0 + a * st] = (unsigned short)(w & 0xffffu); Xs[idx0 + (a + 1) * st] = (unsigned short)(w >> 16); }
            LDS_WAIT();
            u32x4* dst = (u32x4*)(TG + (size_t)item * 4096);
#pragma unroll
            for (int k = 0; k < 8; ++k) dst[k * 64 + lane] = ((const u32x4*)Xs)[k * 64 + lane];
            LDS_WAIT();
        }
        {
            bf16x8 kf[4][4];
#pragma unroll
            for (int mt = 0; mt < 4; ++mt) { const int a = mt * 16 + fr, pp = dir ? 63 - a : a;
#pragma unroll
                for (int kb = 0; kb < 4; ++kb) kf[mt][kb] = *(const bf16x8*)(QKV + (size_t)(t0 + pp) * 3072 + 1024 + h * 128 + kb * 32 + fq * 8); }
            unsigned short* As = (unsigned short*)Lm;
#pragma unroll 1
            for (int mt = 0; mt < 4; ++mt) { bf16x8 qf[4]; const int aq = mt * 16 + fr, pq = dir ? 63 - aq : aq;
#pragma unroll
                for (int kb = 0; kb < 4; ++kb) qf[kb] = *(const bf16x8*)(QKV + (size_t)(t0 + pq) * 3072 + h * 128 + kb * 32 + fq * 8);
#pragma unroll
                for (int nt = 0; nt < 4; ++nt) { f32x4 acc = {0.f, 0.f, 0.f, 0.f};
                    if (nt <= mt) {
#pragma unroll
                        for (int kb = 0; kb < 4; ++kb) acc = MFMA16(qf[kb], kf[nt][kb], acc); }
                    const int b = nt * 16 + fr; const float gb = gcs[b];
#pragma unroll
                    for (int j = 0; j < 4; ++j) { const int a = mt * 16 + fq * 4 + j, n = a * 64 + b;
                        const float v = (a >= b) ? acc[j] * __expf(gcs[a] - gb) : 0.f;
                        As[dir ? 4095 - n : n] = f2bf(v); } } }
            LDS_WAIT();
            u32x4* dst = (u32x4*)(AG + (size_t)item * 4096);
#pragma unroll
            for (int k = 0; k < 8; ++k) dst[k * 64 + lane] = ((const u32x4*)As)[k * 64 + lane];
            LDS_WAIT();
        }
    }
}

#ifndef SCAN_DUPLOAD
#define SCAN_DUPLOAD 0
#endif
constexpr int SCAN_NT = 1;
__device__ void gdn_scan(const Params& p, unsigned char* smem, int chain_half) {
    constexpr int NT = SCAN_NT; static_assert(NT == 1, "block map below assumes two workgroups per chain");
    const int chain = (chain_half >> 4) * 8 + (chain_half & 7), dvh = (chain_half >> 3) & 1;
    const int tid = tid_l(), wid = tid >> 6, lane = tid & 63, fr = lane & 15, fq = lane >> 4;
    unsigned char* ws = p.ws;
    int seq, h, dir, nch, c0;
    if (chain < 32) { seq = chain >> 4; h = (chain >> 1) & 7; dir = chain & 1; nch = 64; c0 = seq * 64; }
    else { const int b = chain - 32; seq = b >> 4; h = (b >> 1) & 7; dir = b & 1; nch = 32; c0 = 128 + seq * 32; }
    unsigned char* kS = smem; unsigned char* qS = smem + 17408; unsigned char* vS = smem + 34816; unsigned char* kTS = smem + 52224;
    unsigned char* TiS = smem + 70656; unsigned char* AS = smem + 79872; float* gS = (float*)(smem + 89088); float* bS = (float*)(smem + 89344);
    const bf16_t* QKV = (const bf16_t*)(ws + O_QKV); const bf16_t* KT = (const bf16_t*)(ws + O_KT); const bf16_t* TG = (const bf16_t*)(ws + O_TINV); const bf16_t* AG = (const bf16_t*)(ws + O_AIN);
    const float* GCP = (const float*)(ws + O_GCP); const float* BT = (const float*)(ws + O_BETA);
    float* of = (float*)(ws + (dir ? O_OBWD : O_OFWD));
    const bool loader = wid >= 4; const int lt = tid - 256;
#define RAW_BAR() do { asm volatile("" ::: "memory"); __builtin_amdgcn_s_barrier(); asm volatile("" ::: "memory"); } while (0)
    u32x4 pq[2][4], pk[2][4], pv[2][4], pt[2][4], pti[2][2], pa[2][2]; float pgb[2] = {0.f, 0.f};
#define SCAN_LOAD(s_, ci_) do { const int cgl = c0 + (dir ? nch - 1 - (ci_) : (ci_)), tl = cgl * 64, iteml = (cgl * 8 + h) * 2 + dir; \
        _Pragma("unroll") for (int rep = 0; rep < 4; ++rep) { const int pid = lt + rep * 256, row = pid >> 4, seg = pid & 15; \
            const bf16_t* src = QKV + (size_t)(tl + row) * 3072 + h * 128 + seg * 8; \
            pq[s_][rep] = *(const u32x4*)(src); pk[s_][rep] = *(const u32x4*)(src + 1024); pv[s_][rep] = *(const u32x4*)(src + 2048); \
            if (SCAN_DUPLOAD) { asm volatile("" : "+v"(pq[s_][rep]), "+v"(pk[s_][rep]), "+v"(pv[s_][rep])); pq[s_][rep] = *(const volatile u32x4*)(src); pk[s_][rep] = *(const volatile u32x4*)(src + 1024); pv[s_][rep] = *(const volatile u32x4*)(src + 2048); } \
            const int rowt = pid >> 3, segt = pid & 7; \
            pt[s_][rep] = *(const u32x4*)(KT + ((size_t)(cgl * 8 + h) * 128 + rowt) * 64 + segt * 8); } \
        _Pragma("unroll") for (int rep = 0; rep < 2; ++rep) { const int pid = lt + rep * 256, row = pid >> 3, seg = pid & 7; \
          pti[s_][rep] = *(const u32x4*)(TG + (size_t)iteml * 4096 + row * 64 + seg * 8); pa[s_][rep] = *(const u32x4*)(AG + (size_t)iteml * 4096 + row * 64 + seg * 8); } \
        { const float* gp_ = (lt < 64) ? (GCP + (size_t)iteml * 64 + lt) : (BT + (size_t)(tl + (lt & 63)) * 16 + dir * 8 + h); pgb[s_] = *gp_; } } while (0)
#define SCAN_STORE(s_) do { \
        _Pragma("unroll") for (int rep = 0; rep < 4; ++rep) { const int pid = lt + rep * 256, row = pid >> 4, seg = pid & 15; \
            *(u32x4*)(qS + row * 272 + seg * 16) = pq[s_][rep]; *(u32x4*)(kS + row * 272 + seg * 16) = pk[s_][rep]; *(u32x4*)(vS + row * 272 + seg * 16) = pv[s_][rep]; \
            const int rowt = pid >> 3, segt = pid & 7; \
            *(u32x4*)(kTS + rowt * 144 + segt * 16) = pt[s_][rep]; } \
        _Pragma("unroll") for (int rep = 0; rep < 2; ++rep) { const int pid = lt + rep * 256, row = pid >> 3, seg = pid & 7; \
            *(u32x4*)(TiS + row * 144 + seg * 16) = pti[s_][rep]; *(u32x4*)(AS + row * 144 + seg * 16) = pa[s_][rep]; } \
        if (lt < 64) gS[lt] = pgb[s_]; else if (lt < 128) bS[lt - 64] = pgb[s_]; } while (0)
    f32x4 S[NT][8];
#pragma unroll
    for (int nt = 0; nt < NT; ++nt)
#pragma unroll
        for (int i = 0; i < 8; ++i) S[nt][i] = (f32x4){0.f, 0.f, 0.f, 0.f};
    const int e0 = dvh * 64 + (wid & 3) * 16 * NT;
    if (loader) {
        SCAN_LOAD(0, 0); SCAN_LOAD(1, 1);
        for (int ci = 0; ci < nch; ci += 2) {
            RAW_BAR();
            SCAN_STORE(0);
            asm volatile("s_waitcnt lgkmcnt(0)" ::: "memory"); RAW_BAR();
            SCAN_LOAD(0, (ci + 2 < nch ? ci + 2 : nch - 1));
            RAW_BAR();
            SCAN_STORE(1);
            asm volatile("s_waitcnt lgkmcnt(0)" ::: "memory"); RAW_BAR();
            SCAN_LOAD(1, (ci + 3 < nch ? ci + 3 : nch - 1));
        }
    } else {
    for (int ci = 0; ci < nch; ++ci) {
        const int cg_ = c0 + (dir ? nch - 1 - ci : ci), t0 = cg_ * 64;
        asm volatile("s_waitcnt lgkmcnt(0)" ::: "memory"); RAW_BAR();
        RAW_BAR();
        {
#define SCHED_FENCE() __builtin_amdgcn_sched_barrier(0)
#define LD272(base, mt_, f) do { _Pragma("unroll") for (int kb = 0; kb < 4; ++kb) { const int off = ((mt_) * 16 + fr) * 272 + (kb * 32 + fq * 4) * 2; \
                (f)[kb] = mk8(*(const u32x2*)((base) + off), *(const u32x2*)((base) + off + 32)); } } while (0)
#define LD144(base, mt_, f) do { _Pragma("unroll") for (int kb = 0; kb < 2; ++kb) { const int off = ((mt_) * 16 + fr) * 144 + (kb * 32 + fq * 4) * 2; \
                (f)[kb] = mk8(*(const u32x2*)((base) + off), *(const u32x2*)((base) + off + 32)); } } while (0)
#define MMA4(ACC, mt_, f) do { _Pragma("unroll") for (int kb = 0; kb < 4; ++kb) _Pragma("unroll") for (int nt = 0; nt < NT; ++nt) ACC[nt][mt_] = MFMA16((f)[kb], Sb[nt][kb], ACC[nt][mt_]); } while (0)
            bf16x8 Sb[NT][4];
#pragma unroll
            for (int nt = 0; nt < NT; ++nt)
#pragma unroll
                for (int kb = 0; kb < 4; ++kb) Sb[nt][kb] = pack8(S[nt][2 * kb], S[nt][2 * kb + 1]);
            f32x4 KS[NT][4], QS[NT][4];
#pragma unroll
            for (int mt = 0; mt < 4; ++mt)
#pragma unroll
                for (int nt = 0; nt < NT; ++nt) { KS[nt][mt] = (f32x4){0.f, 0.f, 0.f, 0.f}; QS[nt][mt] = (f32x4){0.f, 0.f, 0.f, 0.f}; }
            bf16x8 fa[4], fb[4];
            LD272(kS, 0, fa);
            LD272(kS, 1, fb); SCHED_FENCE(); MMA4(KS, 0, fa); SCHED_FENCE();
            LD272(kS, 2, fa); SCHED_FENCE(); MMA4(KS, 1, fb); SCHED_FENCE();
            LD272(kS, 3, fb); SCHED_FENCE(); MMA4(KS, 2, fa); SCHED_FENCE();
            LD272(qS, 0, fa); SCHED_FENCE(); MMA4(KS, 3, fb); SCHED_FENCE();
            LD272(qS, 1, fb); SCHED_FENCE(); MMA4(QS, 0, fa); SCHED_FENCE();
            LD272(qS, 2, fa); SCHED_FENCE(); MMA4(QS, 1, fb); SCHED_FENCE();
            LD272(qS, 3, fb); SCHED_FENCE(); MMA4(QS, 2, fa); SCHED_FENCE();
            f32x4 gv[4], bv[4]; unsigned short vraw[NT][4][4];
#pragma unroll
            for (int mt = 0; mt < 4; ++mt) { gv[mt] = *(const f32x4*)(gS + mt * 16 + fq * 4); bv[mt] = *(const f32x4*)(bS + mt * 16 + fq * 4); }
            SCHED_FENCE(); MMA4(QS, 3, fb); SCHED_FENCE();
#pragma unroll
            for (int mt = 0; mt < 4; ++mt)
#pragma unroll
                for (int j = 0; j < 4; ++j)
#pragma unroll
                    for (int nt = 0; nt < NT; ++nt) vraw[nt][mt][j] = *(const unsigned short*)(vS + (mt * 16 + fq * 4 + j) * 272 + (e0 + nt * 16 + fr) * 2);
            f32x4 eg4[4];
            bf16x8 Rb[NT][2];
            {
                f32x4 R[NT][4];
#pragma unroll
                for (int mt = 0; mt < 4; ++mt)
#pragma unroll
                    for (int j = 0; j < 4; ++j) { eg4[mt][j] = __expf(gv[mt][j]);
#pragma unroll
                        for (int nt = 0; nt < NT; ++nt) R[nt][mt][j] = bv[mt][j] * (bf2f(vraw[nt][mt][j]) - eg4[mt][j] * KS[nt][mt][j]); }
#pragma unroll
                for (int nt = 0; nt < NT; ++nt) { Rb[nt][0] = pack8(R[nt][0], R[nt][1]); Rb[nt][1] = pack8(R[nt][2], R[nt][3]); }
            }
            SCHED_FENCE();
            bf16x8 ti[4][2];
#pragma unroll
            for (int mt = 0; mt < 4; ++mt) LD144(TiS, mt, ti[mt]);
            f32x4 VN[NT][4];
#pragma unroll
            for (int mt = 0; mt < 4; ++mt) {
#pragma unroll
                for (int nt = 0; nt < NT; ++nt) VN[nt][mt] = (f32x4){0.f, 0.f, 0.f, 0.f};
#pragma unroll
                for (int kb = 0; kb < 2; ++kb)
#pragma unroll
                    for (int nt = 0; nt < NT; ++nt) VN[nt][mt] = MFMA16(ti[mt][kb], Rb[nt][kb], VN[nt][mt]); }
            SCHED_FENCE();
            bf16x8 VNb[NT][2];
#pragma unroll
            for (int nt = 0; nt < NT; ++nt) { VNb[nt][0] = pack8(VN[nt][0], VN[nt][1]); VNb[nt][1] = pack8(VN[nt][2], VN[nt][3]); }
            bf16x8 af[4][2];
#pragma unroll
            for (int mt = 0; mt < 4; ++mt) LD144(AS, mt, af[mt]);
            const float glast = gS[dir ? 0 : 63];
            SCHED_FENCE();
#pragma unroll
            for (int mt = 0; mt < 4; ++mt) { f32x4 oa[NT]; _Pragma("unroll") for (int nt = 0; nt < NT; ++nt) oa[nt] = (f32x4){0.f, 0.f, 0.f, 0.f};
#pragma unroll
                for (int kb = 0; kb < 2; ++kb)
#pragma unroll
                    for (int nt = 0; nt < NT; ++nt) oa[nt] = MFMA16(af[mt][kb], VNb[nt][kb], oa[nt]);
#pragma unroll
                for (int j = 0; j < 4; ++j) { const int c = mt * 16 + fq * 4 + j;
#pragma unroll
                    for (int nt = 0; nt < NT; ++nt) of[(size_t)(t0 + c) * 1024 + h * 128 + e0 + nt * 16 + fr] = eg4[mt][j] * QS[nt][mt][j] + oa[nt][j]; } }
            SCHED_FENCE();
            const float eg = __expf(glast);
            bf16x8 VDb[NT][2];
#pragma unroll
            for (int mt = 0; mt < 4; ++mt)
#pragma unroll
                for (int j = 0; j < 4; ++j) { const float sc = __expf(glast - gv[mt][j]); _Pragma("unroll") for (int nt = 0; nt < NT; ++nt) VN[nt][mt][j] *= sc; }
#pragma unroll
            for (int nt = 0; nt < NT; ++nt) { VDb[nt][0] = pack8(VN[nt][0], VN[nt][1]); VDb[nt][1] = pack8(VN[nt][2], VN[nt][3]); }
            bf16x8 kt0[4][2], kt1[4][2];
#pragma unroll
            for (int dt = 0; dt < 4; ++dt) { LD144(kTS, dt, kt0[dt]); LD144(kTS, 4 + dt, kt1[dt]); }
            SCHED_FENCE();
#pragma unroll
            for (int dt = 0; dt < 4; ++dt) {
#pragma unroll
                for (int nt = 0; nt < NT; ++nt) S[nt][dt] = S[nt][dt] * eg;
#pragma unroll
                for (int kb = 0; kb < 2; ++kb)
#pragma unroll
                    for (int nt = 0; nt < NT; ++nt) S[nt][dt] = MFMA16(kt0[dt][kb], VDb[nt][kb], S[nt][dt]); }
            SCHED_FENCE();
#pragma unroll
            for (int dt = 0; dt < 4; ++dt) {
#pragma unroll
                for (int nt = 0; nt < NT; ++nt) S[nt][4 + dt] = S[nt][4 + dt] * eg;
#pragma unroll
                for (int kb = 0; kb < 2; ++kb)
#pragma unroll
                    for (int nt = 0; nt < NT; ++nt) S[nt][4 + dt] = MFMA16(kt1[dt][kb], VDb[nt][kb], S[nt][4 + dt]); }
#undef SCHED_FENCE
#undef LD272
#undef LD144
#undef MMA4
        }
    }
    }
#undef SCAN_LOAD
#undef SCAN_STORE
#undef RAW_BAR
}

__device__ void attn_phase(const Params& p, unsigned char* smem, int L) {
    const int tid = tid_l(), wid = tid >> 6, lane = tid & 63, fr = lane & 15, fq = lane >> 4;
    unsigned char* ws = p.ws;
    float* btab = (float*)(smem + 131072);
    for (int idx = tid; idx < 3 * 4 * 129; idx += 512) { const int g = idx / 516, hq = (idx / 129) & 3, rr = idx % 129 - 64, D = (g == 0) ? 1 : (g == 1 ? 4 : 16);
        const int rel = rr * D, n = rel < 0 ? -rel : rel;
        int bk = (n < 8) ? n : min(15, 5 + (31 - __clz(n)));
        if (rel > 0) bk += 16;
        btab[idx] = p.rel_bias[bk * 12 + g * 4 + hq]; }
    const bf16_t* CQ = (const bf16_t*)(ws + O_CQ); const bf16_t* CK = (const bf16_t*)(ws + O_CK); const bf16_t* VT = (const bf16_t*)(ws + O_VT);
    bf16_t* OG = (bf16_t*)(ws + O_OG); float* LSE = (float*)(ws + O_LSE);
    unsigned char* Ks = smem;
    unsigned* qctr = (unsigned*)(ws + O_QCTR) + L * 64;
    volatile LAS unsigned* slot = (volatile LAS unsigned*)(smem + LDS_BAR_ST) + 2;
    for (;;) {
        __syncthreads();
        if (tid == 0) *slot = __hip_atomic_fetch_add(qctr, 1u, __ATOMIC_RELAXED, __HIP_MEMORY_SCOPE_AGENT);
        __syncthreads();
        const int bi = (int)*slot;
        if (bi >= 768) break;
        const int g = bi >> 8, rem = bi & 255, hq = rem >> 6, bt = rem & 63, dsh = g * 2, D = 1 << dsh, hc = g * 4 + hq, cb = bt * 256;
        __syncthreads();
        {
            u32x4 kv[12];
#pragma unroll
            for (int rep = 0; rep < 12; ++rep) { const int pid = tid + rep * 512, row = pid >> 4, seg = pid & 15;
                int c = cb - 64 + row; c = c < 0 ? 0 : (c > T_ - 1 ? T_ - 1 : c);
                int s0, Ls; seq_of(c, s0, Ls); const int lsh = (Ls == 4096 ? 12 : 11) - dsh, rr = (c - s0) >> lsh, ii = (c - s0) & ((1 << lsh) - 1);
                kv[rep] = *(const u32x4*)(CK + (size_t)(s0 + ii * D + rr) * 1536 + hc * 128 + seg * 8); }
#pragma unroll
            for (int rep = 0; rep < 12; ++rep) { const int pid = tid + rep * 512, row = pid >> 4, seg = pid & 15; *(u32x4*)(Ks + row * 272 + seg * 16) = kv[rep]; }
        }
        const int col0 = cb + wid * 32; int s0, Ls; seq_of(col0, s0, Ls); const int l = Ls >> dsh, r = (col0 - s0) / l, i0 = (col0 - s0) - r * l;
        bf16x8 qf[2][4];
#pragma unroll
        for (int nq = 0; nq < 2; ++nq) { const size_t tq = (size_t)(s0 + (i0 + nq * 16 + fr) * D + r);
#pragma unroll
            for (int kb = 0; kb < 4; ++kb) qf[nq][kb] = *(const bf16x8*)(CQ + tq * 1536 + hc * 128 + kb * 32 + fq * 8); }
        __syncthreads();
        f32x4 st[10][2];
#pragma unroll
        for (int kt = 0; kt < 10; ++kt) { const unsigned char* kp = Ks + (wid * 32 + kt * 16 + fr) * 272 + fq * 16;
            st[kt][0] = (f32x4){0.f, 0.f, 0.f, 0.f}; st[kt][1] = (f32x4){0.f, 0.f, 0.f, 0.f};
#pragma unroll
            for (int kb = 0; kb < 4; ++kb) { const bf16x8 kfr = *(const bf16x8*)(kp + kb * 64);
                st[kt][0] = MFMA16(kfr, qf[0][kb], st[kt][0]); st[kt][1] = MFMA16(kfr, qf[1][kb], st[kt][1]); } }
        const float* bt_ = btab + hc * 129 + 64;
        float mx[2] = {-1e30f, -1e30f};
#pragma unroll
        for (int kt = 0; kt < 10; ++kt)
#pragma unroll
            for (int nq = 0; nq < 2; ++nq)
#pragma unroll
                for (int j = 0; j < 4; ++j) { const int rel = -64 + kt * 16 + fq * 4 + j - nq * 16 - fr, kidx = i0 - 64 + kt * 16 + fq * 4 + j;
                    const bool valid = (rel >= -64) && (rel <= 64) && (kidx >= 0) && (kidx < l);
                    const int rc = rel < -64 ? -64 : (rel > 64 ? 64 : rel);
                    const float sv = valid ? st[kt][nq][j] * 0.08838834764831845f + bt_[rc] : -1e30f;
                    st[kt][nq][j] = sv; mx[nq] = fmaxf(mx[nq], sv); }
        float sm[2];
#pragma unroll
        for (int nq = 0; nq < 2; ++nq) { mx[nq] = fmaxf(mx[nq], __shfl_xor(mx[nq], 16)); mx[nq] = fmaxf(mx[nq], __shfl_xor(mx[nq], 32)); sm[nq] = 0.f; }
#pragma unroll
        for (int kt = 0; kt < 10; ++kt)
#pragma unroll
            for (int nq = 0; nq < 2; ++nq)
#pragma unroll
                for (int j = 0; j < 4; ++j) { const float e = __expf(st[kt][nq][j] - mx[nq]); st[kt][nq][j] = e; sm[nq] += e; }
#pragma unroll
        for (int nq = 0; nq < 2; ++nq) { sm[nq] += __shfl_xor(sm[nq], 16); sm[nq] += __shfl_xor(sm[nq], 32); }
        bf16x8 Pb[5][2];
#pragma unroll
        for (int kb = 0; kb < 5; ++kb) { Pb[kb][0] = pack8(st[2 * kb][0], st[2 * kb + 1][0]); Pb[kb][1] = pack8(st[2 * kb][1], st[2 * kb + 1][1]); }
        __syncthreads();
        {
            u32x4 vv[12]; const bf16_t* vsrc = VT + (size_t)g * 512 * VTLD + (size_t)(hq * 128) * VTLD + 128 + cb - 64;
#pragma unroll
            for (int rep = 0; rep < 12; ++rep) { const int pid = tid + rep * 512, d = pid / 48, seg = pid - d * 48; vv[rep] = *(const u32x4*)(vsrc + (size_t)d * VTLD + seg * 8); }
#pragma unroll
            for (int rep = 0; rep < 12; ++rep) { const int pid = tid + rep * 512, d = pid / 48, seg = pid - d * 48; *(u32x4*)(Ks + d * 784 + seg * 16) = vv[rep]; }
        }
        __syncthreads();
        f32x4 ot[8][2];
#pragma unroll
        for (int dt = 0; dt < 8; ++dt) { ot[dt][0] = (f32x4){0.f, 0.f, 0.f, 0.f}; ot[dt][1] = (f32x4){0.f, 0.f, 0.f, 0.f}; }
#pragma unroll
        for (int kb = 0; kb < 5; ++kb) {
#pragma unroll
            for (int dt = 0; dt < 8; ++dt) { const unsigned char* vp = Ks + (dt * 16 + fr) * 784 + (wid * 32 + kb * 32 + fq * 4) * 2;
                const bf16x8 va = mk8(*(const u32x2*)vp, *(const u32x2*)(vp + 32));
                ot[dt][0] = MFMA16(va, Pb[kb][0], ot[dt][0]); ot[dt][1] = MFMA16(va, Pb[kb][1], ot[dt][1]); } }
#pragma unroll
        for (int nq = 0; nq < 2; ++nq) { const size_t tq = (size_t)(s0 + (i0 + nq * 16 + fr) * D + r); const float inv = 1.0f / sm[nq];
            bf16_t* op = OG + (size_t)g * T_ * 512 + tq * 512 + hq * 128 + fq * 4;
#pragma unroll
            for (int dt = 0; dt < 8; ++dt) { u32x2 o; o.x = pk2(ot[dt][nq][0] * inv, ot[dt][nq][1] * inv); o.y = pk2(ot[dt][nq][2] * inv, ot[dt][nq][3] * inv); *(u32x2*)(op + dt * 16) = o; }
            if (fq == 0) LSE[(size_t)g * T_ * 4 + tq * 4 + hq] = mx[nq] + __logf(sm[nq]); }
    }
}

__device__ void post_phase(const Params& p, int L) {
    const int tid = tid_l(), lane = tid & 63, gw = bid_l() * 8 + (tid >> 6), nw = gridDim.x * 8;
    unsigned char* ws = p.ws;
    const float* OF = (const float*)(ws + O_OFWD); const float* OB = (const float*)(ws + O_OBWD); const bf16_t* Z = (const bf16_t*)(ws + O_SZ);
    bf16_t* YA = (bf16_t*)(ws + O_YA); bf16_t* YC = (bf16_t*)(ws + O_YC); const bf16_t* OG = (const bf16_t*)(ws + O_OG); const float* LSE = (const float*)(ws + O_LSE);
    const f32x4 hn = *(const f32x4*)(p.head_norm + L * 128 + (lane & 31) * 4);
    for (int tp = gw * 2; tp < T_; tp += nw * 2) {
        f32x4 a[2][4], b[2][4]; u32x2 z[2][4]; float ls[2][3]; u32x4 og[2][3];
#pragma unroll
        for (int u = 0; u < 2; ++u) { const size_t t = (size_t)(tp + u);
#pragma unroll
            for (int i = 0; i < 4; ++i) { a[u][i] = *(const f32x4*)(OF + t * 1024 + i * 256 + lane * 4); b[u][i] = *(const f32x4*)(OB + t * 1024 + i * 256 + lane * 4);
                z[u][i] = *(const u32x2*)(Z + t * 1024 + i * 256 + lane * 4); }
#pragma unroll
            for (int g = 0; g < 3; ++g) { ls[u][g] = LSE[(size_t)g * T_ * 4 + t * 4 + (lane >> 4)]; og[u][g] = *(const u32x4*)(OG + (size_t)g * T_ * 512 + t * 512 + lane * 8); } }
#pragma unroll
        for (int u = 0; u < 2; ++u) { const size_t t = (size_t)(tp + u);
            float ss[4];
#pragma unroll
            for (int i = 0; i < 4; ++i) { a[u][i] = a[u][i] + b[u][i]; ss[i] = a[u][i][0] * a[u][i][0] + a[u][i][1] * a[u][i][1] + a[u][i][2] * a[u][i][2] + a[u][i][3] * a[u][i][3]; }
#pragma unroll
            for (int off = 16; off > 0; off >>= 1)
#pragma unroll
                for (int i = 0; i < 4; ++i) ss[i] += __shfl_xor(ss[i], off);
#pragma unroll
            for (int i = 0; i < 4; ++i) { const float rstd = rsqrtf(ss[i] * (1.0f / 128.0f) + 1e-6f);
                u32x2 o; o.x = pk2(a[u][i][0] * rstd * hn[0] * siluf_(bflo(z[u][i].x)), a[u][i][1] * rstd * hn[1] * siluf_(bfhi(z[u][i].x)));
                o.y = pk2(a[u][i][2] * rstd * hn[2] * siluf_(bflo(z[u][i].y)), a[u][i][3] * rstd * hn[3] * siluf_(bfhi(z[u][i].y)));
                *(u32x2*)(YA + t * 1024 + i * 256 + lane * 4) = o; }
            const float l0 = ls[u][0], l1 = ls[u][1], l2 = ls[u][2];
            const float m = fmaxf(l0, fmaxf(l1, l2)); float a0 = __expf(l0 - m), a1 = __expf(l1 - m), a2 = __expf(l2 - m); const float inv = 1.0f / (a0 + a1 + a2); a0 *= inv; a1 *= inv; a2 *= inv;
            const u32x4 g0 = og[u][0], g1 = og[u][1], g2 = og[u][2];
            u32x4 yo;
            yo.x = pk2(a0 * bflo(g0.x) + a1 * bflo(g1.x) + a2 * bflo(g2.x), a0 * bfhi(g0.x) + a1 * bfhi(g1.x) + a2 * bfhi(g2.x));
            yo.y = pk2(a0 * bflo(g0.y) + a1 * bflo(g1.y) + a2 * bflo(g2.y), a0 * bfhi(g0.y) + a1 * bfhi(g1.y) + a2 * bfhi(g2.y));
            yo.z = pk2(a0 * bflo(g0.z) + a1 * bflo(g1.z) + a2 * bflo(g2.z), a0 * bfhi(g0.z) + a1 * bfhi(g1.z) + a2 * bfhi(g2.z));
            yo.w = pk2(a0 * bflo(g0.w) + a1 * bflo(g1.w) + a2 * bflo(g2.w), a0 * bfhi(g0.w) + a1 * bfhi(g1.w) + a2 * bfhi(g2.w));
            *(u32x4*)(YC + t * 512 + lane * 8) = yo; }
    }
}

constexpr int NPHASE = 23;
__device__ __forceinline__ void do_phase(const Params& p, int ph, unsigned char* smem) {
    unsigned char* ws = p.ws;
    if (ph == 22) { norm_rows(p, 2, p.norm_final, nullptr); return; }
    const int L = ph / 11, k = ph - L * 11;
    switch (k) {
    case 0: {
        const float* tile = nullptr;
        conv_tiles(p.w_in + (size_t)L * DM * 17952, DM, 17952, 281, (bf16_t*)(ws + O_WT_IN), 1, p.norm_mix + L * DM);
        if (L == 0) { conv_tiles(p.w_up, DM, DFF, 128, (bf16_t*)(ws + O_WT_UP), 0, p.norm_mlp);
                      conv_tiles(p.w_down, DFF, DM, 32, (bf16_t*)(ws + O_WT_DOWN), 0, tile); }
        conv_tiles(p.w_out + (size_t)L * DM * DM, DM, DM, 32, (bf16_t*)(ws + O_WT_OUT), 0, tile);
        conv_tiles(p.w_br_a + (size_t)L * 1024 * DM, 1024, DM, 32, (bf16_t*)(ws + O_WT_BRA), 0, tile);
        conv_tiles(p.w_br_b + (size_t)L * 1024 * DM, 1024, DM, 32, (bf16_t*)(ws + O_WT_BRB), 0, tile);
        conv_tiles(p.w_br_c + (size_t)L * 512 * DM, 512, DM, 32, (bf16_t*)(ws + O_WT_BRC), 0, tile);
        if (L == 0) norm_rows(p, 0, nullptr, (bf16_t*)(ws + O_XN));
    } break;
    case 1: { EpiProj E; E.ws = ws; E.ssq = (const float*)(ws + O_SSQ) + (size_t)(2 * L) * T_; run_gemm(smem, (const bf16_t*)(ws + O_XN), (const bf16_t*)(ws + O_WT_IN), T_, NPROJ, DM, E); } break;
    case 2: prep_phase(p, L, smem); break;
    case 3: gdn_local(p, smem); break;
    case 4: {
        const int bid = bid_l();
#ifndef SCAN_REP
#define SCAN_REP 1
#endif
        constexpr int NSCAN = 96 * (2 / SCAN_NT);
        if (bid < NSCAN) { int nr = SCAN_REP; asm volatile("" : "+s"(nr));
#pragma unroll 1
            for (int rr = 0; rr < nr; ++rr) { gdn_scan(p, smem, bid); __syncthreads(); } }
        attn_phase(p, smem, L);
        if (L == 0) { unsigned* qc = (unsigned*)(ws + O_QCTR);
            conv_queue(p.w_up + (size_t)DM * DFF, DM, DFF, 128, (bf16_t*)(ws + O_WT_UP1), p.norm_mlp + DM, qc + 16, smem);
            conv_queue(p.w_down + (size_t)DFF * DM, DFF, DM, 32, (bf16_t*)(ws + O_WT_DOWN1), nullptr, qc + 32, smem); }
    } break;
    case 5: post_phase(p, L); break;
    case 6: {
        EpiBranch E; E.merged = (bf16_t*)(ws + O_XN); E.gates = (const bf16_t*)(ws + O_GATES);
        for (int b = 0; b < 3; ++b) { E.goff = b * DM; E.mode = b;
            const bf16_t* A = (const bf16_t*)(ws + (b == 0 ? O_YA : (b == 1 ? O_YB : O_YC))); const bf16_t* Bt = (const bf16_t*)(ws + (b == 0 ? O_WT_BRA : (b == 1 ? O_WT_BRB : O_WT_BRC)));
            run_gemm(smem, A, Bt, T_, DM, b == 2 ? 512 : 1024, E); }
    } break;
    case 7: { EpiResid E; E.xp = (L == 0) ? p.x_prompt : nullptr; E.xs = p.x_sample; E.C = p.out; E.hb = (bf16_t*)(ws + O_HB2); E.ssq = (float*)(ws + O_SSQ) + (size_t)(2 * L + 1) * T_; run_gemm(smem, (const bf16_t*)(ws + O_XN), (const bf16_t*)(ws + O_WT_OUT), T_, DM, DM, E); } break;
    case 8: break;
    case 9: { EpiUp E; E.O = (bf16_t*)(ws + O_HID); E.ssq = (const float*)(ws + O_SSQ) + (size_t)(2 * L + 1) * T_; run_gemm(smem, (const bf16_t*)(ws + O_HB2), (const bf16_t*)(ws + (L == 0 ? O_WT_UP : O_WT_UP1)), T_, DFF, DM, E); } break;
    case 10: { EpiResid E; E.xp = nullptr; E.xs = nullptr; E.C = p.out; E.hb = (bf16_t*)(ws + O_XN); E.ssq = (float*)(ws + O_SSQ) + (size_t)(2 * L + 2) * T_; run_gemm(smem, (const bf16_t*)(ws + O_HID), (const bf16_t*)(ws + (L == 0 ? O_WT_DOWN : O_WT_DOWN1)), T_, DM, DFF, E); } break;
    }
}

__device__ __forceinline__ Params load_params() {
    Params q{};
#if defined(__HIP_DEVICE_COMPILE__)
    typedef const __attribute__((address_space(4))) unsigned long long* KP;
    KP kp = (KP)__builtin_amdgcn_kernarg_segment_ptr(); asm volatile("" : "+s"(kp));
#define GPF(i) ((const float*)(const __attribute__((address_space(1))) float*)kp[i])
    q.x_prompt = GPF(0); q.x_sample = GPF(1); q.rel_bias = GPF(2); q.norm_mix = GPF(3); q.w_in = GPF(4);
    q.conv_a = GPF(5); q.a_log = GPF(6); q.dt_bias = GPF(7); q.head_norm = GPF(8); q.conv_b = GPF(9);
    q.w_br_a = GPF(10); q.w_br_b = GPF(11); q.w_br_c = GPF(12); q.w_out = GPF(13); q.norm_mlp = GPF(14);
    q.w_up = GPF(15); q.w_down = GPF(16); q.norm_final = GPF(17); q.out = (float*)(__attribute__((address_space(1))) float*)kp[18]; q.ws = (unsigned char*)(__attribute__((address_space(1))) unsigned char*)kp[19];
#undef GPF
#endif
    return q;
}
#ifndef DUP_MASK
#define DUP_MASK 0
#endif
__device__ __forceinline__ void grid_barrier(unsigned char* smem) {
    XcdBarrier b; { const Params q = load_params(); b.bar = (unsigned*)(q.ws + O_BAR); } b.x = xb_xcc_id(); b.st = (volatile LAS unsigned*)(smem + LDS_BAR_ST);
    xcd_barrier(b);
}
template <int PH> __device__ __forceinline__ void phase_sync(unsigned char* smem) {
    if (PH < 22 && PH % 11 == 8) return;
    if (PH < 22 && ((DUP_MASK >> (PH % 11)) & 1)) {
        int nrep = 2; asm volatile("" : "+s"(nrep));
#pragma unroll 1
        for (int rep = 0; rep < nrep; ++rep) { { const Params q = load_params(); do_phase(q, PH, smem); } grid_barrier(smem); }
    } else { { const Params q = load_params(); do_phase(q, PH, smem); } if (PH + 1 < NPHASE) grid_barrier(smem); } }
#if MEGA
__global__ __launch_bounds__(512, 2) void k_mega(Params p) {
    extern __shared__ __attribute__((aligned(16))) unsigned char smem[];
    cg::grid_group grid = cg::this_grid();
    {
        const Params q = load_params(); unsigned* bar = (unsigned*)(q.ws + O_BAR); const int tid = tid_l();
        if (bid_l() == 0) for (int i = tid; i < XCD_BAR_WORDS + 128; i += 512) bar[i] = 0u;
        if (tid < 4) ((volatile LAS unsigned*)(smem + LDS_BAR_ST))[tid] = 0u;
        __threadfence();
        grid.sync();
        (void)xcd_barrier_post(bar, (volatile LAS unsigned*)(smem + LDS_BAR_ST));
    }
#ifdef EXTRA_SYNCS
    { int ne = EXTRA_SYNCS; asm volatile("" : "+s"(ne));
#pragma unroll 1
      for (int i = 0; i < ne; ++i) grid_barrier(smem); }
#endif
    phase_sync<0>(smem); phase_sync<1>(smem); phase_sync<2>(smem); phase_sync<3>(smem); phase_sync<4>(smem); phase_sync<5>(smem);
    phase_sync<6>(smem); phase_sync<7>(smem); phase_sync<8>(smem); phase_sync<9>(smem); phase_sync<10>(smem); phase_sync<11>(smem);
    phase_sync<12>(smem); phase_sync<13>(smem); phase_sync<14>(smem); phase_sync<15>(smem); phase_sync<16>(smem); phase_sync<17>(smem);
    phase_sync<18>(smem); phase_sync<19>(smem); phase_sync<20>(smem); phase_sync<21>(smem); phase_sync<22>(smem);
}
#else
template <int PH> __global__ __launch_bounds__(512, 2) void k_ph(Params p) {
    extern __shared__ __attribute__((aligned(16))) unsigned char smem[];
    const Params q = load_params(); do_phase(q, PH, smem);
}
template <int PH> static void launch_ph(const Params& p, hipStream_t stream) {
    (void)hipFuncSetAttribute((const void*)k_ph<PH>, hipFuncAttributeMaxDynamicSharedMemorySize, (int)LDS_BYTES);
    k_ph<PH><<<256, 512, LDS_BYTES, stream>>>(p);
}
#endif

extern "C" void kernel_launch(void* const* d_in, const int* in_sizes, int n_in, void* d_out, int out_size, void* d_ws, size_t ws_size, hipStream_t stream) {
    Params p{};
    p.x_prompt = (const float*)d_in[0]; p.x_sample = (const float*)d_in[1]; p.rel_bias = (const float*)d_in[2]; p.norm_mix = (const float*)d_in[3]; p.w_in = (const float*)d_in[4];
    p.conv_a = (const float*)d_in[5]; p.a_log = (const float*)d_in[6]; p.dt_bias = (const float*)d_in[7]; p.head_norm = (const float*)d_in[8]; p.conv_b = (const float*)d_in[9];
    p.w_br_a = (const float*)d_in[10]; p.w_br_b = (const float*)d_in[11]; p.w_br_c = (const float*)d_in[12]; p.w_out = (const float*)d_in[13]; p.norm_mlp = (const float*)d_in[14];
    p.w_up = (const float*)d_in[15]; p.w_down = (const float*)d_in[16]; p.norm_final = (const float*)d_in[17]; p.out = (float*)d_out; p.ws = (unsigned char*)d_ws;
    if (ws_size < WS_NEED) { fprintf(stderr, "workspace too small: %zu < %zu\n", ws_size, (size_t)WS_NEED); return; }
#if MEGA
    static int grid_blocks = 0;
    if (!grid_blocks) { int dev = 0, cus = 0, per_cu = 0; (void)hipGetDevice(&dev); (void)hipDeviceGetAttribute(&cus, hipDeviceAttributeMultiprocessorCount, dev);
        (void)hipFuncSetAttribute((const void*)k_mega, hipFuncAttributeMaxDynamicSharedMemorySize, (int)LDS_BYTES);
        (void)hipOccupancyMaxActiveBlocksPerMultiprocessor(&per_cu, k_mega, 512, LDS_BYTES);
        if (per_cu < 1) per_cu = 1;
        grid_blocks = cus * per_cu; if (grid_blocks > 256) grid_blocks = 256; }
    void* args[] = {&p};
    hipError_t e = hipLaunchCooperativeKernel((const void*)k_mega, dim3(grid_blocks), dim3(512), args, LDS_BYTES, stream);
    if (e != hipSuccess) fprintf(stderr, "cooperative launch failed: %s (grid %d)\n", hipGetErrorString(e), grid_blocks);
#else
    launch_ph<0>(p, stream); launch_ph<1>(p, stream); launch_ph<2>(p, stream); launch_ph<3>(p, stream); launch_ph<4>(p, stream); launch_ph<5>(p, stream);
    launch_ph<6>(p, stream); launch_ph<7>(p, stream); launch_ph<8>(p, stream); launch_ph<9>(p, stream); launch_ph<10>(p, stream); launch_ph<11>(p, stream);
    launch_ph<12>(p, stream); launch_ph<13>(p, stream); launch_ph<14>(p, stream); launch_ph<15>(p, stream); launch_ph<16>(p, stream); launch_ph<17>(p, stream);
    launch_ph<18>(p, stream); launch_ph<19>(p, stream); launch_ph<20>(p, stream); launch_ph<21>(p, stream); launch_ph<22>(p, stream);
#endif
}
```

```cpp
#include <cstdio>
#define MEGA 1
#define DUP_MASK 0
#define SCAN_REP 1
#include <hip/hip_runtime.h>
namespace pg8 {
#define PG8_LAS __attribute__((address_space(3)))
typedef unsigned short bf16_t;
typedef short bf16x8 __attribute__((ext_vector_type(8)));
typedef float f32x4 __attribute__((ext_vector_type(4)));
typedef unsigned u32x4 __attribute__((ext_vector_type(4)));
constexpr int BM = 256, BK = 64, HALF = 128, HTB = HALF * BK * 2  , STAGE_BYTES = 8 * HTB, NXCD = 8, WGM = 8;

__host__ __device__ __forceinline__ int lds_byte(int r, int c) { const int st = (r >> 4) * 2 + (c >> 5), rr = r & 15, cc = c & 31, ob = rr * 64 + cc * 2; return st * 1024 + (ob ^ (((ob >> 9) & 1) << 5)); }
__host__ __device__ __forceinline__ void stage_rc(int b, int& R, int& C) { const int st = b / 1024, sb = b % 1024, swz = sb ^ (((sb >> 9) & 1) << 5); R = (st >> 1) * 16 + swz / 64; C = (st & 1) * 32 + (swz % 64) / 2; }
__host__ __device__ __forceinline__ int perm32(int rho) { const int n = rho >> 4, i = rho & 15; return 8 * (i >> 2) + 4 * n + (i & 3); }

struct Unit { int pm, pn; };
struct Gemm { const bf16_t* A; const bf16_t* Bt; int M, N, K; };
struct StaticOrder {
    int nM, nN, nwg, G, c;
    __host__ __device__ void init(int M, int N, int G_, int c_) { nM = M / BM; nN = N / BM; nwg = nM * nN; G = G_; c = c_; }
    __host__ __device__ bool next(int i, Unit& u) const {
        const long L = (long)i * G + c; if (L >= nwg) return false;
        int wgid = (int)L; { const int q = nwg / NXCD, r = nwg % NXCD, xcd = wgid % NXCD, off = wgid / NXCD; wgid = (xcd < r ? xcd * (q + 1) : r * (q + 1) + (xcd - r) * q) + off; }
        const int nig = WGM * nN, gid = wgid / nig, fm = gid * WGM, gsz = (nM - fm) < WGM ? (nM - fm) : WGM;
        u.pm = fm + ((wgid % nig) % gsz); u.pn = (wgid % nig) / gsz; return true;
    }
    __device__ __forceinline__ void a_ready(const Unit&) const {}
    __device__ __forceinline__ void done(const Unit&) const {}
};
__device__ __forceinline__ unsigned cvt_pk_bf16(float lo, float hi) { unsigned r; asm volatile("v_cvt_pk_bf16_f32 %0, %1, %2" : "=v"(r) : "v"(lo), "v"(hi)); return r; }

template <class Epi, class Sched, bool STAMP = false>
__device__ __forceinline__ void gemm_phase(PG8_LAS unsigned char* lds, const Gemm g, const Sched& S, const Epi& E, unsigned long long* stamps) {
    int tid_ = threadIdx.x; asm volatile("" : "+v"(tid_)); const int tid = tid_, wid = __builtin_amdgcn_readfirstlane(tid >> 6), lane = tid & 63, wr = wid >> 2, wc = wid & 3, fr = lane & 15, fq = lane >> 4;
    const int K = g.K, nt = K / BK;
    int ts_lo = 0, ts_hi = 0, nts = 0; const unsigned long long rt_entry = STAMP ? (unsigned long long)wall_clock64() : 0ull;
#define PG8_STAMP() do { if (STAMP && wid == 0 && nts < 64) { const unsigned long long _c = (unsigned long long)clock64(); \
        ts_lo = (lane == nts) ? (int)(unsigned)_c : ts_lo; ts_hi = (lane == nts) ? (int)(unsigned)(_c >> 32) : ts_hi; ++nts; } } while (0)
    PG8_STAMP();
    unsigned voffA[2], voffB[2];
#pragma unroll
    for (int i = 0; i < 2; ++i) { int R, C; stage_rc(tid * 16 + i * 8192, R, C); const int Rb = Epi::PERM ? ((R & ~31) + perm32(R & 31)) : R;
        voffA[i] = (unsigned)(R * K + C) * 2u; voffB[i] = (unsigned)(Rb * K + C) * 2u; }
    const size_t kstep = (size_t)(BK * 2);
    const size_t hstep = (size_t)HALF * K * 2;
    const size_t tstep = 2 * hstep;
    const unsigned ldsw = (unsigned)wid * 1024u;
    const int aoff = lds_byte(wr * 64 + fr, fq * 8), boff = lds_byte(wc * 32 + fr, fq * 8);
#define PG8_SA(b, h) (((b) * 2 + (h)) * HTB)
#define PG8_SB(b, h) ((4 + (b) * 2 + (h)) * HTB)
#define PG8_STAGE(bufoff, gbase, voff) do { _Pragma("unroll") for (int _i = 0; _i < 2; ++_i) \
        __builtin_amdgcn_global_load_lds((const unsigned*)((const char*)(gbase) + (voff)[_i]), (PG8_LAS unsigned*)(lds + (bufoff) + ldsw + _i * 8192), 16, 0, 0); } while (0)
#define PG8_LDA(dst, b, h) do { _Pragma("unroll") for (int m = 0; m < 4; ++m) _Pragma("unroll") for (int k = 0; k < 2; ++k) dst[m][k] = *(const PG8_LAS bf16x8*)(lds + PG8_SA(b, h) + aoff + m * 2048 + k * 1024); } while (0)
#define PG8_LDB(dst, b, h) do { _Pragma("unroll") for (int n = 0; n < 2; ++n) _Pragma("unroll") for (int k = 0; k < 2; ++k) dst[n][k] = *(const PG8_LAS bf16x8*)(lds + PG8_SB(b, h) + boff + n * 2048 + k * 1024); } while (0)
#define PG8_MMA(ai, bj, At, Bt) do { __builtin_amdgcn_s_setprio(1); _Pragma("unroll") for (int m = 0; m < 4; ++m) _Pragma("unroll") for (int n = 0; n < 2; ++n) _Pragma("unroll") for (int k = 0; k < 2; ++k) \
        acc[ai][bj][m][n] = __builtin_amdgcn_mfma_f32_16x16x32_bf16(Bt[n][k], At[m][k], acc[ai][bj][m][n], 0, 0, 0); __builtin_amdgcn_s_setprio(0); } while (0)
#define PG8_WAIT_V(n) asm volatile("s_waitcnt vmcnt(" #n ")" ::: "memory")
#define PG8_WAIT_L(n) asm volatile("s_waitcnt lgkmcnt(" #n ")" ::: "memory")
#define PG8_BAR __builtin_amdgcn_s_barrier()
#define PG8_SCHED __builtin_amdgcn_sched_barrier(0)
    Unit cur, nxt; int ui = 0;
    if (!S.next(0, cur)) return;
    f32x4 acc[2][2][4][2];
#pragma unroll
    for (int a = 0; a < 2; ++a)
#pragma unroll
        for (int b = 0; b < 2; ++b)
#pragma unroll
            for (int m = 0; m < 4; ++m)
#pragma unroll
                for (int n = 0; n < 2; ++n) acc[a][b][m][n] = (f32x4){0.f, 0.f, 0.f, 0.f};
    bf16x8 At[4][2], B0[2][2], B1[2][2];
    const char* cA = (const char*)g.A + (size_t)cur.pm * tstep; const char* cB = (const char*)g.Bt + (size_t)cur.pn * tstep;
    S.a_ready(cur);
    PG8_STAGE(PG8_SB(0, 0), cB, voffB); PG8_STAGE(PG8_SA(0, 0), cA, voffA); PG8_STAGE(PG8_SB(0, 1), cB + hstep, voffB); PG8_STAGE(PG8_SA(0, 1), cA + hstep, voffA);
    if (wr == 1) PG8_BAR;
    PG8_WAIT_V(4); PG8_BAR;
    PG8_STAGE(PG8_SB(1, 0), cB + kstep, voffB); PG8_STAGE(PG8_SA(1, 0), cA + kstep, voffA); PG8_STAGE(PG8_SB(1, 1), cB + hstep + kstep, voffB);
    PG8_WAIT_V(6); PG8_BAR;
    PG8_STAMP();
    for (;;) {
        const bool has_next = S.next(ui + 1, nxt);
        const char* nA = has_next ? (const char*)g.A + (size_t)nxt.pm * tstep : cA; const char* nB = has_next ? (const char*)g.Bt + (size_t)nxt.pn * tstep : cB;
        for (int t = 0; t < nt; t += 2) {
            const bool last = (t == nt - 2);
            const char* a1 = cA + (size_t)(t + 1) * kstep;
            const char* a2 = last ? nA : cA + (size_t)(t + 2) * kstep; const char* b2 = last ? nB : cB + (size_t)(t + 2) * kstep;
            const char* a3 = a2 + kstep; const char* b3 = b2 + kstep;
            if (last && has_next) S.a_ready(nxt);
            PG8_LDB(B0, 0, 0); PG8_SCHED; PG8_LDA(At, 0, 0); PG8_STAGE(PG8_SA(1, 1), a1 + hstep, voffA);
            PG8_WAIT_L(8); PG8_BAR; PG8_WAIT_L(0); PG8_MMA(0, 0, At, B0); PG8_BAR; PG8_SCHED;
            PG8_LDB(B1, 0, 1); PG8_STAGE(PG8_SB(0, 0), b2, voffB);
            PG8_BAR; PG8_WAIT_L(0); PG8_MMA(0, 1, At, B1); PG8_BAR;
            PG8_LDA(At, 0, 1); PG8_STAGE(PG8_SA(0, 0), a2, voffA);
            PG8_BAR; PG8_WAIT_L(0); PG8_MMA(1, 0, At, B0); PG8_BAR; PG8_SCHED;
            PG8_STAGE(PG8_SB(0, 1), b2 + hstep, voffB);
            PG8_WAIT_V(6); PG8_BAR; PG8_MMA(1, 1, At, B1); PG8_BAR;
            PG8_LDB(B0, 1, 0); PG8_SCHED; PG8_LDA(At, 1, 0); PG8_STAGE(PG8_SA(0, 1), a2 + hstep, voffA);
            PG8_WAIT_L(8); PG8_BAR; PG8_WAIT_L(0); PG8_MMA(0, 0, At, B0); PG8_BAR; PG8_SCHED;
            PG8_LDB(B1, 1, 1); PG8_STAGE(PG8_SB(1, 0), b3, voffB);
            PG8_BAR; PG8_WAIT_L(0); PG8_MMA(0, 1, At, B1); PG8_BAR;
            PG8_LDA(At, 1, 1); PG8_STAGE(PG8_SA(1, 0), a3, voffA);
            PG8_BAR; PG8_WAIT_L(0); PG8_MMA(1, 0, At, B0); PG8_BAR; PG8_SCHED;
            PG8_STAGE(PG8_SB(1, 1), b3 + hstep, voffB);
            PG8_WAIT_V(6); PG8_BAR; PG8_MMA(1, 1, At, B1); PG8_BAR;
        }
        PG8_STAMP();
        if constexpr (!Epi::AFTER_DRAIN) { E(acc, cur, wr, wc, fr, fq); S.done(cur); }
        PG8_STAMP();
        if (!has_next) break;
#pragma unroll
        for (int a = 0; a < 2; ++a)
#pragma unroll
            for (int b = 0; b < 2; ++b)
#pragma unroll
                for (int m = 0; m < 4; ++m)
#pragma unroll
                    for (int n = 0; n < 2; ++n) acc[a][b][m][n] = (f32x4){0.f, 0.f, 0.f, 0.f};
        cur = nxt; cA = nA; cB = nB; ++ui;
    }
    PG8_WAIT_V(0);
    if (wr == 0) PG8_BAR;
    PG8_BAR;
    if constexpr (Epi::AFTER_DRAIN) { E.fused(acc, cur, wr, wc, fr, fq, lds, wid, lane); S.done(cur); }
    PG8_STAMP();
    if (STAMP && wid == 0) { stamps[lane] = lane < nts ? (((unsigned long long)(unsigned)ts_hi << 32) | (unsigned)ts_lo) : 0ull;
        if (lane == 62) stamps[62] = rt_entry; if (lane == 63) stamps[63] = (unsigned long long)wall_clock64(); }
#undef PG8_STAMP
#undef PG8_SA
#undef PG8_SB
#undef PG8_STAGE
#undef PG8_LDA
#undef PG8_LDB
#undef PG8_MMA
#undef PG8_WAIT_V
#undef PG8_WAIT_L
#undef PG8_BAR
#undef PG8_SCHED
}
}

#define XB_TMO      128
#define XB_XCNT(j)  (256  + 64 * (j))
#define XB_XSUB(j)  (1280 + 64 * (j))
#define XB_XGEN(j)  (2304 + 64 * (j))
#define XB_TOP      3328
#define XB_TOPGEN   3392
#define XCD_BAR_WORDS 3456
#define XB_SPIN_CAP (1u << 18)
#define LAS __attribute__((address_space(3)))

__device__ __forceinline__ unsigned xb_ld(unsigned* p)              { return __hip_atomic_load(p, __ATOMIC_RELAXED, __HIP_MEMORY_SCOPE_AGENT); }
__device__ __forceinline__ unsigned xb_add(unsigned* p, unsigned v) { return __hip_atomic_fetch_add(p, v, __ATOMIC_RELAXED, __HIP_MEMORY_SCOPE_AGENT); }
__device__ __forceinline__ unsigned xb_xcc_id() { return (unsigned)__builtin_amdgcn_s_getreg((3 << 11) | 20) & 0xFu; }
#define XB_SPIN(cond, bar) do { unsigned _sp = 0; while (cond) { __builtin_amdgcn_s_sleep(1); \
    if ((++_sp & 255u) == 0u) { if (xb_ld(&(bar)[XB_TMO])) break; if (_sp > XB_SPIN_CAP) { atomicAdd(&(bar)[XB_TMO], 1u); break; } } } } while (0)

struct XcdBarrier {
    unsigned* bar; unsigned x;
    volatile LAS unsigned* st;
};

__device__ __forceinline__ XcdBarrier xcd_barrier_post(unsigned* bar, volatile LAS unsigned* st) {
    XcdBarrier b; b.bar = bar; b.x = xb_xcc_id(); b.st = st;
    if (threadIdx.x == 0) (void)xb_add(&bar[XB_XCNT(b.x)], 1u);
    return b;
}
__device__ __forceinline__ void xcd_barrier_complete(unsigned* bar, unsigned x, unsigned& nloc, unsigned& nx) {
    const unsigned G = gridDim.x * gridDim.y * gridDim.z;
    unsigned sum, cnt, mine, sp = 0u;
    for (;;) {
        sum = 0u; cnt = 0u; mine = 0u;
#pragma unroll
        for (unsigned j = 0; j < 16; ++j) { const unsigned c = xb_ld(&bar[XB_XCNT(j)]); sum += c; cnt += (c > 0u) ? 1u : 0u; mine = (j == x) ? c : mine; }
        if (sum == G) break;
        __builtin_amdgcn_s_sleep(1);
        if ((++sp & 255u) == 0u) { if (xb_ld(&bar[XB_TMO])) break; if (sp > XB_SPIN_CAP) { atomicAdd(&bar[XB_TMO], 1u); break; } }
    }
    nloc = mine > 0u ? mine : 1u; nx = cnt > 0u ? cnt : 1u;
}

__device__ __forceinline__ void xcd_barrier(const XcdBarrier& b) {
    asm volatile("s_waitcnt vmcnt(0)" ::: "memory");
    __syncthreads();
    if (threadIdx.x == 0) {
        unsigned* bar = b.bar;
        __builtin_amdgcn_s_waitcnt(0);
        unsigned nloc = b.st[0], nx = b.st[1];
        if (nloc == 0u) { xcd_barrier_complete(bar, b.x, nloc, nx); b.st[0] = nloc; b.st[1] = nx; }
        const unsigned old = xb_add(&bar[XB_XSUB(b.x)], 1u);
        const unsigned gen = old / nloc;
        if (old + 1u == (gen + 1u) * nloc) {
            __builtin_amdgcn_fence(__ATOMIC_RELEASE, "agent");
            asm volatile("s_waitcnt vmcnt(0)" ::: "memory");
            const unsigned og = xb_add(&bar[XB_TOP], 1u);
            const unsigned tg = og / nx;
            if (og + 1u == (tg + 1u) * nx) xb_add(&bar[XB_TOPGEN], 1u);
            else XB_SPIN(xb_ld(&bar[XB_TOPGEN]) == tg, bar);
            __builtin_amdgcn_fence(__ATOMIC_ACQUIRE, "agent");
            xb_add(&bar[XB_XGEN(b.x)], 1u);
            asm volatile("s_waitcnt vmcnt(0)" ::: "memory");
        } else {
            XB_SPIN(xb_ld(&bar[XB_XGEN(b.x)]) == gen, bar);
            __builtin_amdgcn_fence(__ATOMIC_ACQUIRE, "agent");
            asm volatile("s_waitcnt vmcnt(0)" ::: "memory");
        }
    }
    __syncthreads();
}

#include <hip/hip_cooperative_groups.h>
namespace cg = cooperative_groups;
using pg8::bf16_t; using pg8::bf16x8; using pg8::f32x4; using pg8::u32x4;
typedef unsigned u32x2 __attribute__((ext_vector_type(2)));

#ifndef MEGA
#define MEGA 1
#endif

constexpr int T_ = 16384, DM = 2048, NPROJ = 18176, DFF = 8192, VTLD = T_ + 256;
constexpr size_t LDS_BYTES = 139264 + 16;
constexpr size_t LDS_BAR_ST = 139264;

constexpr size_t SZ_WT_IN = (size_t)NPROJ * DM * 2, SZ_WT_UP = (size_t)DFF * DM * 2, SZ_WT_DOWN = SZ_WT_UP, SZ_WT_OUT = (size_t)DM * DM * 2,
                 SZ_WT_BRA = (size_t)DM * 1024 * 2, SZ_WT_BRC = (size_t)DM * 512 * 2;
constexpr size_t O_WT_IN = 0, O_WT_UP = O_WT_IN + SZ_WT_IN, O_WT_DOWN = O_WT_UP + SZ_WT_UP, O_WT_OUT = O_WT_DOWN + SZ_WT_DOWN, O_WT_BRA = O_WT_OUT + SZ_WT_OUT,
                 O_WT_BRB = O_WT_BRA + SZ_WT_BRA, O_WT_BRC = O_WT_BRB + SZ_WT_BRA, O_XN = O_WT_BRC + SZ_WT_BRC;
constexpr size_t O_VT = O_XN;
constexpr size_t O_AQKV = O_XN + (size_t)T_ * DM * 2;
constexpr size_t O_SB = O_AQKV + (size_t)T_ * 3072 * 2;
constexpr size_t O_OFWD = O_AQKV, O_OBWD = O_OFWD + (size_t)T_ * 1024 * 4, O_TINV = O_OBWD + (size_t)T_ * 1024 * 4, O_AIN = O_TINV + (size_t)4096 * 4096 * 2;
constexpr size_t O_MACC = O_OFWD;
constexpr size_t O_SZ = O_SB + (size_t)T_ * 3072 * 2;
constexpr size_t O_CQ = O_SZ + (size_t)T_ * 1024 * 2;
constexpr size_t O_CK = O_CQ + (size_t)T_ * 1536 * 2, O_CV = O_CK + (size_t)T_ * 1536 * 2;
constexpr size_t O_GATES = O_CV + (size_t)T_ * 1536 * 2;
constexpr size_t O_HID = O_CQ;
constexpr size_t O_AB = O_GATES + (size_t)T_ * 6144 * 2;
constexpr size_t O_QKV = O_AB + (size_t)T_ * 32 * 4;
constexpr size_t O_KT = O_QKV + (size_t)T_ * 3072 * 2;
constexpr size_t O_G = O_KT + (size_t)T_ * 1024 * 2;
constexpr size_t O_BETA = O_G + (size_t)T_ * 16 * 4;
constexpr size_t O_YA = O_BETA + (size_t)T_ * 16 * 4;
constexpr size_t O_YB = O_YA + (size_t)T_ * 1024 * 2;
constexpr size_t O_YC = O_YB + (size_t)T_ * 1024 * 2;
constexpr size_t O_GCP = O_YC + (size_t)T_ * 512 * 2;
constexpr size_t O_OG = O_GCP + (size_t)4096 * 64 * 4;
constexpr size_t O_LSE = O_OG + (size_t)3 * T_ * 512 * 2;
constexpr size_t O_BAR = O_LSE + (size_t)3 * T_ * 4 * 4;
constexpr size_t O_QCTR = O_BAR + (size_t)XCD_BAR_WORDS * 4;
constexpr size_t O_SSQ = O_QCTR + 512;
constexpr size_t O_WT_UP1 = O_SSQ + (size_t)5 * T_ * 4, O_WT_DOWN1 = O_WT_UP1 + SZ_WT_UP;
constexpr size_t WS_NEED = O_WT_DOWN1 + SZ_WT_DOWN;
constexpr size_t O_HB2 = O_AQKV;
static_assert((size_t)3 * 512 * VTLD * 2 <= (size_t)T_ * DM * 2, "vT alias");
static_assert(O_AIN + (size_t)4096 * 4096 * 2 <= O_SZ, "alias AQKV|SB");
static_assert(O_HID + (size_t)T_ * DFF * 2 <= O_AB, "alias hidden");
static_assert(WS_NEED < (size_t)1176000000, "workspace");

struct Params {
    const float* x_prompt; const float* x_sample; const float* rel_bias; const float* norm_mix; const float* w_in; const float* conv_a; const float* a_log; const float* dt_bias;
    const float* head_norm; const float* conv_b; const float* w_br_a; const float* w_br_b; const float* w_br_c; const float* w_out; const float* norm_mlp; const float* w_up;
    const float* w_down; const float* norm_final; float* out; unsigned char* ws;
};

__device__ __forceinline__ float bf2f(unsigned short b) { return __uint_as_float(((unsigned)b) << 16); }
__device__ __forceinline__ float bflo(unsigned u) { return __uint_as_float(u << 16); }
__device__ __forceinline__ float bfhi(unsigned u) { return __uint_as_float(u & 0xffff0000u); }
__device__ __forceinline__ unsigned pk2(float lo, float hi) { return pg8::cvt_pk_bf16(lo, hi); }
__device__ __forceinline__ unsigned short f2bf(float f) { return (unsigned short)(pk2(f, 0.f) & 0xffffu); }
__device__ __forceinline__ float sigmoidf_(float x) { return __builtin_amdgcn_rcpf(1.0f + __expf(-x)); }
__device__ __forceinline__ float siluf_(float x) { return x * __builtin_amdgcn_rcpf(1.0f + __expf(-x)); }
__device__ __forceinline__ void seq_of(int t, int& s0, int& L) { if (t < 8192) { s0 = t & ~4095; L = 4096; } else { s0 = t & ~2047; L = 2048; } }
__device__ __forceinline__ bf16x8 mk8(u32x2 a, u32x2 b) { u32x4 w; w.x = a.x; w.y = a.y; w.z = b.x; w.w = b.y; return __builtin_bit_cast(bf16x8, w); }
__device__ __forceinline__ bf16x8 pack8(f32x4 a, f32x4 b) { u32x4 w; w.x = pk2(a[0], a[1]); w.y = pk2(a[2], a[3]); w.z = pk2(b[0], b[1]); w.w = pk2(b[2], b[3]); return __builtin_bit_cast(bf16x8, w); }
__device__ __forceinline__ int tid_l() { int t = threadIdx.x; asm volatile("" : "+v"(t)); return t; }
__device__ __forceinline__ int bid_l() { int b = blockIdx.x; asm volatile("" : "+s"(b)); return b; }
#define MFMA16(a, b, c) __builtin_amdgcn_mfma_f32_16x16x32_bf16((a), (b), (c), 0, 0, 0)
#define LDS_WAIT() asm volatile("s_waitcnt lgkmcnt(0)" ::: "memory")

__device__ void conv_tiles(const float* __restrict__ W, int K, int ldn, int ntn, bf16_t* __restrict__ Wt, int mode, const float* __restrict__ kscale) {
    const int nkt = K >> 5, total = ntn * nkt, tid = tid_l(), lane = tid & 63;
    for (int it = bid_l() * 8 + (tid >> 6); it < total; it += gridDim.x * 8) {
        const int tn = it / nkt, tk = it - tn * nkt, n0 = tn * 64, k0 = tk * 32;
        int src0 = n0, nvalid = 64;
        if (mode == 1) { if (n0 >= 17920) { src0 = 4096; nvalid = 32; } else if (n0 >= 4096) src0 = n0 + 32; }
        if (lane < nvalid) {
            const float* src = W + (size_t)k0 * ldn + src0 + lane;
            float v[32];
#pragma unroll
            for (int j = 0; j < 32; ++j) v[j] = src[(size_t)j * ldn];
            if (kscale) {
#pragma unroll
                for (int j = 0; j < 32; ++j) v[j] *= kscale[k0 + j]; }
            bf16_t* dst = Wt + (size_t)(n0 + lane) * K + k0;
#pragma unroll
            for (int q = 0; q < 4; ++q) { u32x4 w; w.x = pk2(v[8 * q], v[8 * q + 1]); w.y = pk2(v[8 * q + 2], v[8 * q + 3]); w.z = pk2(v[8 * q + 4], v[8 * q + 5]); w.w = pk2(v[8 * q + 6], v[8 * q + 7]);
                *(u32x4*)(dst + 8 * q) = w; }
        }
    }
}

__device__ void conv_queue(const float* __restrict__ W, int K, int ldn, int ntn, bf16_t* __restrict__ Wt, const float* __restrict__ kscale, unsigned* qctr, unsigned char* smem) {
    const int nkt = K >> 5, total = ntn * nkt, nbatch = (total + 63) >> 6, tid = tid_l(), lane = tid & 63, wid = tid >> 6;
    volatile LAS unsigned* slot = (volatile LAS unsigned*)(smem + LDS_BAR_ST) + 2;
    for (;;) {
        __syncthreads();
        if (tid == 0) *slot = __hip_atomic_fetch_add(qctr, 1u, __ATOMIC_RELAXED, __HIP_MEMORY_SCOPE_AGENT);
        __syncthreads();
        const int bi = (int)*slot;
        if (bi >= nbatch) break;
#pragma unroll 1
        for (int sub = 0; sub < 8; ++sub) {
            const int it = bi * 64 + sub * 8 + wid; if (it >= total) break;
            const int tn = it / nkt, tk = it - tn * nkt, n0 = tn * 64, k0 = tk * 32;
            const float* src = W + (size_t)k0 * ldn + n0 + lane;
            float v[32];
#pragma unroll
            for (int j = 0; j < 32; ++j) v[j] = src[(size_t)j * ldn];
            if (kscale) {
#pragma unroll
                for (int j = 0; j < 32; ++j) v[j] *= kscale[k0 + j]; }
            bf16_t* dst = Wt + (size_t)(n0 + lane) * K + k0;
#pragma unroll
            for (int q = 0; q < 4; ++q) { u32x4 w; w.x = pk2(v[8 * q], v[8 * q + 1]); w.y = pk2(v[8 * q + 2], v[8 * q + 3]); w.z = pk2(v[8 * q + 4], v[8 * q + 5]); w.w = pk2(v[8 * q + 6], v[8 * q + 7]);
                *(u32x4*)(dst + 8 * q) = w; }
        }
    }
}

__device__ void norm_rows(const Params& p, int mode, const float* __restrict__ w, bf16_t* __restrict__ hb) {
    const int tid = tid_l(), lane = tid & 63, gw = bid_l() * 8 + (tid >> 6), nw = gridDim.x * 8;
    float* ssq = (float*)(p.ws + O_SSQ);
    for (int t = gw; t < T_; t += nw) {
        const float* src = (mode == 0) ? (t < 8192 ? p.x_prompt + (size_t)t * DM : p.x_sample + (size_t)(t - 8192) * DM) : p.out + (size_t)t * DM;
        float4 v[8];
#pragma unroll
        for (int i = 0; i < 8; ++i) v[i] = *(const float4*)(src + i * 256 + lane * 4);
        if (mode == 0) {
            float ss = 0.f;
#pragma unroll
            for (int i = 0; i < 8; ++i) ss += v[i].x * v[i].x + v[i].y * v[i].y + v[i].z * v[i].z + v[i].w * v[i].w;
#pragma unroll
            for (int off = 32; off > 0; off >>= 1) ss += __shfl_xor(ss, off);
            if (lane < 5) ssq[(size_t)lane * T_ + t] = (lane == 0) ? ss : 0.f;
#pragma unroll
            for (int i = 0; i < 8; ++i) { u32x2 o; o.x = pk2(v[i].x, v[i].y); o.y = pk2(v[i].z, v[i].w); *(u32x2*)(hb + (size_t)t * DM + i * 256 + lane * 4) = o;
 }
        } else {
            const float rstd = rsqrtf(ssq[(size_t)4 * T_ + t] * (1.0f / DM) + 1e-6f);
#pragma unroll
            for (int i = 0; i < 8; ++i) { const float4 wv = *(const float4*)(w + i * 256 + lane * 4);
                *(float4*)(p.out + (size_t)t * DM + i * 256 + lane * 4) = make_float4(v[i].x * rstd * wv.x, v[i].y * rstd * wv.y, v[i].z * rstd * wv.z, v[i].w * rstd * wv.w); }
        }
    }
}

struct EpiProj {
    static constexpr bool PERM = true, AFTER_DRAIN = false;
    unsigned char* ws; const float* ssq;
    __device__ __forceinline__ void operator()(const f32x4 (&acc)[2][2][4][2], const pg8::Unit& u, int wr, int wc, int fr, int fq) const {
        const int pn = u.pn, row0 = u.pm * 256 + wr * 64 + fr;
        float rs[2][4];
#pragma unroll
        for (int ai = 0; ai < 2; ++ai)
#pragma unroll
            for (int m = 0; m < 4; ++m) rs[ai][m] = rsqrtf(ssq[row0 + ai * 128 + m * 16] * (1.0f / DM) + 1e-6f);
        if (pn == 70) {
            if (wc == 0) { float* ab = (float*)(ws + O_AB);
#pragma unroll
                for (int ai = 0; ai < 2; ++ai)
#pragma unroll
                    for (int m = 0; m < 4; ++m) { float* rp = ab + (size_t)(row0 + ai * 128 + m * 16) * 32 + 8 * fq; *(f32x4*)rp = acc[ai][0][m][0] * rs[ai][m]; *(f32x4*)(rp + 4) = acc[ai][0][m][1] * rs[ai][m]; } }
            return;
        }
        bf16_t* base; int ldc, colt;
        if (pn < 12) { base = (bf16_t*)(ws + O_AQKV); ldc = 3072; colt = pn * 256; }
        else if (pn < 16) { base = (bf16_t*)(ws + O_SZ); ldc = 1024; colt = (pn - 12) * 256; }
        else if (pn < 28) { base = (bf16_t*)(ws + O_SB); ldc = 3072; colt = (pn - 16) * 256; }
        else if (pn < 46) { const int s = (pn - 28) / 6; base = (bf16_t*)(ws + O_CQ) + (size_t)s * T_ * 1536; ldc = 1536; colt = ((pn - 28) - s * 6) * 256; }
        else { base = (bf16_t*)(ws + O_GATES); ldc = 6144; colt = (pn - 46) * 256; }
        const int col0 = colt + wc * 32 + 8 * fq;
#pragma unroll
        for (int ai = 0; ai < 2; ++ai)
#pragma unroll
            for (int m = 0; m < 4; ++m) { bf16_t* rowp = base + (size_t)(row0 + ai * 128 + m * 16) * ldc + col0;
#pragma unroll
                for (int bj = 0; bj < 2; ++bj) { const f32x4 v0 = acc[ai][bj][m][0] * rs[ai][m], v1 = acc[ai][bj][m][1] * rs[ai][m];
                    u32x4 w; w.x = pk2(v0[0], v0[1]); w.y = pk2(v0[2], v0[3]); w.z = pk2(v1[0], v1[1]); w.w = pk2(v1[2], v1[3]);
                    *(u32x4*)(rowp + bj * 128) = w; } }
    }
};
struct EpiUp {
    static constexpr bool PERM = true, AFTER_DRAIN = false;
    bf16_t* O; const float* ssq;
    __device__ __forceinline__ void operator()(const f32x4 (&acc)[2][2][4][2], const pg8::Unit& u, int wr, int wc, int fr, int fq) const {
        const int row0 = u.pm * 256 + wr * 64 + fr, col0 = u.pn * 256 + wc * 32 + 8 * fq;
        float rs[2][4];
#pragma unroll
        for (int ai = 0; ai < 2; ++ai)
#pragma unroll
            for (int m = 0; m < 4; ++m) rs[ai][m] = rsqrtf(ssq[row0 + ai * 128 + m * 16] * (1.0f / DM) + 1e-6f);
#pragma unroll
        for (int ai = 0; ai < 2; ++ai)
#pragma unroll
            for (int m = 0; m < 4; ++m) { bf16_t* rowp = O + (size_t)(row0 + ai * 128 + m * 16) * DFF + col0;
#pragma unroll
                for (int bj = 0; bj < 2; ++bj) { f32x4 v0 = acc[ai][bj][m][0], v1 = acc[ai][bj][m][1];
#pragma unroll
                    for (int j = 0; j < 4; ++j) { const float a = fmaxf(v0[j] * rs[ai][m], 0.f), b = fmaxf(v1[j] * rs[ai][m], 0.f); v0[j] = a * a; v1[j] = b * b; }
                    u32x4 w; w.x = pk2(v0[0], v0[1]); w.y = pk2(v0[2], v0[3]); w.z = pk2(v1[0], v1[1]); w.w = pk2(v1[2], v1[3]);
                    *(u32x4*)(rowp + bj * 128) = w; } }
    }
};
struct EpiResid {
    static constexpr bool PERM = true, AFTER_DRAIN = false;
    float* C; bf16_t* hb; float* ssq; const float* xp; const float* xs;
    __device__ __forceinline__ void operator()(const f32x4 (&acc)[2][2][4][2], const pg8::Unit& u, int wr, int wc, int fr, int fq) const {
        const int row0 = u.pm * 256 + wr * 64 + fr, col0 = u.pn * 256 + wc * 32 + 8 * fq;
        const float* src = xp ? (u.pm < 32 ? xp : xs - (size_t)8192 * DM) : C;
#pragma unroll
        for (int ai = 0; ai < 2; ++ai) {
            f32x4 old[4][2][2];
#pragma unroll
            for (int m = 0; m < 4; ++m)
#pragma unroll
                for (int bj = 0; bj < 2; ++bj)
#pragma unroll
                    for (int n = 0; n < 2; ++n) old[m][bj][n] = *(const f32x4*)(src + (size_t)(row0 + ai * 128 + m * 16) * DM + col0 + bj * 128 + n * 4);
            asm volatile("" ::: "memory");
#pragma unroll
            for (int m = 0; m < 4; ++m) { const size_t row = (size_t)(row0 + ai * 128 + m * 16); float* rowp = C + row * DM + col0; bf16_t* hrow = hb + row * DM + col0; float part = 0.f;
#pragma unroll
                for (int bj = 0; bj < 2; ++bj) { const f32x4 v0 = old[m][bj][0] + acc[ai][bj][m][0], v1 = old[m][bj][1] + acc[ai][bj][m][1];
                    *(f32x4*)(rowp + bj * 128) = v0; *(f32x4*)(rowp + bj * 128 + 4) = v1;
                    u32x4 o; o.x = pk2(v0[0], v0[1]); o.y = pk2(v0[2], v0[3]); o.z = pk2(v1[0], v1[1]); o.w = pk2(v1[2], v1[3]); *(u32x4*)(hrow + bj * 128) = o;
                    part += v0[0] * v0[0] + v0[1] * v0[1] + v0[2] * v0[2] + v0[3] * v0[3] + v1[0] * v1[0] + v1[1] * v1[1] + v1[2] * v1[2] + v1[3] * v1[3]; }
                part += __shfl_xor(part, 16); part += __shfl_xor(part, 32);
                if (fq == 0) (void)__hip_atomic_fetch_add(ssq + row, part, __ATOMIC_RELAXED, __HIP_MEMORY_SCOPE_AGENT); }
        }
    }
};
struct EpiBranch {
    static constexpr bool PERM = true, AFTER_DRAIN = false;
    bf16_t* merged; const bf16_t* gates; int goff, mode;
    __device__ __forceinline__ void operator()(const f32x4 (&acc)[2][2][4][2], const pg8::Unit& u, int wr, int wc, int fr, int fq) const {
        const int row0 = u.pm * 256 + wr * 64 + fr, col0 = u.pn * 256 + wc * 32 + 8 * fq;
#pragma unroll
        for (int ai = 0; ai < 2; ++ai) {
            u32x4 gw[4][2], old[4][2];
#pragma unroll
            for (int m = 0; m < 4; ++m)
#pragma unroll
                for (int bj = 0; bj < 2; ++bj) { const size_t row = (size_t)(row0 + ai * 128 + m * 16); const int col = col0 + bj * 128;
                    gw[m][bj] = *(const u32x4*)(gates + row * 6144 + goff + col);
                    old[m][bj] = (mode != 0) ? *(const u32x4*)(merged + row * DM + col) : (u32x4){0u, 0u, 0u, 0u}; }
            asm volatile("" ::: "memory");
#pragma unroll
            for (int m = 0; m < 4; ++m)
#pragma unroll
                for (int bj = 0; bj < 2; ++bj) { const size_t row = (size_t)(row0 + ai * 128 + m * 16); const int col = col0 + bj * 128;
                    const u32x4 g = gw[m][bj], od = old[m][bj];
                    const f32x4 v0 = acc[ai][bj][m][0], v1 = acc[ai][bj][m][1];
                    u32x4 o;
                    o.x = pk2(v0[0] * sigmoidf_(bflo(g.x)) + bflo(od.x), v0[1] * sigmoidf_(bfhi(g.x)) + bfhi(od.x));
                    o.y = pk2(v0[2] * sigmoidf_(bflo(g.y)) + bflo(od.y), v0[3] * sigmoidf_(bfhi(g.y)) + bfhi(od.y));
                    o.z = pk2(v1[0] * sigmoidf_(bflo(g.z)) + bflo(od.z), v1[1] * sigmoidf_(bfhi(g.z)) + bfhi(od.z));
                    o.w = pk2(v1[2] * sigmoidf_(bflo(g.w)) + bflo(od.w), v1[3] * sigmoidf_(bfhi(g.w)) + bfhi(od.w));
                    *(u32x4*)(merged + row * DM + col) = o; }
        }
    }
};

template <class Epi> __device__ __forceinline__ void run_gemm(unsigned char* smem, const bf16_t* A, const bf16_t* Bt, int M, int N, int K, const Epi& E) {
    pg8::Gemm g; g.A = A; g.Bt = Bt; g.M = M; g.N = N; g.K = K;
    pg8::StaticOrder S; S.init(M, N, (int)gridDim.x, bid_l());
    pg8::gemm_phase<Epi, pg8::StaticOrder, false>((PG8_LAS unsigned char*)smem, g, S, E, nullptr);
}

__device__ void prep_phase(const Params& p, int L, unsigned char* smem) {
    const int tid = tid_l(), wid = tid >> 6, lane = tid & 63, gw = bid_l() * 8 + wid, nw = gridDim.x * 8;
    unsigned char* ws = p.ws;
    const bf16_t* AQ = (const bf16_t*)(ws + O_AQKV); const bf16_t* SB = (const bf16_t*)(ws + O_SB);
    bf16_t* QKV = (bf16_t*)(ws + O_QKV); bf16_t* KT = (bf16_t*)(ws + O_KT); bf16_t* YB = (bf16_t*)(ws + O_YB);
    const float* ca = p.conv_a + (size_t)L * 3 * 3072; const float* cb = p.conv_b + (size_t)L * 3 * 1024;
    for (int it = gw; it < 16384; it += nw) {
        const int hc_ = it >> 3, h = hc_ & 7, ch = hc_ >> 3, cloc = (it & 7) * 8, tw = ch * 64 + cloc;
        int s0, Ls; seq_of(tw, s0, Ls);
        const bool v0 = tw - 1 >= s0, v9 = tw + 8 < s0 + Ls;
        float qv[3][8][2];
#pragma unroll
        for (int part = 0; part < 3; ++part) {
            const int col = part * 1024 + h * 128 + 2 * lane;
            const float2 w0 = *(const float2*)(ca + col), w1 = *(const float2*)(ca + 3072 + col), w2 = *(const float2*)(ca + 6144 + col);
            unsigned x[10];
#pragma unroll
            for (int j = 0; j < 10; ++j) { const bool ok = (j == 0) ? v0 : ((j == 9) ? v9 : true); x[j] = ok ? *(const unsigned*)(AQ + (size_t)(tw - 1 + j) * 3072 + col) : 0u; }
#pragma unroll
            for (int i = 0; i < 8; ++i) {
                qv[part][i][0] = siluf_(w0.x * bflo(x[i]) + w1.x * bflo(x[i + 1]) + w2.x * bflo(x[i + 2]));
                qv[part][i][1] = siluf_(w0.y * bfhi(x[i]) + w1.y * bfhi(x[i + 1]) + w2.y * bfhi(x[i + 2])); }
        }
        const int cbn = h * 128 + 2 * lane;
        unsigned sc[10], sh[10], sg[8];
#pragma unroll
        for (int j = 0; j < 10; ++j) { const bool ok = (j == 0) ? v0 : ((j == 9) ? v9 : true);
            const bf16_t* rp = SB + (size_t)(tw - 1 + j) * 3072 + cbn;
            sc[j] = ok ? *(const unsigned*)(rp + 1024) : 0u; sh[j] = ok ? *(const unsigned*)(rp + 2048) : 0u; }
#pragma unroll
        for (int i = 0; i < 8; ++i) sg[i] = *(const unsigned*)(SB + (size_t)(tw + i) * 3072 + cbn);
        float sq[8], sk[8];
#pragma unroll
        for (int i = 0; i < 8; ++i) { sq[i] = qv[0][i][0] * qv[0][i][0] + qv[0][i][1] * qv[0][i][1]; sk[i] = qv[1][i][0] * qv[1][i][0] + qv[1][i][1] * qv[1][i][1]; }
#pragma unroll
        for (int off = 32; off > 0; off >>= 1)
#pragma unroll
            for (int i = 0; i < 8; ++i) { sq[i] += __shfl_xor(sq[i], off); sk[i] += __shfl_xor(sk[i], off); }
        unsigned klo[8], khi[8];
#pragma unroll
        for (int i = 0; i < 8; ++i) {
            const int t = tw + i;
            const float rq = rsqrtf(sq[i] + 1e-6f) * 0.08838834764831845f, rk = rsqrtf(sk[i] + 1e-6f);
            const unsigned qo = pk2(qv[0][i][0] * rq, qv[0][i][1] * rq), ko = pk2(qv[1][i][0] * rk, qv[1][i][1] * rk), vo = pk2(qv[2][i][0], qv[2][i][1]);
            bf16_t* orow = QKV + (size_t)t * 3072 + h * 128 + 2 * lane;
            *(unsigned*)(orow) = qo; *(unsigned*)(orow + 1024) = ko; *(unsigned*)(orow + 2048) = vo;
            klo[i] = ko & 0xffffu; khi[i] = ko >> 16; }
        { u32x4 a, b; a.x = klo[0] | (klo[1] << 16); a.y = klo[2] | (klo[3] << 16); a.z = klo[4] | (klo[5] << 16); a.w = klo[6] | (klo[7] << 16);
          b.x = khi[0] | (khi[1] << 16); b.y = khi[2] | (khi[3] << 16); b.z = khi[4] | (khi[5] << 16); b.w = khi[6] | (khi[7] << 16);
          bf16_t* dst = KT + ((size_t)(ch * 8 + h) * 128 + 2 * lane) * 64 + cloc;
          *(u32x4*)dst = a; *(u32x4*)(dst + 64) = b; }
        { const float2 w0 = *(const float2*)(cb + cbn), w1 = *(const float2*)(cb + 1024 + cbn), w2 = *(const float2*)(cb + 2048 + cbn);
          float u[10][2];
#pragma unroll
          for (int j = 0; j < 10; ++j) { u[j][0] = bflo(sc[j]) * bflo(sh[j]); u[j][1] = bfhi(sc[j]) * bfhi(sh[j]); }
#pragma unroll
          for (int i = 0; i < 8; ++i) {
              const float ya = bflo(sg[i]) * (w0.x * u[i][0] + w1.x * u[i + 1][0] + w2.x * u[i + 2][0]);
              const float yb = bfhi(sg[i]) * (w0.y * u[i][1] + w1.y * u[i + 1][1] + w2.y * u[i + 2][1]);
              *(unsigned*)(YB + (size_t)(tw + i) * 1024 + cbn) = pk2(ya, yb); } }
        if (h == 0 && lane < 8) {
            const float* AB = (const float*)(ws + O_AB); float* G = (float*)(ws + O_G); float* BT = (float*)(ws + O_BETA); const int tok = tw + lane;
#pragma unroll
            for (int q4 = 0; q4 < 4; ++q4) { const f32x4 a4 = *(const f32x4*)(AB + (size_t)tok * 32 + q4 * 4), b4 = *(const f32x4*)(AB + (size_t)tok * 32 + 16 + q4 * 4); f32x4 go, bo;
#pragma unroll
                for (int j = 0; j < 4; ++j) { const int dh = q4 * 4 + j; const float a = a4[j] + p.dt_bias[L * 16 + dh];
                    const float sp = fmaxf(a, 0.f) + log1pf(__expf(-fabsf(a)));
                    go[j] = -__expf(p.a_log[L * 16 + dh]) * sp; bo[j] = sigmoidf_(b4[j]); }
                *(f32x4*)(G + (size_t)tok * 16 + q4 * 4) = go; *(f32x4*)(BT + (size_t)tok * 16 + q4 * 4) = bo; }
        }
    }
    const bf16_t* CV = (const bf16_t*)(ws + O_CV); bf16_t* VT = (bf16_t*)(ws + O_VT);
    for (int it = gw; it < 6144; it += nw) {
        const int hc = it % 12, hf = it / 12, g = hc >> 2, hq = hc & 3, t0 = hf * 32, dsh = g * 2, D = 1 << dsh;
        int s0, Ls; seq_of(t0, s0, Ls); const int l = Ls >> dsh;
        unsigned xv[32];
#pragma unroll
        for (int j = 0; j < 32; ++j) xv[j] = *(const unsigned*)(CV + (size_t)(t0 + j) * 1536 + hc * 128 + 2 * lane);
        bf16_t* vrow = VT + (size_t)g * 512 * VTLD + (size_t)(hq * 128 + 2 * lane) * VTLD + 128;
        if (g == 0) {
#pragma unroll
            for (int u = 0; u < 8; ++u) { const int col = t0 + 4 * u; u32x2 lo, hi;
                lo.x = (xv[4 * u] & 0xffffu) | (xv[4 * u + 1] << 16); lo.y = (xv[4 * u + 2] & 0xffffu) | (xv[4 * u + 3] << 16);
                hi.x = (xv[4 * u] >> 16) | (xv[4 * u + 1] & 0xffff0000u); hi.y = (xv[4 * u + 2] >> 16) | (xv[4 * u + 3] & 0xffff0000u);
                *(u32x2*)(vrow + col) = lo; *(u32x2*)(vrow + VTLD + col) = hi; }
        } else if (g == 1) {
#pragma unroll
            for (int r = 0; r < 4; ++r)
#pragma unroll
                for (int m0 = 0; m0 < 8; m0 += 4) { const int col = s0 + r * l + ((t0 - s0) >> 2) + m0; u32x2 lo, hi;
                    const unsigned e0 = xv[(m0 + 0) * 4 + r], e1 = xv[(m0 + 1) * 4 + r], e2 = xv[(m0 + 2) * 4 + r], e3 = xv[(m0 + 3) * 4 + r];
                    lo.x = (e0 & 0xffffu) | (e1 << 16); lo.y = (e2 & 0xffffu) | (e3 << 16); hi.x = (e0 >> 16) | (e1 & 0xffff0000u); hi.y = (e2 >> 16) | (e3 & 0xffff0000u);
                    *(u32x2*)(vrow + col) = lo; *(u32x2*)(vrow + VTLD + col) = hi; }
        } else {
#pragma unroll
            for (int r = 0; r < 16; ++r) { const int col = s0 + r * l + ((t0 - s0) >> 4);
                const unsigned e0 = xv[r], e1 = xv[16 + r];
                *(unsigned*)(vrow + col) = (e0 & 0xffffu) | (e1 << 16); *(unsigned*)(vrow + VTLD + col) = (e0 >> 16) | (e1 & 0xffff0000u); }
        }
        if (hf == 0) {
            bf16_t* rowp = VT + (size_t)g * 512 * VTLD + (size_t)(hq * 128) * VTLD; const u32x4 z = {0u, 0u, 0u, 0u};
            for (int q = lane; q < 128 * 32; q += 64) { const int d = q >> 5, piece = q & 31; const int coff = piece < 16 ? piece * 8 : 128 + T_ + (piece - 16) * 8;
                *(u32x4*)(rowp + (size_t)d * VTLD + coff) = z; }
        }
    }
}

__device__ void gdn_local(const Params& p, unsigned char* smem) {
    const int tid = tid_l(), wid = tid >> 6, lane = tid & 63, fr = lane & 15, fq = lane >> 4;
    unsigned char* ws = p.ws;
    float* Lm = (float*)(smem + wid * 16384);
    float* gcs = (float*)(smem + 131072 + wid * 512); float* bts = gcs + 64;
    const float* G = (const float*)(ws + O_G); const float* BT = (const float*)(ws + O_BETA); const bf16_t* QKV = (const bf16_t*)(ws + O_QKV);
    float* GCP = (float*)(ws + O_GCP); bf16_t* TG = (bf16_t*)(ws + O_TINV); bf16_t* AG = (bf16_t*)(ws + O_AIN);
    for (int item = bid_l() * 8 + wid; item < 4096; item += gridDim.x * 8) {
        const int dir = item & 1, h = (item >> 1) & 7, ch = item >> 4, t0 = ch * 64;
        const int pl = dir ? 63 - lane : lane;
        float gc = G[(size_t)(t0 + pl) * 16 + dir * 8 + h];
        const float bt = BT[(size_t)(t0 + pl) * 16 + dir * 8 + h];
#pragma unroll
        for (int off = 1; off < 64; off <<= 1) { const float v = __shfl_up(gc, off); if (lane >= off) gc += v; }
        LDS_WAIT();
        gcs[lane] = gc; bts[lane] = bt;
        GCP[(size_t)item * 64 + pl] = gc;
        LDS_WAIT();
        {
            bf16x8 kf[4][4];
#pragma unroll
            for (int mt = 0; mt < 4; ++mt) { const int a = mt * 16 + fr, pp = dir ? 63 - a : a;
#pragma unroll
                for (int kb = 0; kb < 4; ++kb) kf[mt][kb] = *(const bf16x8*)(QKV + (size_t)(t0 + pp) * 3072 + 1024 + h * 128 + kb * 32 + fq * 8); }
#pragma unroll
            for (int mt = 0; mt < 4; ++mt)
#pragma unroll
                for (int nt = 0; nt <= mt; ++nt) { f32x4 acc = {0.f, 0.f, 0.f, 0.f};
#pragma unroll
                    for (int kb = 0; kb < 4; ++kb) acc = MFMA16(kf[mt][kb], kf[nt][kb], acc);
                    const int b = nt * 16 + fr; const float gb = gcs[b];
#pragma unroll
                    for (int j = 0; j < 4; ++j) { const int a = mt * 16 + fq * 4 + j;
                        Lm[a * 64 + b] = (a > b) ? acc[j] * bts[a] * __expf(gcs[a] - gb) : 0.f; } }
        }
        LDS_WAIT();
        float x[64];
#pragma unroll
        for (int i = 0; i < 64; ++i) { int ln = lane; asm volatile("" : "+v"(ln)); float s = (i == ln) ? 1.f : 0.f;
#pragma unroll
            for (int j = 0; j < i; ++j) s -= Lm[i * 64 + j] * x[j];
            x[i] = s; asm volatile("" ::: "memory"); }
        LDS_WAIT();
        {
            unsigned short* Xs = (unsigned short*)Lm; const int idx0 = dir ? 4095 - lane : lane, st = dir ? -64 : 64;
#pragma unroll
            for (int a = 0; a < 64; a += 2) { const unsigned w = pk2(x[a], x[a + 1]); Xs[idx0 + a * st] = (unsigned short)(w & 0xffffu); Xs[idx0 + (a + 1) * st] = (unsigned short)(w >> 16); }
            LDS_WAIT();
            u32x4* dst = (u32x4*)(TG + (size_t)item * 4096);
#pragma unroll
            for (int k = 0; k < 8; ++k) dst[k * 64 + lane] = ((const u32x4*)Xs)[k * 64 + lane];
            LDS_WAIT();
        }
        {
            bf16x8 kf[4][4];
#pragma unroll
            for (int mt = 0; mt < 4; ++mt) { const int a = mt * 16 + fr, pp = dir ? 63 - a : a;
#pragma unroll
                for (int kb = 0; kb < 4; ++kb) kf[mt][kb] = *(const bf16x8*)(QKV + (size_t)(t0 + pp) * 3072 + 1024 + h * 128 + kb * 32 + fq * 8); }
            unsigned short* As = (unsigned short*)Lm;
#pragma unroll 1
            for (int mt = 0; mt < 4; ++mt) { bf16x8 qf[4]; const int aq = mt * 16 + fr, pq = dir ? 63 - aq : aq;
#pragma unroll
                for (int kb = 0; kb < 4; ++kb) qf[kb] = *(const bf16x8*)(QKV + (size_t)(t0 + pq) * 3072 + h * 128 + kb * 32 + fq * 8);
#pragma unroll
                for (int nt = 0; nt < 4; ++nt) { f32x4 acc = {0.f, 0.f, 0.f, 0.f};
                    if (nt <= mt) {
#pragma unroll
                        for (int kb = 0; kb < 4; ++kb) acc = MFMA16(qf[kb], kf[nt][kb], acc); }
                    const int b = nt * 16 + fr; const float gb = gcs[b];
#pragma unroll
                    for (int j = 0; j < 4; ++j) { const int a = mt * 16 + fq * 4 + j, n = a * 64 + b;
                        const float v = (a >= b) ? acc[j] * __expf(gcs[a] - gb) : 0.f;
                        As[dir ? 4095 - n : n] = f2bf(v); } } }
            LDS_WAIT();
            u32x4* dst = (u32x4*)(AG + (size_t)item * 4096);
#pragma unroll
            for (int k = 0; k < 8; ++k) dst[k * 64 + lane] = ((const u32x4*)As)[k * 64 + lane];
            LDS_WAIT();
        }
    }
}

#ifndef SCAN_DUPLOAD
#define SCAN_DUPLOAD 0
#endif
constexpr int SCAN_NT = 1;
__device__ void gdn_scan(const Params& p, unsigned char* smem, int chain_half) {
    constexpr int NT = SCAN_NT; static_assert(NT == 1, "block map below assumes two workgroups per chain");
    const int chain = (chain_half >> 4) * 8 + (chain_half & 7), dvh = (chain_half >> 3) & 1;
    const int tid = tid_l(), wid = tid >> 6, lane = tid & 63, fr = lane & 15, fq = lane >> 4;
    unsigned char* ws = p.ws;
    int seq, h, dir, nch, c0;
    if (chain < 32) { seq = chain >> 4; h = (chain >> 1) & 7; dir = chain & 1; nch = 64; c0 = seq * 64; }
    else { const int b = chain - 32; seq = b >> 4; h = (b >> 1) & 7; dir = b & 1; nch = 32; c0 = 128 + seq * 32; }
    unsigned char* kS = smem; unsigned char* qS = smem + 17408; unsigned char* vS = smem + 34816; unsigned char* kTS = smem + 52224;
    unsigned char* TiS = smem + 70656; unsigned char* AS = smem + 79872; float* gS = (float*)(smem + 89088); float* bS = (float*)(smem + 89344);
    const bf16_t* QKV = (const bf16_t*)(ws + O_QKV); const bf16_t* KT = (const bf16_t*)(ws + O_KT); const bf16_t* TG = (const bf16_t*)(ws + O_TINV); const bf16_t* AG = (const bf16_t*)(ws + O_AIN);
    const float* GCP = (const float*)(ws + O_GCP); const float* BT = (const float*)(ws + O_BETA);
    float* of = (float*)(ws + (dir ? O_OBWD : O_OFWD));
    const bool loader = wid >= 4; const int lt = tid - 256;
#define RAW_BAR() do { asm volatile("" ::: "memory"); __builtin_amdgcn_s_barrier(); asm volatile("" ::: "memory"); } while (0)
    u32x4 pq[2][4], pk[2][4], pv[2][4], pt[2][4], pti[2][2], pa[2][2]; float pgb[2] = {0.f, 0.f};
#define SCAN_LOAD(s_, ci_) do { const int cgl = c0 + (dir ? nch - 1 - (ci_) : (ci_)), tl = cgl * 64, iteml = (cgl * 8 + h) * 2 + dir; \
        _Pragma("unroll") for (int rep = 0; rep < 4; ++rep) { const int pid = lt + rep * 256, row = pid >> 4, seg = pid & 15; \
            const bf16_t* src = QKV + (size_t)(tl + row) * 3072 + h * 128 + seg * 8; \
            pq[s_][rep] = *(const u32x4*)(src); pk[s_][rep] = *(const u32x4*)(src + 1024); pv[s_][rep] = *(const u32x4*)(src + 2048); \
            if (SCAN_DUPLOAD) { asm volatile("" : "+v"(pq[s_][rep]), "+v"(pk[s_][rep]), "+v"(pv[s_][rep])); pq[s_][rep] = *(const volatile u32x4*)(src); pk[s_][rep] = *(const volatile u32x4*)(src + 1024); pv[s_][rep] = *(const volatile u32x4*)(src + 2048); } \
            const int rowt = pid >> 3, segt = pid & 7; \
            pt[s_][rep] = *(const u32x4*)(KT + ((size_t)(cgl * 8 + h) * 128 + rowt) * 64 + segt * 8); } \
        _Pragma("unroll") for (int rep = 0; rep < 2; ++rep) { const int pid = lt + rep * 256, row = pid >> 3, seg = pid & 7; \
          pti[s_][rep] = *(const u32x4*)(TG + (size_t)iteml * 4096 + row * 64 + seg * 8); pa[s_][rep] = *(const u32x4*)(AG + (size_t)iteml * 4096 + row * 64 + seg * 8); } \
        { const float* gp_ = (lt < 64) ? (GCP + (size_t)iteml * 64 + lt) : (BT + (size_t)(tl + (lt & 63)) * 16 + dir * 8 + h); pgb[s_] = *gp_; } } while (0)
#define SCAN_STORE(s_) do { \
        _Pragma("unroll") for (int rep = 0; rep < 4; ++rep) { const int pid = lt + rep * 256, row = pid >> 4, seg = pid & 15; \
            *(u32x4*)(qS + row * 272 + seg * 16) = pq[s_][rep]; *(u32x4*)(kS + row * 272 + seg * 16) = pk[s_][rep]; *(u32x4*)(vS + row * 272 + seg * 16) = pv[s_][rep]; \
            const int rowt = pid >> 3, segt = pid & 7; \
            *(u32x4*)(kTS + rowt * 144 + segt * 16) = pt[s_][rep]; } \
        _Pragma("unroll") for (int rep = 0; rep < 2; ++rep) { const int pid = lt + rep * 256, row = pid >> 3, seg = pid & 7; \
            *(u32x4*)(TiS + row * 144 + seg * 16) = pti[s_][rep]; *(u32x4*)(AS + row * 144 + seg * 16) = pa[s_][rep]; } \
        if (lt < 64) gS[lt] = pgb[s_]; else if (lt < 128) bS[lt - 64] = pgb[s_]; } while (0)
    f32x4 S[NT][8];
#pragma unroll
    for (int nt = 0; nt < NT; ++nt)
#pragma unroll
        for (int i = 0; i < 8; ++i) S[nt][i] = (f32x4){0.f, 0.f, 0.f, 0.f};
    const int e0 = dvh * 64 + (wid & 3) * 16 * NT;
    if (loader) {
        SCAN_LOAD(0, 0); SCAN_LOAD(1, 1);
        for (int ci = 0; ci < nch; ci += 2) {
            RAW_BAR();
            SCAN_STORE(0);
            asm volatile("s_waitcnt lgkmcnt(0)" ::: "memory"); RAW_BAR();
            SCAN_LOAD(0, (ci + 2 < nch ? ci + 2 : nch - 1));
            RAW_BAR();
            SCAN_STORE(1);
            asm volatile("s_waitcnt lgkmcnt(0)" ::: "memory"); RAW_BAR();
            SCAN_LOAD(1, (ci + 3 < nch ? ci + 3 : nch - 1));
        }
    } else {
    for (int ci = 0; ci < nch; ++ci) {
        const int cg_ = c0 + (dir ? nch - 1 - ci : ci), t0 = cg_ * 64;
        asm volatile("s_waitcnt lgkmcnt(0)" ::: "memory"); RAW_BAR();
        RAW_BAR();
        {
#define SCHED_FENCE() __builtin_amdgcn_sched_barrier(0)
#define LD272(base, mt_, f) do { _Pragma("unroll") for (int kb = 0; kb < 4; ++kb) { const int off = ((mt_) * 16 + fr) * 272 + (kb * 32 + fq * 4) * 2; \
                (f)[kb] = mk8(*(const u32x2*)((base) + off), *(const u32x2*)((base) + off + 32)); } } while (0)
#define LD144(base, mt_, f) do { _Pragma("unroll") for (int kb = 0; kb < 2; ++kb) { const int off = ((mt_) * 16 + fr) * 144 + (kb * 32 + fq * 4) * 2; \
                (f)[kb] = mk8(*(const u32x2*)((base) + off), *(const u32x2*)((base) + off + 32)); } } while (0)
#define MMA4(ACC, mt_, f) do { _Pragma("unroll") for (int kb = 0; kb < 4; ++kb) _Pragma("unroll") for (int nt = 0; nt < NT; ++nt) ACC[nt][mt_] = MFMA16((f)[kb], Sb[nt][kb], ACC[nt][mt_]); } while (0)
            bf16x8 Sb[NT][4];
#pragma unroll
            for (int nt = 0; nt < NT; ++nt)
#pragma unroll
                for (int kb = 0; kb < 4; ++kb) Sb[nt][kb] = pack8(S[nt][2 * kb], S[nt][2 * kb + 1]);
            f32x4 KS[NT][4], QS[NT][4];
#pragma unroll
            for (int mt = 0; mt < 4; ++mt)
#pragma unroll
                for (int nt = 0; nt < NT; ++nt) { KS[nt][mt] = (f32x4){0.f, 0.f, 0.f, 0.f}; QS[nt][mt] = (f32x4){0.f, 0.f, 0.f, 0.f}; }
            bf16x8 fa[4], fb[4];
            LD272(kS, 0, fa);
            LD272(kS, 1, fb); SCHED_FENCE(); MMA4(KS, 0, fa); SCHED_FENCE();
            LD272(kS, 2, fa); SCHED_FENCE(); MMA4(KS, 1, fb); SCHED_FENCE();
            LD272(kS, 3, fb); SCHED_FENCE(); MMA4(KS, 2, fa); SCHED_FENCE();
            LD272(qS, 0, fa); SCHED_FENCE(); MMA4(KS, 3, fb); SCHED_FENCE();
            LD272(qS, 1, fb); SCHED_FENCE(); MMA4(QS, 0, fa); SCHED_FENCE();
            LD272(qS, 2, fa); SCHED_FENCE(); MMA4(QS, 1, fb); SCHED_FENCE();
            LD272(qS, 3, fb); SCHED_FENCE(); MMA4(QS, 2, fa); SCHED_FENCE();
            f32x4 gv[4], bv[4]; unsigned short vraw[NT][4][4];
#pragma unroll
            for (int mt = 0; mt < 4; ++mt) { gv[mt] = *(const f32x4*)(gS + mt * 16 + fq * 4); bv[mt] = *(const f32x4*)(bS + mt * 16 + fq * 4); }
            SCHED_FENCE(); MMA4(QS, 3, fb); SCHED_FENCE();
#pragma unroll
            for (int mt = 0; mt < 4; ++mt)
#pragma unroll
                for (int j = 0; j < 4; ++j)
#pragma unroll
                    for (int nt = 0; nt < NT; ++nt) vraw[nt][mt][j] = *(const unsigned short*)(vS + (mt * 16 + fq * 4 + j) * 272 + (e0 + nt * 16 + fr) * 2);
            f32x4 eg4[4];
            bf16x8 Rb[NT][2];
            {
                f32x4 R[NT][4];
#pragma unroll
                for (int mt = 0; mt < 4; ++mt)
#pragma unroll
                    for (int j = 0; j < 4; ++j) { eg4[mt][j] = __expf(gv[mt][j]);
#pragma unroll
                        for (int nt = 0; nt < NT; ++nt) R[nt][mt][j] = bv[mt][j] * (bf2f(vraw[nt][mt][j]) - eg4[mt][j] * KS[nt][mt][j]); }
#pragma unroll
                for (int nt = 0; nt < NT; ++nt) { Rb[nt][0] = pack8(R[nt][0], R[nt][1]); Rb[nt][1] = pack8(R[nt][2], R[nt][3]); }
            }
            SCHED_FENCE();
            bf16x8 ti[4][2];
#pragma unroll
            for (int mt = 0; mt < 4; ++mt) LD144(TiS, mt, ti[mt]);
            f32x4 VN[NT][4];
#pragma unroll
            for (int mt = 0; mt < 4; ++mt) {
#pragma unroll
                for (int nt = 0; nt < NT; ++nt) VN[nt][mt] = (f32x4){0.f, 0.f, 0.f, 0.f};
#pragma unroll
                for (int kb = 0; kb < 2; ++kb)
#pragma unroll
                    for (int nt = 0; nt < NT; ++nt) VN[nt][mt] = MFMA16(ti[mt][kb], Rb[nt][kb], VN[nt][mt]); }
            SCHED_FENCE();
            bf16x8 VNb[NT][2];
#pragma unroll
            for (int nt = 0; nt < NT; ++nt) { VNb[nt][0] = pack8(VN[nt][0], VN[nt][1]); VNb[nt][1] = pack8(VN[nt][2], VN[nt][3]); }
            bf16x8 af[4][2];
#pragma unroll
            for (int mt = 0; mt < 4; ++mt) LD144(AS, mt, af[mt]);
            const float glast = gS[dir ? 0 : 63];
            SCHED_FENCE();
#pragma unroll
            for (int mt = 0; mt < 4; ++mt) { f32x4 oa[NT]; _Pragma("unroll") for (int nt = 0; nt < NT; ++nt) oa[nt] = (f32x4){0.f, 0.f, 0.f, 0.f};
#pragma unroll
                for (int kb = 0; kb < 2; ++kb)
#pragma unroll
                    for (int nt = 0; nt < NT; ++nt) oa[nt] = MFMA16(af[mt][kb], VNb[nt][kb], oa[nt]);
#pragma unroll
                for (int j = 0; j < 4; ++j) { const int c = mt * 16 + fq * 4 + j;
#pragma unroll
                    for (int nt = 0; nt < NT; ++nt) of[(size_t)(t0 + c) * 1024 + h * 128 + e0 + nt * 16 + fr] = eg4[mt][j] * QS[nt][mt][j] + oa[nt][j]; } }
            SCHED_FENCE();
            const float eg = __expf(glast);
            bf16x8 VDb[NT][2];
#pragma unroll
            for (int mt = 0; mt < 4; ++mt)
#pragma unroll
                for (int j = 0; j < 4; ++j) { const float sc = __expf(glast - gv[mt][j]); _Pragma("unroll") for (int nt = 0; nt < NT; ++nt) VN[nt][mt][j] *= sc; }
#pragma unroll
            for (int nt = 0; nt < NT; ++nt) { VDb[nt][0] = pack8(VN[nt][0], VN[nt][1]); VDb[nt][1] = pack8(VN[nt][2], VN[nt][3]); }
            bf16x8 kt0[4][2], kt1[4][2];
#pragma unroll
            for (int dt = 0; dt < 4; ++dt) { LD144(kTS, dt, kt0[dt]); LD144(kTS, 4 + dt, kt1[dt]); }
            SCHED_FENCE();
#pragma unroll
            for (int dt = 0; dt < 4; ++dt) {
#pragma unroll
                for (int nt = 0; nt < NT; ++nt) S[nt][dt] = S[nt][dt] * eg;
#pragma unroll
                for (int kb = 0; kb < 2; ++kb)
#pragma unroll
                    for (int nt = 0; nt < NT; ++nt) S[nt][dt] = MFMA16(kt0[dt][kb], VDb[nt][kb], S[nt][dt]); }
            SCHED_FENCE();
#pragma unroll
            for (int dt = 0; dt < 4; ++dt) {
#pragma unroll
                for (int nt = 0; nt < NT; ++nt) S[nt][4 + dt] = S[nt][4 + dt] * eg;
#pragma unroll
                for (int kb = 0; kb < 2; ++kb)
#pragma unroll
                    for (int nt = 0; nt < NT; ++nt) S[nt][4 + dt] = MFMA16(kt1[dt][kb], VDb[nt][kb], S[nt][4 + dt]); }
#undef SCHED_FENCE
#undef LD272
#undef LD144
#undef MMA4
        }
    }
    }
#undef SCAN_LOAD
#undef SCAN_STORE
#undef RAW_BAR
}

__device__ void attn_phase(const Params& p, unsigned char* smem, int L) {
    const int tid = tid_l(), wid = tid >> 6, lane = tid & 63, fr = lane & 15, fq = lane >> 4;
    unsigned char* ws = p.ws;
    float* btab = (float*)(smem + 131072);
    for (int idx = tid; idx < 3 * 4 * 129; idx += 512) { const int g = idx / 516, hq = (idx / 129) & 3, rr = idx % 129 - 64, D = (g == 0) ? 1 : (g == 1 ? 4 : 16);
        const int rel = rr * D, n = rel < 0 ? -rel : rel;
        int bk = (n < 8) ? n : min(15, 5 + (31 - __clz(n)));
        if (rel > 0) bk += 16;
        btab[idx] = p.rel_bias[bk * 12 + g * 4 + hq]; }
    const bf16_t* CQ = (const bf16_t*)(ws + O_CQ); const bf16_t* CK = (const bf16_t*)(ws + O_CK); const bf16_t* VT = (const bf16_t*)(ws + O_VT);
    bf16_t* OG = (bf16_t*)(ws + O_OG); float* LSE = (float*)(ws + O_LSE);
    unsigned char* Ks = smem;
    unsigned* qctr = (unsigned*)(ws + O_QCTR) + L * 64;
    volatile LAS unsigned* slot = (volatile LAS unsigned*)(smem + LDS_BAR_ST) + 2;
    for (;;) {
        __syncthreads();
        if (tid == 0) *slot = __hip_atomic_fetch_add(qctr, 1u, __ATOMIC_RELAXED, __HIP_MEMORY_SCOPE_AGENT);
        __syncthreads();
        const int bi = (int)*slot;
        if (bi >= 768) break;
        const int g = bi >> 8, rem = bi & 255, hq = rem >> 6, bt = rem & 63, dsh = g * 2, D = 1 << dsh, hc = g * 4 + hq, cb = bt * 256;
        __syncthreads();
        {
            u32x4 kv[12];
#pragma unroll
            for (int rep = 0; rep < 12; ++rep) { const int pid = tid + rep * 512, row = pid >> 4, seg = pid & 15;
                int c = cb - 64 + row; c = c < 0 ? 0 : (c > T_ - 1 ? T_ - 1 : c);
                int s0, Ls; seq_of(c, s0, Ls); const int lsh = (Ls == 4096 ? 12 : 11) - dsh, rr = (c - s0) >> lsh, ii = (c - s0) & ((1 << lsh) - 1);
                kv[rep] = *(const u32x4*)(CK + (size_t)(s0 + ii * D + rr) * 1536 + hc * 128 + seg * 8); }
#pragma unroll
            for (int rep = 0; rep < 12; ++rep) { const int pid = tid + rep * 512, row = pid >> 4, seg = pid & 15; *(u32x4*)(Ks + row * 272 + seg * 16) = kv[rep]; }
        }
        const int col0 = cb + wid * 32; int s0, Ls; seq_of(col0, s0, Ls); const int l = Ls >> dsh, r = (col0 - s0) / l, i0 = (col0 - s0) - r * l;
        bf16x8 qf[2][4];
#pragma unroll
        for (int nq = 0; nq < 2; ++nq) { const size_t tq = (size_t)(s0 + (i0 + nq * 16 + fr) * D + r);
#pragma unroll
            for (int kb = 0; kb < 4; ++kb) qf[nq][kb] = *(const bf16x8*)(CQ + tq * 1536 + hc * 128 + kb * 32 + fq * 8); }
        __syncthreads();
        f32x4 st[10][2];
#pragma unroll
        for (int kt = 0; kt < 10; ++kt) { const unsigned char* kp = Ks + (wid * 32 + kt * 16 + fr) * 272 + fq * 16;
            st[kt][0] = (f32x4){0.f, 0.f, 0.f, 0.f}; st[kt][1] = (f32x4){0.f, 0.f, 0.f, 0.f};
#pragma unroll
            for (int kb = 0; kb < 4; ++kb) { const bf16x8 kfr = *(const bf16x8*)(kp + kb * 64);
                st[kt][0] = MFMA16(kfr, qf[0][kb], st[kt][0]); st[kt][1] = MFMA16(kfr, qf[1][kb], st[kt][1]); } }
        const float* bt_ = btab + hc * 129 + 64;
        float mx[2] = {-1e30f, -1e30f};
#pragma unroll
        for (int kt = 0; kt < 10; ++kt)
#pragma unroll
            for (int nq = 0; nq < 2; ++nq)
#pragma unroll
                for (int j = 0; j < 4; ++j) { const int rel = -64 + kt * 16 + fq * 4 + j - nq * 16 - fr, kidx = i0 - 64 + kt * 16 + fq * 4 + j;
                    const bool valid = (rel >= -64) && (rel <= 64) && (kidx >= 0) && (kidx < l);
                    const int rc = rel < -64 ? -64 : (rel > 64 ? 64 : rel);
                    const float sv = valid ? st[kt][nq][j] * 0.08838834764831845f + bt_[rc] : -1e30f;
                    st[kt][nq][j] = sv; mx[nq] = fmaxf(mx[nq], sv); }
        float sm[2];
#pragma unroll
        for (int nq = 0; nq < 2; ++nq) { mx[nq] = fmaxf(mx[nq], __shfl_xor(mx[nq], 16)); mx[nq] = fmaxf(mx[nq], __shfl_xor(mx[nq], 32)); sm[nq] = 0.f; }
#pragma unroll
        for (int kt = 0; kt < 10; ++kt)
#pragma unroll
            for (int nq = 0; nq < 2; ++nq)
#pragma unroll
                for (int j = 0; j < 4; ++j) { const float e = __expf(st[kt][nq][j] - mx[nq]); st[kt][nq][j] = e; sm[nq] += e; }
#pragma unroll
        for (int nq = 0; nq < 2; ++nq) { sm[nq] += __shfl_xor(sm[nq], 16); sm[nq] += __shfl_xor(sm[nq], 32); }
        bf16x8 Pb[5][2];
#pragma unroll
        for (int kb = 0; kb < 5; ++kb) { Pb[kb][0] = pack8(st[2 * kb][0], st[2 * kb + 1][0]); Pb[kb][1] = pack8(st[2 * kb][1], st[2 * kb + 1][1]); }
        __syncthreads();
        {
            u32x4 vv[12]; const bf16_t* vsrc = VT + (size_t)g * 512 * VTLD + (size_t)(hq * 128) * VTLD + 128 + cb - 64;
#pragma unroll
            for (int rep = 0; rep < 12; ++rep) { const int pid = tid + rep * 512, d = pid / 48, seg = pid - d * 48; vv[rep] = *(const u32x4*)(vsrc + (size_t)d * VTLD + seg * 8); }
#pragma unroll
            for (int rep = 0; rep < 12; ++rep) { const int pid = tid + rep * 512, d = pid / 48, seg = pid - d * 48; *(u32x4*)(Ks + d * 784 + seg * 16) = vv[rep]; }
        }
        __syncthreads();
        f32x4 ot[8][2];
#pragma unroll
        for (int dt = 0; dt < 8; ++dt) { ot[dt][0] = (f32x4){0.f, 0.f, 0.f, 0.f}; ot[dt][1] = (f32x4){0.f, 0.f, 0.f, 0.f}; }
#pragma unroll
        for (int kb = 0; kb < 5; ++kb) {
#pragma unroll
            for (int dt = 0; dt < 8; ++dt) { const unsigned char* vp = Ks + (dt * 16 + fr) * 784 + (wid * 32 + kb * 32 + fq * 4) * 2;
                const bf16x8 va = mk8(*(const u32x2*)vp, *(const u32x2*)(vp + 32));
                ot[dt][0] = MFMA16(va, Pb[kb][0], ot[dt][0]); ot[dt][1] = MFMA16(va, Pb[kb][1], ot[dt][1]); } }
#pragma unroll
        for (int nq = 0; nq < 2; ++nq) { const size_t tq = (size_t)(s0 + (i0 + nq * 16 + fr) * D + r); const float inv = 1.0f / sm[nq];
            bf16_t* op = OG + (size_t)g * T_ * 512 + tq * 512 + hq * 128 + fq * 4;
#pragma unroll
            for (int dt = 0; dt < 8; ++dt) { u32x2 o; o.x = pk2(ot[dt][nq][0] * inv, ot[dt][nq][1] * inv); o.y = pk2(ot[dt][nq][2] * inv, ot[dt][nq][3] * inv); *(u32x2*)(op + dt * 16) = o; }
            if (fq == 0) LSE[(size_t)g * T_ * 4 + tq * 4 + hq] = mx[nq] + __logf(sm[nq]); }
    }
}

__device__ void post_phase(const Params& p, int L) {
    const int tid = tid_l(), lane = tid & 63, gw = bid_l() * 8 + (tid >> 6), nw = gridDim.x * 8;
    unsigned char* ws = p.ws;
    const float* OF = (const float*)(ws + O_OFWD); const float* OB = (const float*)(ws + O_OBWD); const bf16_t* Z = (const bf16_t*)(ws + O_SZ);
    bf16_t* YA = (bf16_t*)(ws + O_YA); bf16_t* YC = (bf16_t*)(ws + O_YC); const bf16_t* OG = (const bf16_t*)(ws + O_OG); const float* LSE = (const float*)(ws + O_LSE);
    const f32x4 hn = *(const f32x4*)(p.head_norm + L * 128 + (lane & 31) * 4);
    for (int tp = gw * 2; tp < T_; tp += nw * 2) {
        f32x4 a[2][4], b[2][4]; u32x2 z[2][4]; float ls[2][3]; u32x4 og[2][3];
#pragma unroll
        for (int u = 0; u < 2; ++u) { const size_t t = (size_t)(tp + u);
#pragma unroll
            for (int i = 0; i < 4; ++i) { a[u][i] = *(const f32x4*)(OF + t * 1024 + i * 256 + lane * 4); b[u][i] = *(const f32x4*)(OB + t * 1024 + i * 256 + lane * 4);
                z[u][i] = *(const u32x2*)(Z + t * 1024 + i * 256 + lane * 4); }
#pragma unroll
            for (int g = 0; g < 3; ++g) { ls[u][g] = LSE[(size_t)g * T_ * 4 + t * 4 + (lane >> 4)]; og[u][g] = *(const u32x4*)(OG + (size_t)g * T_ * 512 + t * 512 + lane * 8); } }
#pragma unroll
        for (int u = 0; u < 2; ++u) { const size_t t = (size_t)(tp + u);
            float ss[4];
#pragma unroll
            for (int i = 0; i < 4; ++i) { a[u][i] = a[u][i] + b[u][i]; ss[i] = a[u][i][0] * a[u][i][0] + a[u][i][1] * a[u][i][1] + a[u][i][2] * a[u][i][2] + a[u][i][3] * a[u][i][3]; }
#pragma unroll
            for (int off = 16; off > 0; off >>= 1)
#pragma unroll
                for (int i = 0; i < 4; ++i) ss[i] += __shfl_xor(ss[i], off);
#pragma unroll
            for (int i = 0; i < 4; ++i) { const float rstd = rsqrtf(ss[i] * (1.0f / 128.0f) + 1e-6f);
                u32x2 o; o.x = pk2(a[u][i][0] * rstd * hn[0] * siluf_(bflo(z[u][i].x)), a[u][i][1] * rstd * hn[1] * siluf_(bfhi(z[u][i].x)));
                o.y = pk2(a[u][i][2] * rstd * hn[2] * siluf_(bflo(z[u][i].y)), a[u][i][3] * rstd * hn[3] * siluf_(bfhi(z[u][i].y)));
                *(u32x2*)(YA + t * 1024 + i * 256 + lane * 4) = o; }
            const float l0 = ls[u][0], l1 = ls[u][1], l2 = ls[u][2];
            const float m = fmaxf(l0, fmaxf(l1, l2)); float a0 = __expf(l0 - m), a1 = __expf(l1 - m), a2 = __expf(l2 - m); const float inv = 1.0f / (a0 + a1 + a2); a0 *= inv; a1 *= inv; a2 *= inv;
            const u32x4 g0 = og[u][0], g1 = og[u][1], g2 = og[u][2];
            u32x4 yo;
            yo.x = pk2(a0 * bflo(g0.x) + a1 * bflo(g1.x) + a2 * bflo(g2.x), a0 * bfhi(g0.x) + a1 * bfhi(g1.x) + a2 * bfhi(g2.x));
            yo.y = pk2(a0 * bflo(g0.y) + a1 * bflo(g1.y) + a2 * bflo(g2.y), a0 * bfhi(g0.y) + a1 * bfhi(g1.y) + a2 * bfhi(g2.y));
            yo.z = pk2(a0 * bflo(g0.z) + a1 * bflo(g1.z) + a2 * bflo(g2.z), a0 * bfhi(g0.z) + a1 * bfhi(g1.z) + a2 * bfhi(g2.z));
            yo.w = pk2(a0 * bflo(g0.w) + a1 * bflo(g1.w) + a2 * bflo(g2.w), a0 * bfhi(g0.w) + a1 * bfhi(g1.w) + a2 * bfhi(g2.w));
            *(u32x4*)(YC + t * 512 + lane * 8) = yo; }
    }
}

constexpr int NPHASE = 23;
__device__ __forceinline__ void do_phase(const Params& p, int ph, unsigned char* smem) {
    unsigned char* ws = p.ws;
    if (ph == 22) { norm_rows(p, 2, p.norm_final, nullptr); return; }
    const int L = ph / 11, k = ph - L * 11;
    switch (k) {
    case 0: {
        const float* tile = nullptr;
        conv_tiles(p.w_in + (size_t)L * DM * 17952, DM, 17952, 281, (bf16_t*)(ws + O_WT_IN), 1, p.norm_mix + L * DM);
        if (L == 0) { conv_tiles(p.w_up, DM, DFF, 128, (bf16_t*)(ws + O_WT_UP), 0, p.norm_mlp);
                      conv_tiles(p.w_down, DFF, DM, 32, (bf16_t*)(ws + O_WT_DOWN), 0, tile); }
        conv_tiles(p.w_out + (size_t)L * DM * DM, DM, DM, 32, (bf16_t*)(ws + O_WT_OUT), 0, tile);
        conv_tiles(p.w_br_a + (size_t)L * 1024 * DM, 1024, DM, 32, (bf16_t*)(ws + O_WT_BRA), 0, tile);
        conv_tiles(p.w_br_b + (size_t)L * 1024 * DM, 1024, DM, 32, (bf16_t*)(ws + O_WT_BRB), 0, tile);
        conv_tiles(p.w_br_c + (size_t)L * 512 * DM, 512, DM, 32, (bf16_t*)(ws + O_WT_BRC), 0, tile);
        if (L == 0) norm_rows(p, 0, nullptr, (bf16_t*)(ws + O_XN));
    } break;
    case 1: { EpiProj E; E.ws = ws; E.ssq = (const float*)(ws + O_SSQ) + (size_t)(2 * L) * T_; run_gemm(smem, (const bf16_t*)(ws + O_XN), (const bf16_t*)(ws + O_WT_IN), T_, NPROJ, DM, E); } break;
    case 2: prep_phase(p, L, smem); break;
    case 3: gdn_local(p, smem); break;
    case 4: {
        const int bid = bid_l();
#ifndef SCAN_REP
#define SCAN_REP 1
#endif
        constexpr int NSCAN = 96 * (2 / SCAN_NT);
        if (bid < NSCAN) { int nr = SCAN_REP; asm volatile("" : "+s"(nr));
#pragma unroll 1
            for (int rr = 0; rr < nr; ++rr) { gdn_scan(p, smem, bid); __syncthreads(); } }
        attn_phase(p, smem, L);
        if (L == 0) { unsigned* qc = (unsigned*)(ws + O_QCTR);
            conv_queue(p.w_up + (size_t)DM * DFF, DM, DFF, 128, (bf16_t*)(ws + O_WT_UP1), p.norm_mlp + DM, qc + 16, smem);
            conv_queue(p.w_down + (size_t)DFF * DM, DFF, DM, 32, (bf16_t*)(ws + O_WT_DOWN1), nullptr, qc + 32, smem); }
    } break;
    case 5: post_phase(p, L); break;
    case 6: {
        EpiBranch E; E.merged = (bf16_t*)(ws + O_XN); E.gates = (const bf16_t*)(ws + O_GATES);
        for (int b = 0; b < 3; ++b) { E.goff = b * DM; E.mode = b;
            const bf16_t* A = (const bf16_t*)(ws + (b == 0 ? O_YA : (b == 1 ? O_YB : O_YC))); const bf16_t* Bt = (const bf16_t*)(ws + (b == 0 ? O_WT_BRA : (b == 1 ? O_WT_BRB : O_WT_BRC)));
            run_gemm(smem, A, Bt, T_, DM, b == 2 ? 512 : 1024, E); }
    } break;
    case 7: { EpiResid E; E.xp = (L == 0) ? p.x_prompt : nullptr; E.xs = p.x_sample; E.C = p.out; E.hb = (bf16_t*)(ws + O_HB2); E.ssq = (float*)(ws + O_SSQ) + (size_t)(2 * L + 1) * T_; run_gemm(smem, (const bf16_t*)(ws + O_XN), (const bf16_t*)(ws + O_WT_OUT), T_, DM, DM, E); } break;
    case 8: break;
    case 9: { EpiUp E; E.O = (bf16_t*)(ws + O_HID); E.ssq = (const float*)(ws + O_SSQ) + (size_t)(2 * L + 1) * T_; run_gemm(smem, (const bf16_t*)(ws + O_HB2), (const bf16_t*)(ws + (L == 0 ? O_WT_UP : O_WT_UP1)), T_, DFF, DM, E); } break;
    case 10: { EpiResid E; E.xp = nullptr; E.xs = nullptr; E.C = p.out; E.hb = (bf16_t*)(ws + O_XN); E.ssq = (float*)(ws + O_SSQ) + (size_t)(2 * L + 2) * T_; run_gemm(smem, (const bf16_t*)(ws + O_HID), (const bf16_t*)(ws + (L == 0 ? O_WT_DOWN : O_WT_DOWN1)), T_, DM, DFF, E); } break;
    }
}

__device__ __forceinline__ Params load_params() {
    Params q{};
#if defined(__HIP_DEVICE_COMPILE__)
    typedef const __attribute__((address_space(4))) unsigned long long* KP;
    KP kp = (KP)__builtin_amdgcn_kernarg_segment_ptr(); asm volatile("" : "+s"(kp));
#define GPF(i) ((const float*)(const __attribute__((address_space(1))) float*)kp[i])
    q.x_prompt = GPF(0); q.x_sample = GPF(1); q.rel_bias = GPF(2); q.norm_mix = GPF(3); q.w_in = GPF(4);
    q.conv_a = GPF(5); q.a_log = GPF(6); q.dt_bias = GPF(7); q.head_norm = GPF(8); q.conv_b = GPF(9);
    q.w_br_a = GPF(10); q.w_br_b = GPF(11); q.w_br_c = GPF(12); q.w_out = GPF(13); q.norm_mlp = GPF(14);
    q.w_up = GPF(15); q.w_down = GPF(16); q.norm_final = GPF(17); q.out = (float*)(__attribute__((address_space(1))) float*)kp[18]; q.ws = (unsigned char*)(__attribute__((address_space(1))) unsigned char*)kp[19];
#undef GPF
#endif
    return q;
}
#ifndef DUP_MASK
#define DUP_MASK 0
#endif
__device__ __forceinline__ void grid_barrier(unsigned char* smem) {
    XcdBarrier b; { const Params q = load_params(); b.bar = (unsigned*)(q.ws + O_BAR); } b.x = xb_xcc_id(); b.st = (volatile LAS unsigned*)(smem + LDS_BAR_ST);
    xcd_barrier(b);
}
template <int PH> __device__ __forceinline__ void phase_sync(unsigned char* smem) {
    if (PH < 22 && PH % 11 == 8) return;
    if (PH < 22 && ((DUP_MASK >> (PH % 11)) & 1)) {
        int nrep = 2; asm volatile("" : "+s"(nrep));
#pragma unroll 1
        for (int rep = 0; rep < nrep; ++rep) { { const Params q = load_params(); do_phase(q, PH, smem); } grid_barrier(smem); }
    } else { { const Params q = load_params(); do_phase(q, PH, smem); } if (PH + 1 < NPHASE) grid_barrier(smem); } }
#if MEGA
__global__ __launch_bounds__(512, 2) void k_mega(Params p) {
    extern __shared__ __attribute__((aligned(16))) unsigned char smem[];
    cg::grid_group grid = cg::this_grid();
    {
        const Params q = load_params(); unsigned* bar = (unsigned*)(q.ws + O_BAR); const int tid = tid_l();
        if (bid_l() == 0) for (int i = tid; i < XCD_BAR_WORDS + 128; i += 512) bar[i] = 0u;
        if (tid < 4) ((volatile LAS unsigned*)(smem + LDS_BAR_ST))[tid] = 0u;
        __threadfence();
        grid.sync();
        (void)xcd_barrier_post(bar, (volatile LAS unsigned*)(smem + LDS_BAR_ST));
    }
#ifdef EXTRA_SYNCS
    { int ne = EXTRA_SYNCS; asm volatile("" : "+s"(ne));
#pragma unroll 1
      for (int i = 0; i < ne; ++i) grid_barrier(smem); }
#endif
    phase_sync<0>(smem); phase_sync<1>(smem); phase_sync<2>(smem); phase_sync<3>(smem); phase_sync<4>(smem); phase_sync<5>(smem);
    phase_sync<6>(smem); phase_sync<7>(smem); phase_sync<8>(smem); phase_sync<9>(smem); phase_sync<10>(smem); phase_sync<11>(smem);
    phase_sync<12>(smem); phase_sync<13>(smem); phase_sync<14>(smem); phase_sync<15>(smem); phase_sync<16>(smem); phase_sync<17>(smem);
    phase_sync<18>(smem); phase_sync<19>(smem); phase_sync<20>(smem); phase_sync<21>(smem); phase_sync<22>(smem);
}
#else
template <int PH> __global__ __launch_bounds__(512, 2) void k_ph(Params p) {
    extern __shared__ __attribute__((aligned(16))) unsigned char smem[];
    const Params q = load_params(); do_phase(q, PH, smem);
}
template <int PH> static void launch_ph(const Params& p, hipStream_t stream) {
    (void)hipFuncSetAttribute((const void*)k_ph<PH>, hipFuncAttributeMaxDynamicSharedMemorySize, (int)LDS_BYTES);
    k_ph<PH><<<256, 512, LDS_BYTES, stream>>>(p);
}
#endif

extern "C" void kernel_launch(void* const* d_in, const int* in_sizes, int n_in, void* d_out, int out_size, void* d_ws, size_t ws_size, hipStream_t stream) {
    Params p{};
    p.x_prompt = (const float*)d_in[0]; p.x_sample = (const float*)d_in[1]; p.rel_bias = (const float*)d_in[2]; p.norm_mix = (const float*)d_in[3]; p.w_in = (const float*)d_in[4];
    p.conv_a = (const float*)d_in[5]; p.a_log = (const float*)d_in[6]; p.dt_bias = (const float*)d_in[7]; p.head_norm = (const float*)d_in[8]; p.conv_b = (const float*)d_in[9];
    p.w_br_a = (const float*)d_in[10]; p.w_br_b = (const float*)d_in[11]; p.w_br_c = (const float*)d_in[12]; p.w_out = (const float*)d_in[13]; p.norm_mlp = (const float*)d_in[14];
    p.w_up = (const float*)d_in[15]; p.w_down = (const float*)d_in[16]; p.norm_final = (const float*)d_in[17]; p.out = (float*)d_out; p.ws = (unsigned char*)d_ws;
    if (ws_size < WS_NEED) { fprintf(stderr, "workspace too small: %zu < %zu\n", ws_size, (size_t)WS_NEED); return; }
#if MEGA
    static int grid_blocks = 0;
    if (!grid_blocks) { int dev = 0, cus = 0, per_cu = 0; (void)hipGetDevice(&dev); (void)hipDeviceGetAttribute(&cus, hipDeviceAttributeMultiprocessorCount, dev);
        (void)hipFuncSetAttribute((const void*)k_mega, hipFuncAttributeMaxDynamicSharedMemorySize, (int)LDS_BYTES);
        (void)hipOccupancyMaxActiveBlocksPerMultiprocessor(&per_cu, k_mega, 512, LDS_BYTES);
        if (per_cu < 1) per_cu = 1;
        grid_blocks = cus * per_cu; if (grid_blocks > 256) grid_blocks = 256; }
    void* args[] = {&p};
    hipError_t e = hipLaunchCooperativeKernel((const void*)k_mega, dim3(grid_blocks), dim3(512), args, LDS_BYTES, stream);
    if (e != hipSuccess) fprintf(stderr, "cooperative launch failed: %s (grid %d)\n", hipGetErrorString(e), grid_blocks);
#else
    launch_ph<0>(p, stream); launch_ph<1>(p, stream); launch_ph<2>(p, stream); launch_ph<3>(p, stream); launch_ph<4>(p, stream); launch_ph<5>(p, stream);
    launch_ph<6>(p, stream); launch_ph<7>(p, stream); launch_ph<8>(p, stream); launch_ph<9>(p, stream); launch_ph<10>(p, stream); launch_ph<11>(p, stream);
    launch_ph<12>(p, stream); launch_ph<13>(p, stream); launch_ph<14>(p, stream); launch_ph<15>(p, stream); launch_ph<16>(p, stream); launch_ph<17>(p, stream);
    launch_ph<18>(p, stream); launch_ph<19>(p, stream); launch_ph<20>(p, stream); launch_ph<21>(p, stream); launch_ph<22>(p, stream);
#endif
}
```

```cpp
#include <cstdio>
#define MEGA 1
#define DUP_MASK 0
#define SCAN_REP 1
#include <hip/hip_runtime.h>
namespace pg8 {
#define PG8_LAS __attribute__((address_space(3)))
typedef unsigned short bf16_t;
typedef short bf16x8 __attribute__((ext_vector_type(8)));
typedef float f32x4 __attribute__((ext_vector_type(4)));
typedef unsigned u32x4 __attribute__((ext_vector_type(4)));
constexpr int BM = 256, BK = 64, HALF = 128, HTB = HALF * BK * 2  , STAGE_BYTES = 8 * HTB, NXCD = 8, WGM = 8;

__host__ __device__ __forceinline__ int lds_byte(int r, int c) { const int st = (r >> 4) * 2 + (c >> 5), rr = r & 15, cc = c & 31, ob = rr * 64 + cc * 2; return st * 1024 + (ob ^ (((ob >> 9) & 1) << 5)); }
__host__ __device__ __forceinline__ void stage_rc(int b, int& R, int& C) { const int st = b / 1024, sb = b % 1024, swz = sb ^ (((sb >> 9) & 1) << 5); R = (st >> 1) * 16 + swz / 64; C = (st & 1) * 32 + (swz % 64) / 2; }
__host__ __device__ __forceinline__ int perm32(int rho) { const int n = rho >> 4, i = rho & 15; return 8 * (i >> 2) + 4 * n + (i & 3); }

struct Unit { int pm, pn; };
struct Gemm { const bf16_t* A; const bf16_t* Bt; int M, N, K; };
struct StaticOrder {
    int nM, nN, nwg, G, c;
    __host__ __device__ void init(int M, int N, int G_, int c_) { nM = M / BM; nN = N / BM; nwg = nM * nN; G = G_; c = c_; }
    __host__ __device__ bool next(int i, Unit& u) const {
        const long L = (long)i * G + c; if (L >= nwg) return false;
        int wgid = (int)L; { const int q = nwg / NXCD, r = nwg % NXCD, xcd = wgid % NXCD, off = wgid / NXCD; wgid = (xcd < r ? xcd * (q + 1) : r * (q + 1) + (xcd - r) * q) + off; }
        const int nig = WGM * nN, gid = wgid / nig, fm = gid * WGM, gsz = (nM - fm) < WGM ? (nM - fm) : WGM;
        u.pm = fm + ((wgid % nig) % gsz); u.pn = (wgid % nig) / gsz; return true;
    }
    __device__ __forceinline__ void a_ready(const Unit&) const {}
    __device__ __forceinline__ void done(const Unit&) const {}
};
__device__ __forceinline__ unsigned cvt_pk_bf16(float lo, float hi) { unsigned r; asm volatile("v_cvt_pk_bf16_f32 %0, %1, %2" : "=v"(r) : "v"(lo), "v"(hi)); return r; }

template <class Epi, class Sched, bool STAMP = false>
__device__ __forceinline__ void gemm_phase(PG8_LAS unsigned char* lds, const Gemm g, const Sched& S, const Epi& E, unsigned long long* stamps) {
    int tid_ = threadIdx.x; asm volatile("" : "+v"(tid_)); const int tid = tid_, wid = __builtin_amdgcn_readfirstlane(tid >> 6), lane = tid & 63, wr = wid >> 2, wc = wid & 3, fr = lane & 15, fq = lane >> 4;
    const int K = g.K, nt = K / BK;
    int ts_lo = 0, ts_hi = 0, nts = 0; const unsigned long long rt_entry = STAMP ? (unsigned long long)wall_clock64() : 0ull;
#define PG8_STAMP() do { if (STAMP && wid == 0 && nts < 64) { const unsigned long long _c = (unsigned long long)clock64(); \
        ts_lo = (lane == nts) ? (int)(unsigned)_c : ts_lo; ts_hi = (lane == nts) ? (int)(unsigned)(_c >> 32) : ts_hi; ++nts; } } while (0)
    PG8_STAMP();
    unsigned voffA[2], voffB[2];
#pragma unroll
    for (int i = 0; i < 2; ++i) { int R, C; stage_rc(tid * 16 + i * 8192, R, C); const int Rb = Epi::PERM ? ((R & ~31) + perm32(R & 31)) : R;
        voffA[i] = (unsigned)(R * K + C) * 2u; voffB[i] = (unsigned)(Rb * K + C) * 2u; }
    const size_t kstep = (size_t)(BK * 2);
    const size_t hstep = (size_t)HALF * K * 2;
    const size_t tstep = 2 * hstep;
    const unsigned ldsw = (unsigned)wid * 1024u;
    const int aoff = lds_byte(wr * 64 + fr, fq * 8), boff = lds_byte(wc * 32 + fr, fq * 8);
#define PG8_SA(b, h) (((b) * 2 + (h)) * HTB)
#define PG8_SB(b, h) ((4 + (b) * 2 + (h)) * HTB)
#define PG8_STAGE(bufoff, gbase, voff) do { _Pragma("unroll") for (int _i = 0; _i < 2; ++_i) \
        __builtin_amdgcn_global_load_lds((const unsigned*)((const char*)(gbase) + (voff)[_i]), (PG8_LAS unsigned*)(lds + (bufoff) + ldsw + _i * 8192), 16, 0, 0); } while (0)
#define PG8_LDA(dst, b, h) do { _Pragma("unroll") for (int m = 0; m < 4; ++m) _Pragma("unroll") for (int k = 0; k < 2; ++k) dst[m][k] = *(const PG8_LAS bf16x8*)(lds + PG8_SA(b, h) + aoff + m * 2048 + k * 1024); } while (0)
#define PG8_LDB(dst, b, h) do { _Pragma("unroll") for (int n = 0; n < 2; ++n) _Pragma("unroll") for (int k = 0; k < 2; ++k) dst[n][k] = *(const PG8_LAS bf16x8*)(lds + PG8_SB(b, h) + boff + n * 2048 + k * 1024); } while (0)
#define PG8_MMA(ai, bj, At, Bt) do { __builtin_amdgcn_s_setprio(1); _Pragma("unroll") for (int m = 0; m < 4; ++m) _Pragma("unroll") for (int n = 0; n < 2; ++n) _Pragma("unroll") for (int k = 0; k < 2; ++k) \
        acc[ai][bj][m][n] = __builtin_amdgcn_mfma_f32_16x16x32_bf16(Bt[n][k], At[m][k], acc[ai][bj][m][n], 0, 0, 0); __builtin_amdgcn_s_setprio(0); } while (0)
#define PG8_WAIT_V(n) asm volatile("s_waitcnt vmcnt(" #n ")" ::: "memory")
#define PG8_WAIT_L(n) asm volatile("s_waitcnt lgkmcnt(" #n ")" ::: "memory")
#define PG8_BAR __builtin_amdgcn_s_barrier()
#define PG8_SCHED __builtin_amdgcn_sched_barrier(0)
    Unit cur, nxt; int ui = 0;
    if (!S.next(0, cur)) return;
    f32x4 acc[2][2][4][2];
#pragma unroll
    for (int a = 0; a < 2; ++a)
#pragma unroll
        for (int b = 0; b < 2; ++b)
#pragma unroll
            for (int m = 0; m < 4; ++m)
#pragma unroll
                for (int n = 0; n < 2; ++n) acc[a][b][m][n] = (f32x4){0.f, 0.f, 0.f, 0.f};
    bf16x8 At[4][2], B0[2][2], B1[2][2];
    const char* cA = (const char*)g.A + (size_t)cur.pm * tstep; const char* cB = (const char*)g.Bt + (size_t)cur.pn * tstep;
    S.a_ready(cur);
    PG8_STAGE(PG8_SB(0, 0), cB, voffB); PG8_STAGE(PG8_SA(0, 0), cA, voffA); PG8_STAGE(PG8_SB(0, 1), cB + hstep, voffB); PG8_STAGE(PG8_SA(0, 1), cA + hstep, voffA);
    if (wr == 1) PG8_BAR;
    PG8_WAIT_V(4); PG8_BAR;
    PG8_STAGE(PG8_SB(1, 0), cB + kstep, voffB); PG8_STAGE(PG8_SA(1, 0), cA + kstep, voffA); PG8_STAGE(PG8_SB(1, 1), cB + hstep + kstep, voffB);
    PG8_WAIT_V(6); PG8_BAR;
    PG8_STAMP();
    for (;;) {
        const bool has_next = S.next(ui + 1, nxt);
        const char* nA = has_next ? (const char*)g.A + (size_t)nxt.pm * tstep : cA; const char* nB = has_next ? (const char*)g.Bt + (size_t)nxt.pn * tstep : cB;
        for (int t = 0; t < nt; t += 2) {
            const bool last = (t == nt - 2);
            const char* a1 = cA + (size_t)(t + 1) * kstep;
            const char* a2 = last ? nA : cA + (size_t)(t + 2) * kstep; const char* b2 = last ? nB : cB + (size_t)(t + 2) * kstep;
            const char* a3 = a2 + kstep; const char* b3 = b2 + kstep;
            if (last && has_next) S.a_ready(nxt);
            PG8_LDB(B0, 0, 0); PG8_SCHED; PG8_LDA(At, 0, 0); PG8_STAGE(PG8_SA(1, 1), a1 + hstep, voffA);
            PG8_WAIT_L(8); PG8_BAR; PG8_WAIT_L(0); PG8_MMA(0, 0, At, B0); PG8_BAR; PG8_SCHED;
            PG8_LDB(B1, 0, 1); PG8_STAGE(PG8_SB(0, 0), b2, voffB);
            PG8_BAR; PG8_WAIT_L(0); PG8_MMA(0, 1, At, B1); PG8_BAR;
            PG8_LDA(At, 0, 1); PG8_STAGE(PG8_SA(0, 0), a2, voffA);
            PG8_BAR; PG8_WAIT_L(0); PG8_MMA(1, 0, At, B0); PG8_BAR; PG8_SCHED;
            PG8_STAGE(PG8_SB(0, 1), b2 + hstep, voffB);
            PG8_WAIT_V(6); PG8_BAR; PG8_MMA(1, 1, At, B1); PG8_BAR;
            PG8_LDB(B0, 1, 0); PG8_SCHED; PG8_LDA(At, 1, 0); PG8_STAGE(PG8_SA(0, 1), a2 + hstep, voffA);
            PG8_WAIT_L(8); PG8_BAR; PG8_WAIT_L(0); PG8_MMA(0, 0, At, B0); PG8_BAR; PG8_SCHED;
            PG8_LDB(B1, 1, 1); PG8_STAGE(PG8_SB(1, 0), b3, voffB);
            PG8_BAR; PG8_WAIT_L(0); PG8_MMA(0, 1, At, B1); PG8_BAR;
            PG8_LDA(At, 1, 1); PG8_STAGE(PG8_SA(1, 0), a3, voffA);
            PG8_BAR; PG8_WAIT_L(0); PG8_MMA(1, 0, At, B0); PG8_BAR; PG8_SCHED;
            PG8_STAGE(PG8_SB(1, 1), b3 + hstep, voffB);
            PG8_WAIT_V(6); PG8_BAR; PG8_MMA(1, 1, At, B1); PG8_BAR;
        }
        PG8_STAMP();
        if constexpr (!Epi::AFTER_DRAIN) { E(acc, cur, wr, wc, fr, fq); S.done(cur); }
        PG8_STAMP();
        if (!has_next) break;
#pragma unroll
        for (int a = 0; a < 2; ++a)
#pragma unroll
            for (int b = 0; b < 2; ++b)
#pragma unroll
                for (int m = 0; m < 4; ++m)
#pragma unroll
                    for (int n = 0; n < 2; ++n) acc[a][b][m][n] = (f32x4){0.f, 0.f, 0.f, 0.f};
        cur = nxt; cA = nA; cB = nB; ++ui;
    }
    PG8_WAIT_V(0);
    if (wr == 0) PG8_BAR;
    PG8_BAR;
    if constexpr (Epi::AFTER_DRAIN) { E.fused(acc, cur, wr, wc, fr, fq, lds, wid, lane); S.done(cur); }
    PG8_STAMP();
    if (STAMP && wid == 0) { stamps[lane] = lane < nts ? (((unsigned long long)(unsigned)ts_hi << 32) | (unsigned)ts_lo) : 0ull;
        if (lane == 62) stamps[62] = rt_entry; if (lane == 63) stamps[63] = (unsigned long long)wall_clock64(); }
#undef PG8_STAMP
#undef PG8_SA
#undef PG8_SB
#undef PG8_STAGE
#undef PG8_LDA
#undef PG8_LDB
#undef PG8_MMA
#undef PG8_WAIT_V
#undef PG8_WAIT_L
#undef PG8_BAR
#undef PG8_SCHED
}
}

#define XB_TMO      128
#define XB_XCNT(j)  (256  + 64 * (j))
#define XB_XSUB(j)  (1280 + 64 * (j))
#define XB_XGEN(j)  (2304 + 64 * (j))
#define XB_TOP      3328
#define XB_TOPGEN   3392
#define XCD_BAR_WORDS 3456
#define XB_SPIN_CAP (1u << 18)
#define LAS __attribute__((address_space(3)))

__device__ __forceinline__ unsigned xb_ld(unsigned* p)              { return __hip_atomic_load(p, __ATOMIC_RELAXED, __HIP_MEMORY_SCOPE_AGENT); }
__device__ __forceinline__ unsigned xb_add(unsigned* p, unsigned v) { return __hip_atomic_fetch_add(p, v, __ATOMIC_RELAXED, __HIP_MEMORY_SCOPE_AGENT); }
__device__ __forceinline__ unsigned xb_xcc_id() { return (unsigned)__builtin_amdgcn_s_getreg((3 << 11) | 20) & 0xFu; }
#define XB_SPIN(cond, bar) do { unsigned _sp = 0; while (cond) { __builtin_amdgcn_s_sleep(1); \
    if ((++_sp & 255u) == 0u) { if (xb_ld(&(bar)[XB_TMO])) break; if (_sp > XB_SPIN_CAP) { atomicAdd(&(bar)[XB_TMO], 1u); break; } } } } while (0)

struct XcdBarrier {
    unsigned* bar; unsigned x;
    volatile LAS unsigned* st;
};

__device__ __forceinline__ XcdBarrier xcd_barrier_post(unsigned* bar, volatile LAS unsigned* st) {
    XcdBarrier b; b.bar = bar; b.x = xb_xcc_id(); b.st = st;
    if (threadIdx.x == 0) (void)xb_add(&bar[XB_XCNT(b.x)], 1u);
    return b;
}
__device__ __forceinline__ void xcd_barrier_complete(unsigned* bar, unsigned x, unsigned& nloc, unsigned& nx) {
    const unsigned G = gridDim.x * gridDim.y * gridDim.z;
    unsigned sum, cnt, mine, sp = 0u;
    for (;;) {
        sum = 0u; cnt = 0u; mine = 0u;
#pragma unroll
        for (unsigned j = 0; j < 16; ++j) { const unsigned c = xb_ld(&bar[XB_XCNT(j)]); sum += c; cnt += (c > 0u) ? 1u : 0u; mine = (j == x) ? c : mine; }
        if (sum == G) break;
        __builtin_amdgcn_s_sleep(1);
        if ((++sp & 255u) == 0u) { if (xb_ld(&bar[XB_TMO])) break; if (sp > XB_SPIN_CAP) { atomicAdd(&bar[XB_TMO], 1u); break; } }
    }
    nloc = mine > 0u ? mine : 1u; nx = cnt > 0u ? cnt : 1u;
}

__device__ __forceinline__ void xcd_barrier(const XcdBarrier& b) {
    asm volatile("s_waitcnt vmcnt(0)" ::: "memory");
    __syncthreads();
    if (threadIdx.x == 0) {
        unsigned* bar = b.bar;
        __builtin_amdgcn_s_waitcnt(0);
        unsigned nloc = b.st[0], nx = b.st[1];
        if (nloc == 0u) { xcd_barrier_complete(bar, b.x, nloc, nx); b.st[0] = nloc; b.st[1] = nx; }
        const unsigned old = xb_add(&bar[XB_XSUB(b.x)], 1u);
        const unsigned gen = old / nloc;
        if (old + 1u == (gen + 1u) * nloc) {
            __builtin_amdgcn_fence(__ATOMIC_RELEASE, "agent");
            asm volatile("s_waitcnt vmcnt(0)" ::: "memory");
            const unsigned og = xb_add(&bar[XB_TOP], 1u);
            const unsigned tg = og / nx;
            if (og + 1u == (tg + 1u) * nx) xb_add(&bar[XB_TOPGEN], 1u);
            else XB_SPIN(xb_ld(&bar[XB_TOPGEN]) == tg, bar);
            __builtin_amdgcn_fence(__ATOMIC_ACQUIRE, "agent");
            xb_add(&bar[XB_XGEN(b.x)], 1u);
            asm volatile("s_waitcnt vmcnt(0)" ::: "memory");
        } else {
            XB_SPIN(xb_ld(&bar[XB_XGEN(b.x)]) == gen, bar);
            __builtin_amdgcn_fence(__ATOMIC_ACQUIRE, "agent");
            asm volatile("s_waitcnt vmcnt(0)" ::: "memory");
        }
    }
    __syncthreads();
}

#include <hip/hip_cooperative_groups.h>
namespace cg = cooperative_groups;
using pg8::bf16_t; using pg8::bf16x8; using pg8::f32x4; using pg8::u32x4;
typedef unsigned u32x2 __attribute__((ext_vector_type(2)));
typedef unsigned long long u64_t;
#define SSQ_SCALE 16777216.0f
#define SSQ_INV (1.0f / 16777216.0f)

#ifndef MEGA
#define MEGA 1
#endif

constexpr int T_ = 16384, DM = 2048, NPROJ = 18176, DFF = 8192, VTLD = T_ + 256;
constexpr size_t LDS_BYTES = 139264 + 16;
constexpr size_t LDS_BAR_ST = 139264;

constexpr size_t SZ_WT_IN = (size_t)NPROJ * DM * 2, SZ_WT_UP = (size_t)DFF * DM * 2, SZ_WT_DOWN = SZ_WT_UP, SZ_WT_OUT = (size_t)DM * DM * 2,
                 SZ_WT_BRA = (size_t)DM * 1024 * 2, SZ_WT_BRC = (size_t)DM * 512 * 2;
constexpr size_t O_WT_IN = 0, O_WT_UP = O_WT_IN + SZ_WT_IN, O_WT_DOWN = O_WT_UP + SZ_WT_UP, O_WT_OUT = O_WT_DOWN + SZ_WT_DOWN, O_WT_BRA = O_WT_OUT + SZ_WT_OUT,
                 O_WT_BRB = O_WT_BRA + SZ_WT_BRA, O_WT_BRC = O_WT_BRB + SZ_WT_BRA, O_XN = O_WT_BRC + SZ_WT_BRC;
constexpr size_t O_VT = O_XN;
constexpr size_t O_AQKV = O_XN + (size_t)T_ * DM * 2;
constexpr size_t O_SB = O_AQKV + (size_t)T_ * 3072 * 2;
constexpr size_t O_OFWD = O_AQKV, O_OBWD = O_OFWD + (size_t)T_ * 1024 * 4, O_TINV = O_OBWD + (size_t)T_ * 1024 * 4, O_AIN = O_TINV + (size_t)4096 * 4096 * 2;
constexpr size_t O_MACC = O_OFWD;
constexpr size_t O_SZ = O_SB + (size_t)T_ * 3072 * 2;
constexpr size_t O_CQ = O_SZ + (size_t)T_ * 1024 * 2;
constexpr size_t O_CK = O_CQ + (size_t)T_ * 1536 * 2, O_CV = O_CK + (size_t)T_ * 1536 * 2;
constexpr size_t O_GATES = O_CV + (size_t)T_ * 1536 * 2;
constexpr size_t O_HID = O_CQ;
constexpr size_t O_AB = O_GATES + (size_t)T_ * 6144 * 2;
constexpr size_t O_QKV = O_AB + (size_t)T_ * 32 * 4;
constexpr size_t O_KT = O_QKV + (size_t)T_ * 3072 * 2;
constexpr size_t O_G = O_KT + (size_t)T_ * 1024 * 2;
constexpr size_t O_BETA = O_G + (size_t)T_ * 16 * 4;
constexpr size_t O_YA = O_BETA + (size_t)T_ * 16 * 4;
constexpr size_t O_YB = O_YA + (size_t)T_ * 1024 * 2;
constexpr size_t O_YC = O_YB + (size_t)T_ * 1024 * 2;
constexpr size_t O_GCP = O_YC + (size_t)T_ * 512 * 2;
constexpr size_t O_OG = O_GCP + (size_t)4096 * 64 * 4;
constexpr size_t O_LSE = O_OG + (size_t)3 * T_ * 512 * 2;
constexpr size_t O_BAR = O_LSE + (size_t)3 * T_ * 4 * 4;
constexpr size_t O_QCTR = O_BAR + (size_t)XCD_BAR_WORDS * 4;
constexpr size_t O_SSQ = O_QCTR + 512;
constexpr size_t O_WT_UP1 = O_SSQ + (size_t)5 * T_ * 8, O_WT_DOWN1 = O_WT_UP1 + SZ_WT_UP;
constexpr size_t WS_NEED = O_WT_DOWN1 + SZ_WT_DOWN;
constexpr size_t O_HB2 = O_AQKV;
static_assert((size_t)3 * 512 * VTLD * 2 <= (size_t)T_ * DM * 2, "vT alias");
static_assert(O_AIN + (size_t)4096 * 4096 * 2 <= O_SZ, "alias AQKV|SB");
static_assert(O_HID + (size_t)T_ * DFF * 2 <= O_AB, "alias hidden");
static_assert(WS_NEED < (size_t)1176000000, "workspace");

struct Params {
    const float* x_prompt; const float* x_sample; const float* rel_bias; const float* norm_mix; const float* w_in; const float* conv_a; const float* a_log; const float* dt_bias;
    const float* head_norm; const float* conv_b; const float* w_br_a; const float* w_br_b; const float* w_br_c; const float* w_out; const float* norm_mlp; const float* w_up;
    const float* w_down; const float* norm_final; float* out; unsigned char* ws;
};

__device__ __forceinline__ float bf2f(unsigned short b) { return __uint_as_float(((unsigned)b) << 16); }
__device__ __forceinline__ float bflo(unsigned u) { return __uint_as_float(u << 16); }
__device__ __forceinline__ float bfhi(unsigned u) { return __uint_as_float(u & 0xffff0000u); }
__device__ __forceinline__ unsigned pk2(float lo, float hi) { return pg8::cvt_pk_bf16(lo, hi); }
__device__ __forceinline__ unsigned short f2bf(float f) { return (unsigned short)(pk2(f, 0.f) & 0xffffu); }
__device__ __forceinline__ float sigmoidf_(float x) { return __builtin_amdgcn_rcpf(1.0f + __expf(-x)); }
__device__ __forceinline__ float siluf_(float x) { return x * __builtin_amdgcn_rcpf(1.0f + __expf(-x)); }
__device__ __forceinline__ void seq_of(int t, int& s0, int& L) { if (t < 8192) { s0 = t & ~4095; L = 4096; } else { s0 = t & ~2047; L = 2048; } }
__device__ __forceinline__ bf16x8 mk8(u32x2 a, u32x2 b) { u32x4 w; w.x = a.x; w.y = a.y; w.z = b.x; w.w = b.y; return __builtin_bit_cast(bf16x8, w); }
__device__ __forceinline__ bf16x8 pack8(f32x4 a, f32x4 b) { u32x4 w; w.x = pk2(a[0], a[1]); w.y = pk2(a[2], a[3]); w.z = pk2(b[0], b[1]); w.w = pk2(b[2], b[3]); return __builtin_bit_cast(bf16x8, w); }
__device__ __forceinline__ int tid_l() { int t = threadIdx.x; asm volatile("" : "+v"(t)); return t; }
__device__ __forceinline__ int bid_l() { int b = blockIdx.x; asm volatile("" : "+s"(b)); return b; }
#define MFMA16(a, b, c) __builtin_amdgcn_mfma_f32_16x16x32_bf16((a), (b), (c), 0, 0, 0)
#define LDS_WAIT() asm volatile("s_waitcnt lgkmcnt(0)" ::: "memory")

__device__ void conv_tiles(const float* __restrict__ W, int K, int ldn, int ntn, bf16_t* __restrict__ Wt, int mode, const float* __restrict__ kscale) {
    const int nkt = K >> 5, total = ntn * nkt, tid = tid_l(), lane = tid & 63;
    for (int it = bid_l() * 8 + (tid >> 6); it < total; it += gridDim.x * 8) {
        const int tn = it / nkt, tk = it - tn * nkt, n0 = tn * 64, k0 = tk * 32;
        int src0 = n0, nvalid = 64;
        if (mode == 1) { if (n0 >= 17920) { src0 = 4096; nvalid = 32; } else if (n0 >= 4096) src0 = n0 + 32; }
        if (lane < nvalid) {
            const float* src = W + (size_t)k0 * ldn + src0 + lane;
            float v[32];
#pragma unroll
            for (int j = 0; j < 32; ++j) v[j] = src[(size_t)j * ldn];
            if (kscale) {
#pragma unroll
                for (int j = 0; j < 32; ++j) v[j] *= kscale[k0 + j]; }
            bf16_t* dst = Wt + (size_t)(n0 + lane) * K + k0;
#pragma unroll
            for (int q = 0; q < 4; ++q) { u32x4 w; w.x = pk2(v[8 * q], v[8 * q + 1]); w.y = pk2(v[8 * q + 2], v[8 * q + 3]); w.z = pk2(v[8 * q + 4], v[8 * q + 5]); w.w = pk2(v[8 * q + 6], v[8 * q + 7]);
                *(u32x4*)(dst + 8 * q) = w; }
        }
    }
}

__device__ void conv_queue(const float* __restrict__ W, int K, int ldn, int ntn, bf16_t* __restrict__ Wt, const float* __restrict__ kscale, unsigned* qctr, unsigned char* smem) {
    const int nkt = K >> 5, total = ntn * nkt, nbatch = (total + 63) >> 6, tid = tid_l(), lane = tid & 63, wid = tid >> 6;
    volatile LAS unsigned* slot = (volatile LAS unsigned*)(smem + LDS_BAR_ST) + 2;
    for (;;) {
        __syncthreads();
        if (tid == 0) *slot = __hip_atomic_fetch_add(qctr, 1u, __ATOMIC_RELAXED, __HIP_MEMORY_SCOPE_AGENT);
        __syncthreads();
        const int bi = (int)*slot;
        if (bi >= nbatch) break;
#pragma unroll 1
        for (int sub = 0; sub < 8; ++sub) {
            const int it = bi * 64 + sub * 8 + wid; if (it >= total) break;
            const int tn = it / nkt, tk = it - tn * nkt, n0 = tn * 64, k0 = tk * 32;
            const float* src = W + (size_t)k0 * ldn + n0 + lane;
            float v[32];
#pragma unroll
            for (int j = 0; j < 32; ++j) v[j] = src[(size_t)j * ldn];
            if (kscale) {
#pragma unroll
                for (int j = 0; j < 32; ++j) v[j] *= kscale[k0 + j]; }
            bf16_t* dst = Wt + (size_t)(n0 + lane) * K + k0;
#pragma unroll
            for (int q = 0; q < 4; ++q) { u32x4 w; w.x = pk2(v[8 * q], v[8 * q + 1]); w.y = pk2(v[8 * q + 2], v[8 * q + 3]); w.z = pk2(v[8 * q + 4], v[8 * q + 5]); w.w = pk2(v[8 * q + 6], v[8 * q + 7]);
                *(u32x4*)(dst + 8 * q) = w; }
        }
    }
}

__device__ void norm_rows(const Params& p, int mode, const float* __restrict__ w, bf16_t* __restrict__ hb) {
    const int tid = tid_l(), lane = tid & 63, gw = bid_l() * 8 + (tid >> 6), nw = gridDim.x * 8;
    u64_t* ssq = (u64_t*)(p.ws + O_SSQ);
    for (int t = gw; t < T_; t += nw) {
        float4 v[8];
        if (mode == 0) { const float* src = (t < 8192 ? p.x_prompt + (size_t)t * DM : p.x_sample + (size_t)(t - 8192) * DM);
#pragma unroll
            for (int i = 0; i < 8; ++i) v[i] = *(const float4*)(src + i * 256 + lane * 4);
        } else { const bf16_t* hsrc = (const bf16_t*)(p.ws + O_XN) + (size_t)t * DM;
#pragma unroll
            for (int i = 0; i < 8; ++i) { const u32x2 w = *(const u32x2*)(hsrc + i * 256 + lane * 4); v[i] = make_float4(bflo(w.x), bfhi(w.x), bflo(w.y), bfhi(w.y)); } }
        if (mode == 0) {
            float ss = 0.f;
#pragma unroll
            for (int i = 0; i < 8; ++i) ss += v[i].x * v[i].x + v[i].y * v[i].y + v[i].z * v[i].z + v[i].w * v[i].w;
#pragma unroll
            for (int off = 32; off > 0; off >>= 1) ss += __shfl_xor(ss, off);
            if (lane < 5) ssq[(size_t)lane * T_ + t] = (lane == 0) ? (u64_t)(ss * SSQ_SCALE) : 0ull;
#pragma unroll
            for (int i = 0; i < 8; ++i) { u32x2 o; o.x = pk2(v[i].x, v[i].y); o.y = pk2(v[i].z, v[i].w); *(u32x2*)(hb + (size_t)t * DM + i * 256 + lane * 4) = o;
 }
        } else {
            const float rstd = rsqrtf((float)ssq[(size_t)4 * T_ + t] * SSQ_INV * (1.0f / DM) + 1e-6f);
#pragma unroll
            for (int i = 0; i < 8; ++i) { const float4 wv = *(const float4*)(w + i * 256 + lane * 4);
                *(float4*)(p.out + (size_t)t * DM + i * 256 + lane * 4) = make_float4(v[i].x * rstd * wv.x, v[i].y * rstd * wv.y, v[i].z * rstd * wv.z, v[i].w * rstd * wv.w); }
        }
    }
}

struct EpiProj {
    static constexpr bool PERM = true, AFTER_DRAIN = false;
    unsigned char* ws; const u64_t* ssq;
    __device__ __forceinline__ void operator()(const f32x4 (&acc)[2][2][4][2], const pg8::Unit& u, int wr, int wc, int fr, int fq) const {
        const int pn = u.pn, row0 = u.pm * 256 + wr * 64 + fr;
        float rs[2][4];
#pragma unroll
        for (int ai = 0; ai < 2; ++ai)
#pragma unroll
            for (int m = 0; m < 4; ++m) rs[ai][m] = rsqrtf((float)ssq[row0 + ai * 128 + m * 16] * SSQ_INV * (1.0f / DM) + 1e-6f);
        if (pn == 70) {
            if (wc == 0) { float* ab = (float*)(ws + O_AB);
#pragma unroll
                for (int ai = 0; ai < 2; ++ai)
#pragma unroll
                    for (int m = 0; m < 4; ++m) { float* rp = ab + (size_t)(row0 + ai * 128 + m * 16) * 32 + 8 * fq; *(f32x4*)rp = acc[ai][0][m][0] * rs[ai][m]; *(f32x4*)(rp + 4) = acc[ai][0][m][1] * rs[ai][m]; } }
            return;
        }
        bf16_t* base; int ldc, colt;
        if (pn < 12) { base = (bf16_t*)(ws + O_AQKV); ldc = 3072; colt = pn * 256; }
        else if (pn < 16) { base = (bf16_t*)(ws + O_SZ); ldc = 1024; colt = (pn - 12) * 256; }
        else if (pn < 28) { base = (bf16_t*)(ws + O_SB); ldc = 3072; colt = (pn - 16) * 256; }
        else if (pn < 46) { const int s = (pn - 28) / 6; base = (bf16_t*)(ws + O_CQ) + (size_t)s * T_ * 1536; ldc = 1536; colt = ((pn - 28) - s * 6) * 256; }
        else { base = (bf16_t*)(ws + O_GATES); ldc = 6144; colt = (pn - 46) * 256; }
        const int col0 = colt + wc * 32 + 8 * fq;
#pragma unroll
        for (int ai = 0; ai < 2; ++ai)
#pragma unroll
            for (int m = 0; m < 4; ++m) { bf16_t* rowp = base + (size_t)(row0 + ai * 128 + m * 16) * ldc + col0;
#pragma unroll
                for (int bj = 0; bj < 2; ++bj) { const f32x4 v0 = acc[ai][bj][m][0] * rs[ai][m], v1 = acc[ai][bj][m][1] * rs[ai][m];
                    u32x4 w; w.x = pk2(v0[0], v0[1]); w.y = pk2(v0[2], v0[3]); w.z = pk2(v1[0], v1[1]); w.w = pk2(v1[2], v1[3]);
                    *(u32x4*)(rowp + bj * 128) = w; } }
    }
};
struct EpiUp {
    static constexpr bool PERM = true, AFTER_DRAIN = false;
    bf16_t* O; const u64_t* ssq;
    __device__ __forceinline__ void operator()(const f32x4 (&acc)[2][2][4][2], const pg8::Unit& u, int wr, int wc, int fr, int fq) const {
        const int row0 = u.pm * 256 + wr * 64 + fr, col0 = u.pn * 256 + wc * 32 + 8 * fq;
        float rs[2][4];
#pragma unroll
        for (int ai = 0; ai < 2; ++ai)
#pragma unroll
            for (int m = 0; m < 4; ++m) rs[ai][m] = rsqrtf((float)ssq[row0 + ai * 128 + m * 16] * SSQ_INV * (1.0f / DM) + 1e-6f);
#pragma unroll
        for (int ai = 0; ai < 2; ++ai)
#pragma unroll
            for (int m = 0; m < 4; ++m) { bf16_t* rowp = O + (size_t)(row0 + ai * 128 + m * 16) * DFF + col0;
#pragma unroll
                for (int bj = 0; bj < 2; ++bj) { f32x4 v0 = acc[ai][bj][m][0], v1 = acc[ai][bj][m][1];
#pragma unroll
                    for (int j = 0; j < 4; ++j) { const float a = fmaxf(v0[j] * rs[ai][m], 0.f), b = fmaxf(v1[j] * rs[ai][m], 0.f); v0[j] = a * a; v1[j] = b * b; }
                    u32x4 w; w.x = pk2(v0[0], v0[1]); w.y = pk2(v0[2], v0[3]); w.z = pk2(v1[0], v1[1]); w.w = pk2(v1[2], v1[3]);
                    *(u32x4*)(rowp + bj * 128) = w; } }
    }
};
struct EpiResid {
    static constexpr bool PERM = true, AFTER_DRAIN = false;
    const float* xp; const float* xs; const bf16_t* hin; bf16_t* hout; u64_t* ssq;
    __device__ __forceinline__ void operator()(const f32x4 (&acc)[2][2][4][2], const pg8::Unit& u, int wr, int wc, int fr, int fq) const {
        const int row0 = u.pm * 256 + wr * 64 + fr, col0 = u.pn * 256 + wc * 32 + 8 * fq;
        const float* src = xp ? (u.pm < 32 ? xp : xs - (size_t)8192 * DM) : nullptr;
#pragma unroll
        for (int ai = 0; ai < 2; ++ai) {
            f32x4 old[4][2][2];
            if (src) {
#pragma unroll
                for (int m = 0; m < 4; ++m)
#pragma unroll
                    for (int bj = 0; bj < 2; ++bj)
#pragma unroll
                        for (int n = 0; n < 2; ++n) old[m][bj][n] = *(const f32x4*)(src + (size_t)(row0 + ai * 128 + m * 16) * DM + col0 + bj * 128 + n * 4);
            } else {
                u32x4 ob[4][2];
#pragma unroll
                for (int m = 0; m < 4; ++m)
#pragma unroll
                    for (int bj = 0; bj < 2; ++bj) ob[m][bj] = *(const u32x4*)(hin + (size_t)(row0 + ai * 128 + m * 16) * DM + col0 + bj * 128);
#pragma unroll
                for (int m = 0; m < 4; ++m)
#pragma unroll
                    for (int bj = 0; bj < 2; ++bj) { const u32x4 w = ob[m][bj];
                        old[m][bj][0] = (f32x4){bflo(w.x), bfhi(w.x), bflo(w.y), bfhi(w.y)}; old[m][bj][1] = (f32x4){bflo(w.z), bfhi(w.z), bflo(w.w), bfhi(w.w)}; }
            }
            asm volatile("" ::: "memory");
#pragma unroll
            for (int m = 0; m < 4; ++m) { const size_t row = (size_t)(row0 + ai * 128 + m * 16); bf16_t* hrow = hout + row * DM + col0; float part = 0.f;
#pragma unroll
                for (int bj = 0; bj < 2; ++bj) { const f32x4 v0 = old[m][bj][0] + acc[ai][bj][m][0], v1 = old[m][bj][1] + acc[ai][bj][m][1];
                    u32x4 o; o.x = pk2(v0[0], v0[1]); o.y = pk2(v0[2], v0[3]); o.z = pk2(v1[0], v1[1]); o.w = pk2(v1[2], v1[3]); *(u32x4*)(hrow + bj * 128) = o;
                    part += v0[0] * v0[0] + v0[1] * v0[1] + v0[2] * v0[2] + v0[3] * v0[3] + v1[0] * v1[0] + v1[1] * v1[1] + v1[2] * v1[2] + v1[3] * v1[3]; }
                part += __shfl_xor(part, 16); part += __shfl_xor(part, 32);
                if (fq == 0) (void)__hip_atomic_fetch_add(ssq + row, (u64_t)(part * SSQ_SCALE), __ATOMIC_RELAXED, __HIP_MEMORY_SCOPE_AGENT); }
        }
    }
};
struct EpiBranch {
    static constexpr bool PERM = true, AFTER_DRAIN = false;
    bf16_t* merged; const bf16_t* gates; int goff, mode;
    __device__ __forceinline__ void operator()(const f32x4 (&acc)[2][2][4][2], const pg8::Unit& u, int wr, int wc, int fr, int fq) const {
        const int row0 = u.pm * 256 + wr * 64 + fr, col0 = u.pn * 256 + wc * 32 + 8 * fq;
#pragma unroll
        for (int ai = 0; ai < 2; ++ai) {
            u32x4 gw[4][2], old[4][2];
#pragma unroll
            for (int m = 0; m < 4; ++m)
#pragma unroll
                for (int bj = 0; bj < 2; ++bj) { const size_t row = (size_t)(row0 + ai * 128 + m * 16); const int col = col0 + bj * 128;
                    gw[m][bj] = *(const u32x4*)(gates + row * 6144 + goff + col);
                    old[m][bj] = (mode != 0) ? *(const u32x4*)(merged + row * DM + col) : (u32x4){0u, 0u, 0u, 0u}; }
            asm volatile("" ::: "memory");
#pragma unroll
            for (int m = 0; m < 4; ++m)
#pragma unroll
                for (int bj = 0; bj < 2; ++bj) { const size_t row = (size_t)(row0 + ai * 128 + m * 16); const int col = col0 + bj * 128;
                    const u32x4 g = gw[m][bj], od = old[m][bj];
                    const f32x4 v0 = acc[ai][bj][m][0], v1 = acc[ai][bj][m][1];
                    u32x4 o;
                    o.x = pk2(v0[0] * sigmoidf_(bflo(g.x)) + bflo(od.x), v0[1] * sigmoidf_(bfhi(g.x)) + bfhi(od.x));
                    o.y = pk2(v0[2] * sigmoidf_(bflo(g.y)) + bflo(od.y), v0[3] * sigmoidf_(bfhi(g.y)) + bfhi(od.y));
                    o.z = pk2(v1[0] * sigmoidf_(bflo(g.z)) + bflo(od.z), v1[1] * sigmoidf_(bfhi(g.z)) + bfhi(od.z));
                    o.w = pk2(v1[2] * sigmoidf_(bflo(g.w)) + bflo(od.w), v1[3] * sigmoidf_(bfhi(g.w)) + bfhi(od.w));
                    *(u32x4*)(merged + row * DM + col) = o; }
        }
    }
};

template <class Epi> __device__ __forceinline__ void run_gemm(unsigned char* smem, const bf16_t* A, const bf16_t* Bt, int M, int N, int K, const Epi& E) {
    pg8::Gemm g; g.A = A; g.Bt = Bt; g.M = M; g.N = N; g.K = K;
    pg8::StaticOrder S; S.init(M, N, (int)gridDim.x, bid_l());
    pg8::gemm_phase<Epi, pg8::StaticOrder, false>((PG8_LAS unsigned char*)smem, g, S, E, nullptr);
}

__device__ void prep_phase(const Params& p, int L, unsigned char* smem) {
    const int tid = tid_l(), wid = tid >> 6, lane = tid & 63, gw = bid_l() * 8 + wid, nw = gridDim.x * 8;
    unsigned char* ws = p.ws;
    const bf16_t* AQ = (const bf16_t*)(ws + O_AQKV); const bf16_t* SB = (const bf16_t*)(ws + O_SB);
    bf16_t* QKV = (bf16_t*)(ws + O_QKV); bf16_t* KT = (bf16_t*)(ws + O_KT); bf16_t* YB = (bf16_t*)(ws + O_YB);
    const float* ca = p.conv_a + (size_t)L * 3 * 3072; const float* cb = p.conv_b + (size_t)L * 3 * 1024;
    for (int it = gw; it < 16384; it += nw) {
        const int h = it & 7, oct = it >> 3, tw = oct * 8, ch = tw >> 6, cloc = tw & 63;
        int s0, Ls; seq_of(tw, s0, Ls);
        const bool v0 = tw - 1 >= s0, v9 = tw + 8 < s0 + Ls;
        float qv[3][8][2];
#pragma unroll
        for (int part = 0; part < 3; ++part) {
            const int col = part * 1024 + h * 128 + 2 * lane;
            const float2 w0 = *(const float2*)(ca + col), w1 = *(const float2*)(ca + 3072 + col), w2 = *(const float2*)(ca + 6144 + col);
            unsigned x[10];
#pragma unroll
            for (int j = 0; j < 10; ++j) { const bool ok = (j == 0) ? v0 : ((j == 9) ? v9 : true); x[j] = ok ? *(const unsigned*)(AQ + (size_t)(tw - 1 + j) * 3072 + col) : 0u; }
#pragma unroll
            for (int i = 0; i < 8; ++i) {
                qv[part][i][0] = siluf_(w0.x * bflo(x[i]) + w1.x * bflo(x[i + 1]) + w2.x * bflo(x[i + 2]));
                qv[part][i][1] = siluf_(w0.y * bfhi(x[i]) + w1.y * bfhi(x[i + 1]) + w2.y * bfhi(x[i + 2])); }
        }
        const int cbn = h * 128 + 2 * lane;
        unsigned sc[10], sh[10], sg[8];
#pragma unroll
        for (int j = 0; j < 10; ++j) { const bool ok = (j == 0) ? v0 : ((j == 9) ? v9 : true);
            const bf16_t* rp = SB + (size_t)(tw - 1 + j) * 3072 + cbn;
            sc[j] = ok ? *(const unsigned*)(rp + 1024) : 0u; sh[j] = ok ? *(const unsigned*)(rp + 2048) : 0u; }
#pragma unroll
        for (int i = 0; i < 8; ++i) sg[i] = *(const unsigned*)(SB + (size_t)(tw + i) * 3072 + cbn);
        float sq[8], sk[8];
#pragma unroll
        for (int i = 0; i < 8; ++i) { sq[i] = qv[0][i][0] * qv[0][i][0] + qv[0][i][1] * qv[0][i][1]; sk[i] = qv[1][i][0] * qv[1][i][0] + qv[1][i][1] * qv[1][i][1]; }
#pragma unroll
        for (int off = 32; off > 0; off >>= 1)
#pragma unroll
            for (int i = 0; i < 8; ++i) { sq[i] += __shfl_xor(sq[i], off); sk[i] += __shfl_xor(sk[i], off); }
        unsigned klo[8], khi[8];
#pragma unroll
        for (int i = 0; i < 8; ++i) {
            const int t = tw + i;
            const float rq = rsqrtf(sq[i] + 1e-6f) * 0.08838834764831845f, rk = rsqrtf(sk[i] + 1e-6f);
            const unsigned qo = pk2(qv[0][i][0] * rq, qv[0][i][1] * rq), ko = pk2(qv[1][i][0] * rk, qv[1][i][1] * rk), vo = pk2(qv[2][i][0], qv[2][i][1]);
            bf16_t* orow = QKV + (size_t)t * 3072 + h * 128 + 2 * lane;
            *(unsigned*)(orow) = qo; *(unsigned*)(orow + 1024) = ko; *(unsigned*)(orow + 2048) = vo;
            klo[i] = ko & 0xffffu; khi[i] = ko >> 16; }
        { u32x4 a, b; a.x = klo[0] | (klo[1] << 16); a.y = klo[2] | (klo[3] << 16); a.z = klo[4] | (klo[5] << 16); a.w = klo[6] | (klo[7] << 16);
          b.x = khi[0] | (khi[1] << 16); b.y = khi[2] | (khi[3] << 16); b.z = khi[4] | (khi[5] << 16); b.w = khi[6] | (khi[7] << 16);
          bf16_t* dst = KT + ((size_t)(ch * 8 + h) * 128 + 2 * lane) * 64 + cloc;
          *(u32x4*)dst = a; *(u32x4*)(dst + 64) = b; }
        { const float2 w0 = *(const float2*)(cb + cbn), w1 = *(const float2*)(cb + 1024 + cbn), w2 = *(const float2*)(cb + 2048 + cbn);
          float u[10][2];
#pragma unroll
          for (int j = 0; j < 10; ++j) { u[j][0] = bflo(sc[j]) * bflo(sh[j]); u[j][1] = bfhi(sc[j]) * bfhi(sh[j]); }
#pragma unroll
          for (int i = 0; i < 8; ++i) {
              const float ya = bflo(sg[i]) * (w0.x * u[i][0] + w1.x * u[i + 1][0] + w2.x * u[i + 2][0]);
              const float yb = bfhi(sg[i]) * (w0.y * u[i][1] + w1.y * u[i + 1][1] + w2.y * u[i + 2][1]);
              *(unsigned*)(YB + (size_t)(tw + i) * 1024 + cbn) = pk2(ya, yb); } }
        if (h == 0 && lane < 8) {
            const float* AB = (const float*)(ws + O_AB); float* G = (float*)(ws + O_G); float* BT = (float*)(ws + O_BETA); const int tok = tw + lane;
#pragma unroll
            for (int q4 = 0; q4 < 4; ++q4) { const f32x4 a4 = *(const f32x4*)(AB + (size_t)tok * 32 + q4 * 4), b4 = *(const f32x4*)(AB + (size_t)tok * 32 + 16 + q4 * 4); f32x4 go, bo;
#pragma unroll
                for (int j = 0; j < 4; ++j) { const int dh = q4 * 4 + j; const float a = a4[j] + p.dt_bias[L * 16 + dh];
                    const float sp = fmaxf(a, 0.f) + log1pf(__expf(-fabsf(a)));
                    go[j] = -__expf(p.a_log[L * 16 + dh]) * sp; bo[j] = sigmoidf_(b4[j]); }
                *(f32x4*)(G + (size_t)tok * 16 + q4 * 4) = go; *(f32x4*)(BT + (size_t)tok * 16 + q4 * 4) = bo; }
        }
    }
    const bf16_t* CV = (const bf16_t*)(ws + O_CV); bf16_t* VT = (bf16_t*)(ws + O_VT);
    for (int it = gw; it < 6144; it += nw) {
        const int hc = it % 12, hf = it / 12, g = hc >> 2, hq = hc & 3, t0 = hf * 32, dsh = g * 2, D = 1 << dsh;
        int s0, Ls; seq_of(t0, s0, Ls); const int l = Ls >> dsh;
        unsigned xv[32];
#pragma unroll
        for (int j = 0; j < 32; ++j) xv[j] = *(const unsigned*)(CV + (size_t)(t0 + j) * 1536 + hc * 128 + 2 * lane);
        bf16_t* vrow = VT + (size_t)g * 512 * VTLD + (size_t)(hq * 128 + 2 * lane) * VTLD + 128;
        if (g == 0) {
#pragma unroll
            for (int u = 0; u < 8; ++u) { const int col = t0 + 4 * u; u32x2 lo, hi;
                lo.x = (xv[4 * u] & 0xffffu) | (xv[4 * u + 1] << 16); lo.y = (xv[4 * u + 2] & 0xffffu) | (xv[4 * u + 3] << 16);
                hi.x = (xv[4 * u] >> 16) | (xv[4 * u + 1] & 0xffff0000u); hi.y = (xv[4 * u + 2] >> 16) | (xv[4 * u + 3] & 0xffff0000u);
                *(u32x2*)(vrow + col) = lo; *(u32x2*)(vrow + VTLD + col) = hi; }
        } else if (g == 1) {
#pragma unroll
            for (int r = 0; r < 4; ++r)
#pragma unroll
                for (int m0 = 0; m0 < 8; m0 += 4) { const int col = s0 + r * l + ((t0 - s0) >> 2) + m0; u32x2 lo, hi;
                    const unsigned e0 = xv[(m0 + 0) * 4 + r], e1 = xv[(m0 + 1) * 4 + r], e2 = xv[(m0 + 2) * 4 + r], e3 = xv[(m0 + 3) * 4 + r];
                    lo.x = (e0 & 0xffffu) | (e1 << 16); lo.y = (e2 & 0xffffu) | (e3 << 16); hi.x = (e0 >> 16) | (e1 & 0xffff0000u); hi.y = (e2 >> 16) | (e3 & 0xffff0000u);
                    *(u32x2*)(vrow + col) = lo; *(u32x2*)(vrow + VTLD + col) = hi; }
        } else {
#pragma unroll
            for (int r = 0; r < 16; ++r) { const int col = s0 + r * l + ((t0 - s0) >> 4);
                const unsigned e0 = xv[r], e1 = xv[16 + r];
                *(unsigned*)(vrow + col) = (e0 & 0xffffu) | (e1 << 16); *(unsigned*)(vrow + VTLD + col) = (e0 >> 16) | (e1 & 0xffff0000u); }
        }
        if (hf == 0) {
            bf16_t* rowp = VT + (size_t)g * 512 * VTLD + (size_t)(hq * 128) * VTLD; const u32x4 z = {0u, 0u, 0u, 0u};
            for (int q = lane; q < 128 * 32; q += 64) { const int d = q >> 5, piece = q & 31; const int coff = piece < 16 ? piece * 8 : 128 + T_ + (piece - 16) * 8;
                *(u32x4*)(rowp + (size_t)d * VTLD + coff) = z; }
        }
    }
}

__device__ void gdn_local(const Params& p, unsigned char* smem) {
    const int tid = tid_l(), wid = tid >> 6, lane = tid & 63, fr = lane & 15, fq = lane >> 4;
    unsigned char* ws = p.ws;
    float* Lm = (float*)(smem + wid * 16384);
    float* gcs = (float*)(smem + 131072 + wid * 512); float* bts = gcs + 64;
    const float* G = (const float*)(ws + O_G); const float* BT = (const float*)(ws + O_BETA); const bf16_t* QKV = (const bf16_t*)(ws + O_QKV);
    float* GCP = (float*)(ws + O_GCP); bf16_t* TG = (bf16_t*)(ws + O_TINV); bf16_t* AG = (bf16_t*)(ws + O_AIN);
    for (int item = bid_l() * 8 + wid; item < 4096; item += gridDim.x * 8) {
        const int dir = item & 1, h = (item >> 1) & 7, ch = item >> 4, t0 = ch * 64;
        const int pl = dir ? 63 - lane : lane;
        float gc = G[(size_t)(t0 + pl) * 16 + dir * 8 + h];
        const float bt = BT[(size_t)(t0 + pl) * 16 + dir * 8 + h];
#pragma unroll
        for (int off = 1; off < 64; off <<= 1) { const float v = __shfl_up(gc, off); if (lane >= off) gc += v; }
        LDS_WAIT();
        gcs[lane] = gc; bts[lane] = bt;
        GCP[(size_t)item * 64 + pl] = gc;
        LDS_WAIT();
        {
            bf16x8 kf[4][4];
#pragma unroll
            for (int mt = 0; mt < 4; ++mt) { const int a = mt * 16 + fr, pp = dir ? 63 - a : a;
#pragma unroll
                for (int kb = 0; kb < 4; ++kb) kf[mt][kb] = *(const bf16x8*)(QKV + (size_t)(t0 + pp) * 3072 + 1024 + h * 128 + kb * 32 + fq * 8); }
#pragma unroll
            for (int mt = 0; mt < 4; ++mt)
#pragma unroll
                for (int nt = 0; nt <= mt; ++nt) { f32x4 acc = {0.f, 0.f, 0.f, 0.f};
#pragma unroll
                    for (int kb = 0; kb < 4; ++kb) acc = MFMA16(kf[mt][kb], kf[nt][kb], acc);
                    const int b = nt * 16 + fr; const float gb = gcs[b];
#pragma unroll
                    for (int j = 0; j < 4; ++j) { const int a = mt * 16 + fq * 4 + j;
                        Lm[a * 64 + b] = (a > b) ? acc[j] * bts[a] * __expf(gcs[a] - gb) : 0.f; } }
        }
        LDS_WAIT();
        float x[64];
#pragma unroll
        for (int i = 0; i < 64; ++i) { int ln = lane; asm volatile("" : "+v"(ln)); float s = (i == ln) ? 1.f : 0.f;
#pragma unroll
            for (int j = 0; j < i; ++j) s -= Lm[i * 64 + j] * x[j];
            x[i] = s; asm volatile("" ::: "memory"); }
        LDS_WAIT();
        {
            unsigned short* Xs = (unsigned short*)Lm; const int idx0 = dir ? 4095 - lane : lane, st = dir ? -64 : 64;
#pragma unroll
            for (int a = 0; a < 64; a += 2) { const unsigned w = pk2(x[a], x[a + 1]); Xs[idx0 + a * st] = (unsigned short)(w & 0xffffu); Xs[idx0 + (a + 1) * st] = (unsigned short)(w >> 16); }
            LDS_WAIT();
            u32x4* dst = (u32x4*)(TG + (size_t)item * 4096);
#pragma unroll
            for (int k = 0; k < 8; ++k) dst[k * 64 + lane] = ((const u32x4*)Xs)[k * 64 + lane];
            LDS_WAIT();
        }
        {
            bf16x8 kf[4][4];
#pragma unroll
            for (int mt = 0; mt < 4; ++mt) { const int a = mt * 16 + fr, pp = dir ? 63 - a : a;
#pragma unroll
                for (int kb = 0; kb < 4; ++kb) kf[mt][kb] = *(const bf16x8*)(QKV + (size_t)(t0 + pp) * 3072 + 1024 + h * 128 + kb * 32 + fq * 8); }
            unsigned short* As = (unsigned short*)Lm;
#pragma unroll 1
            for (int mt = 0; mt < 4; ++mt) { bf16x8 qf[4]; const int aq = mt * 16 + fr, pq = dir ? 63 - aq : aq;
#pragma unroll
                for (int kb = 0; kb < 4; ++kb) qf[kb] = *(const bf16x8*)(QKV + (size_t)(t0 + pq) * 3072 + h * 128 + kb * 32 + fq * 8);
#pragma unroll
                for (int nt = 0; nt < 4; ++nt) { f32x4 acc = {0.f, 0.f, 0.f, 0.f};
                    if (nt <= mt) {
#pragma unroll
                        for (int kb = 0; kb < 4; ++kb) acc = MFMA16(qf[kb], kf[nt][kb], acc); }
                    const int b = nt * 16 + fr; const float gb = gcs[b];
#pragma unroll
                    for (int j = 0; j < 4; ++j) { const int a = mt * 16 + fq * 4 + j, n = a * 64 + b;
                        const float v = (a >= b) ? acc[j] * __expf(gcs[a] - gb) : 0.f;
                        As[dir ? 4095 - n : n] = f2bf(v); } } }
            LDS_WAIT();
            u32x4* dst = (u32x4*)(AG + (size_t)item * 4096);
#pragma unroll
            for (int k = 0; k < 8; ++k) dst[k * 64 + lane] = ((const u32x4*)As)[k * 64 + lane];
            LDS_WAIT();
        }
    }
}

#ifndef SCAN_DUPLOAD
#define SCAN_DUPLOAD 0
#endif
constexpr int SCAN_NT = 1;
__device__ void gdn_scan(const Params& p, unsigned char* smem, int chain_half) {
    constexpr int NT = SCAN_NT; static_assert(NT == 1, "block map below assumes two workgroups per chain");
    const int chain = (chain_half >> 4) * 8 + (chain_half & 7), dvh = (chain_half >> 3) & 1;
    const int tid = tid_l(), wid = tid >> 6, lane = tid & 63, fr = lane & 15, fq = lane >> 4;
    unsigned char* ws = p.ws;
    int seq, h, dir, nch, c0;
    if (chain < 32) { seq = chain >> 4; h = (chain >> 1) & 7; dir = chain & 1; nch = 64; c0 = seq * 64; }
    else { const int b = chain - 32; seq = b >> 4; h = (b >> 1) & 7; dir = b & 1; nch = 32; c0 = 128 + seq * 32; }
    unsigned char* kS = smem; unsigned char* qS = smem + 17408; unsigned char* vS = smem + 34816; unsigned char* kTS = smem + 52224;
    unsigned char* TiS = smem + 70656; unsigned char* AS = smem + 79872; float* gS = (float*)(smem + 89088); float* bS = (float*)(smem + 89344);
    const bf16_t* QKV = (const bf16_t*)(ws + O_QKV); const bf16_t* KT = (const bf16_t*)(ws + O_KT); const bf16_t* TG = (const bf16_t*)(ws + O_TINV); const bf16_t* AG = (const bf16_t*)(ws + O_AIN);
    const float* GCP = (const float*)(ws + O_GCP); const float* BT = (const float*)(ws + O_BETA);
    float* of = (float*)(ws + (dir ? O_OBWD : O_OFWD));
    const bool loader = wid >= 4; const int lt = tid - 256;
#define RAW_BAR() do { asm volatile("" ::: "memory"); __builtin_amdgcn_s_barrier(); asm volatile("" ::: "memory"); } while (0)
    u32x4 pq[2][4], pk[2][4], pv[2][4], pt[2][4], pti[2][2], pa[2][2]; float pgb[2] = {0.f, 0.f};
#define SCAN_LOAD(s_, ci_) do { const int cgl = c0 + (dir ? nch - 1 - (ci_) : (ci_)), tl = cgl * 64, iteml = (cgl * 8 + h) * 2 + dir; \
        _Pragma("unroll") for (int rep = 0; rep < 4; ++rep) { const int pid = lt + rep * 256, row = pid >> 4, seg = pid & 15; \
            const bf16_t* src = QKV + (size_t)(tl + row) * 3072 + h * 128 + seg * 8; \
            pq[s_][rep] = *(const u32x4*)(src); pk[s_][rep] = *(const u32x4*)(src + 1024); pv[s_][rep] = *(const u32x4*)(src + 2048); \
            if (SCAN_DUPLOAD) { asm volatile("" : "+v"(pq[s_][rep]), "+v"(pk[s_][rep]), "+v"(pv[s_][rep])); pq[s_][rep] = *(const volatile u32x4*)(src); pk[s_][rep] = *(const volatile u32x4*)(src + 1024); pv[s_][rep] = *(const volatile u32x4*)(src + 2048); } \
            const int rowt = pid >> 3, segt = pid & 7; \
            pt[s_][rep] = *(const u32x4*)(KT + ((size_t)(cgl * 8 + h) * 128 + rowt) * 64 + segt * 8); } \
        _Pragma("unroll") for (int rep = 0; rep < 2; ++rep) { const int pid = lt + rep * 256, row = pid >> 3, seg = pid & 7; \
          pti[s_][rep] = *(const u32x4*)(TG + (size_t)iteml * 4096 + row * 64 + seg * 8); pa[s_][rep] = *(const u32x4*)(AG + (size_t)iteml * 4096 + row * 64 + seg * 8); } \
        { const float* gp_ = (lt < 64) ? (GCP + (size_t)iteml * 64 + lt) : (BT + (size_t)(tl + (lt & 63)) * 16 + dir * 8 + h); pgb[s_] = *gp_; } } while (0)
#define SCAN_STORE(s_) do { \
        _Pragma("unroll") for (int rep = 0; rep < 4; ++rep) { const int pid = lt + rep * 256, row = pid >> 4, seg = pid & 15; \
            *(u32x4*)(qS + row * 272 + seg * 16) = pq[s_][rep]; *(u32x4*)(kS + row * 272 + seg * 16) = pk[s_][rep]; *(u32x4*)(vS + row * 272 + seg * 16) = pv[s_][rep]; \
            const int rowt = pid >> 3, segt = pid & 7; \
            *(u32x4*)(kTS + rowt * 144 + segt * 16) = pt[s_][rep]; } \
        _Pragma("unroll") for (int rep = 0; rep < 2; ++rep) { const int pid = lt + rep * 256, row = pid >> 3, seg = pid & 7; \
            *(u32x4*)(TiS + row * 144 + seg * 16) = pti[s_][rep]; *(u32x4*)(AS + row * 144 + seg * 16) = pa[s_][rep]; } \
        if (lt < 64) gS[lt] = pgb[s_]; else if (lt < 128) bS[lt - 64] = pgb[s_]; } while (0)
    f32x4 S[NT][8];
#pragma unroll
    for (int nt = 0; nt < NT; ++nt)
#pragma unroll
        for (int i = 0; i < 8; ++i) S[nt][i] = (f32x4){0.f, 0.f, 0.f, 0.f};
    const int e0 = dvh * 64 + (wid & 3) * 16 * NT;
    if (loader) {
        SCAN_LOAD(0, 0); SCAN_LOAD(1, 1);
        for (int ci = 0; ci < nch; ci += 2) {
            RAW_BAR();
            SCAN_STORE(0);
            asm volatile("s_waitcnt lgkmcnt(0)" ::: "memory"); RAW_BAR();
            SCAN_LOAD(0, (ci + 2 < nch ? ci + 2 : nch - 1));
            RAW_BAR();
            SCAN_STORE(1);
            asm volatile("s_waitcnt lgkmcnt(0)" ::: "memory"); RAW_BAR();
            SCAN_LOAD(1, (ci + 3 < nch ? ci + 3 : nch - 1));
        }
    } else {
    for (int ci = 0; ci < nch; ++ci) {
        const int cg_ = c0 + (dir ? nch - 1 - ci : ci), t0 = cg_ * 64;
        asm volatile("s_waitcnt lgkmcnt(0)" ::: "memory"); RAW_BAR();
        RAW_BAR();
        {
#define SCHED_FENCE() __builtin_amdgcn_sched_barrier(0)
#define LD272(base, mt_, f) do { _Pragma("unroll") for (int kb = 0; kb < 4; ++kb) { const int off = ((mt_) * 16 + fr) * 272 + (kb * 32 + fq * 4) * 2; \
                (f)[kb] = mk8(*(const u32x2*)((base) + off), *(const u32x2*)((base) + off + 32)); } } while (0)
#define LD144(base, mt_, f) do { _Pragma("unroll") for (int kb = 0; kb < 2; ++kb) { const int off = ((mt_) * 16 + fr) * 144 + (kb * 32 + fq * 4) * 2; \
                (f)[kb] = mk8(*(const u32x2*)((base) + off), *(const u32x2*)((base) + off + 32)); } } while (0)
#define MMA4(ACC, mt_, f) do { _Pragma("unroll") for (int kb = 0; kb < 4; ++kb) _Pragma("unroll") for (int nt = 0; nt < NT; ++nt) ACC[nt][mt_] = MFMA16((f)[kb], Sb[nt][kb], ACC[nt][mt_]); } while (0)
            bf16x8 Sb[NT][4];
#pragma unroll
            for (int nt = 0; nt < NT; ++nt)
#pragma unroll
                for (int kb = 0; kb < 4; ++kb) Sb[nt][kb] = pack8(S[nt][2 * kb], S[nt][2 * kb + 1]);
            f32x4 KS[NT][4], QS[NT][4];
#pragma unroll
            for (int mt = 0; mt < 4; ++mt)
#pragma unroll
                for (int nt = 0; nt < NT; ++nt) { KS[nt][mt] = (f32x4){0.f, 0.f, 0.f, 0.f}; QS[nt][mt] = (f32x4){0.f, 0.f, 0.f, 0.f}; }
            bf16x8 fa[4], fb[4];
            LD272(kS, 0, fa);
            LD272(kS, 1, fb); SCHED_FENCE(); MMA4(KS, 0, fa); SCHED_FENCE();
            LD272(kS, 2, fa); SCHED_FENCE(); MMA4(KS, 1, fb); SCHED_FENCE();
            LD272(kS, 3, fb); SCHED_FENCE(); MMA4(KS, 2, fa); SCHED_FENCE();
            LD272(qS, 0, fa); SCHED_FENCE(); MMA4(KS, 3, fb); SCHED_FENCE();
            LD272(qS, 1, fb); SCHED_FENCE(); MMA4(QS, 0, fa); SCHED_FENCE();
            LD272(qS, 2, fa); SCHED_FENCE(); MMA4(QS, 1, fb); SCHED_FENCE();
            LD272(qS, 3, fb); SCHED_FENCE(); MMA4(QS, 2, fa); SCHED_FENCE();
            f32x4 gv[4], bv[4]; unsigned short vraw[NT][4][4];
#pragma unroll
            for (int mt = 0; mt < 4; ++mt) { gv[mt] = *(const f32x4*)(gS + mt * 16 + fq * 4); bv[mt] = *(const f32x4*)(bS + mt * 16 + fq * 4); }
            SCHED_FENCE(); MMA4(QS, 3, fb); SCHED_FENCE();
#pragma unroll
            for (int mt = 0; mt < 4; ++mt)
#pragma unroll
                for (int j = 0; j < 4; ++j)
#pragma unroll
                    for (int nt = 0; nt < NT; ++nt) vraw[nt][mt][j] = *(const unsigned short*)(vS + (mt * 16 + fq * 4 + j) * 272 + (e0 + nt * 16 + fr) * 2);
            f32x4 eg4[4];
            bf16x8 Rb[NT][2];
            {
                f32x4 R[NT][4];
#pragma unroll
                for (int mt = 0; mt < 4; ++mt)
#pragma unroll
                    for (int j = 0; j < 4; ++j) { eg4[mt][j] = __expf(gv[mt][j]);
#pragma unroll
                        for (int nt = 0; nt < NT; ++nt) R[nt][mt][j] = bv[mt][j] * (bf2f(vraw[nt][mt][j]) - eg4[mt][j] * KS[nt][mt][j]); }
#pragma unroll
                for (int nt = 0; nt < NT; ++nt) { Rb[nt][0] = pack8(R[nt][0], R[nt][1]); Rb[nt][1] = pack8(R[nt][2], R[nt][3]); }
            }
            SCHED_FENCE();
            bf16x8 ti[4][2];
#pragma unroll
            for (int mt = 0; mt < 4; ++mt) LD144(TiS, mt, ti[mt]);
            f32x4 VN[NT][4];
#pragma unroll
            for (int mt = 0; mt < 4; ++mt) {
#pragma unroll
                for (int nt = 0; nt < NT; ++nt) VN[nt][mt] = (f32x4){0.f, 0.f, 0.f, 0.f};
#pragma unroll
                for (int kb = 0; kb < 2; ++kb)
#pragma unroll
                    for (int nt = 0; nt < NT; ++nt) VN[nt][mt] = MFMA16(ti[mt][kb], Rb[nt][kb], VN[nt][mt]); }
            SCHED_FENCE();
            bf16x8 VNb[NT][2];
#pragma unroll
            for (int nt = 0; nt < NT; ++nt) { VNb[nt][0] = pack8(VN[nt][0], VN[nt][1]); VNb[nt][1] = pack8(VN[nt][2], VN[nt][3]); }
            bf16x8 af[4][2];
#pragma unroll
            for (int mt = 0; mt < 4; ++mt) LD144(AS, mt, af[mt]);
            const float glast = gS[dir ? 0 : 63];
            SCHED_FENCE();
#pragma unroll
            for (int mt = 0; mt < 4; ++mt) { f32x4 oa[NT]; _Pragma("unroll") for (int nt = 0; nt < NT; ++nt) oa[nt] = (f32x4){0.f, 0.f, 0.f, 0.f};
#pragma unroll
                for (int kb = 0; kb < 2; ++kb)
#pragma unroll
                    for (int nt = 0; nt < NT; ++nt) oa[nt] = MFMA16(af[mt][kb], VNb[nt][kb], oa[nt]);
#pragma unroll
                for (int j = 0; j < 4; ++j) { const int c = mt * 16 + fq * 4 + j;
#pragma unroll
                    for (int nt = 0; nt < NT; ++nt) of[(size_t)(t0 + c) * 1024 + h * 128 + e0 + nt * 16 + fr] = eg4[mt][j] * QS[nt][mt][j] + oa[nt][j]; } }
            SCHED_FENCE();
            const float eg = __expf(glast);
            bf16x8 VDb[NT][2];
#pragma unroll
            for (int mt = 0; mt < 4; ++mt)
#pragma unroll
                for (int j = 0; j < 4; ++j) { const float sc = __expf(glast - gv[mt][j]); _Pragma("unroll") for (int nt = 0; nt < NT; ++nt) VN[nt][mt][j] *= sc; }
#pragma unroll
            for (int nt = 0; nt < NT; ++nt) { VDb[nt][0] = pack8(VN[nt][0], VN[nt][1]); VDb[nt][1] = pack8(VN[nt][2], VN[nt][3]); }
            bf16x8 kt0[4][2], kt1[4][2];
#pragma unroll
            for (int dt = 0; dt < 4; ++dt) { LD144(kTS, dt, kt0[dt]); LD144(kTS, 4 + dt, kt1[dt]); }
            SCHED_FENCE();
#pragma unroll
            for (int dt = 0; dt < 4; ++dt) {
#pragma unroll
                for (int nt = 0; nt < NT; ++nt) S[nt][dt] = S[nt][dt] * eg;
#pragma unroll
                for (int kb = 0; kb < 2; ++kb)
#pragma unroll
                    for (int nt = 0; nt < NT; ++nt) S[nt][dt] = MFMA16(kt0[dt][kb], VDb[nt][kb], S[nt][dt]); }
            SCHED_FENCE();
#pragma unroll
            for (int dt = 0; dt < 4; ++dt) {
#pragma unroll
                for (int nt = 0; nt < NT; ++nt) S[nt][4 + dt] = S[nt][4 + dt] * eg;
#pragma unroll
                for (int kb = 0; kb < 2; ++kb)
#pragma unroll
                    for (int nt = 0; nt < NT; ++nt) S[nt][4 + dt] = MFMA16(kt1[dt][kb], VDb[nt][kb], S[nt][4 + dt]); }
#undef SCHED_FENCE
#undef LD272
#undef LD144
#undef MMA4
        }
    }
    }
#undef SCAN_LOAD
#undef SCAN_STORE
#undef RAW_BAR
}

__device__ void attn_phase(const Params& p, unsigned char* smem, int L) {
    const int tid = tid_l(), wid = tid >> 6, lane = tid & 63, fr = lane & 15, fq = lane >> 4;
    unsigned char* ws = p.ws;
    float* btab = (float*)(smem + 131072);
    for (int idx = tid; idx < 3 * 4 * 129; idx += 512) { const int g = idx / 516, hq = (idx / 129) & 3, rr = idx % 129 - 64, D = (g == 0) ? 1 : (g == 1 ? 4 : 16);
        const int rel = rr * D, n = rel < 0 ? -rel : rel;
        int bk = (n < 8) ? n : min(15, 5 + (31 - __clz(n)));
        if (rel > 0) bk += 16;
        btab[idx] = p.rel_bias[bk * 12 + g * 4 + hq]; }
    const bf16_t* CQ = (const bf16_t*)(ws + O_CQ); const bf16_t* CK = (const bf16_t*)(ws + O_CK); const bf16_t* VT = (const bf16_t*)(ws + O_VT);
    bf16_t* OG = (bf16_t*)(ws + O_OG); float* LSE = (float*)(ws + O_LSE);
    unsigned char* Ks = smem;
    unsigned* qctr = (unsigned*)(ws + O_QCTR) + L * 64;
    volatile LAS unsigned* slot = (volatile LAS unsigned*)(smem + LDS_BAR_ST) + 2;
    for (;;) {
        __syncthreads();
        if (tid == 0) *slot = __hip_atomic_fetch_add(qctr, 1u, __ATOMIC_RELAXED, __HIP_MEMORY_SCOPE_AGENT);
        __syncthreads();
        const int bi = (int)*slot;
        if (bi >= 768) break;
        const int g = bi >> 8, rem = bi & 255, hq = rem >> 6, bt = rem & 63, dsh = g * 2, D = 1 << dsh, hc = g * 4 + hq, cb = bt * 256;
        __syncthreads();
        {
            u32x4 kv[12];
#pragma unroll
            for (int rep = 0; rep < 12; ++rep) { const int pid = tid + rep * 512, row = pid >> 4, seg = pid & 15;
                int c = cb - 64 + row; c = c < 0 ? 0 : (c > T_ - 1 ? T_ - 1 : c);
                int s0, Ls; seq_of(c, s0, Ls); const int lsh = (Ls == 4096 ? 12 : 11) - dsh, rr = (c - s0) >> lsh, ii = (c - s0) & ((1 << lsh) - 1);
                kv[rep] = *(const u32x4*)(CK + (size_t)(s0 + ii * D + rr) * 1536 + hc * 128 + seg * 8); }
#pragma unroll
            for (int rep = 0; rep < 12; ++rep) { const int pid = tid + rep * 512, row = pid >> 4, seg = pid & 15; *(u32x4*)(Ks + row * 272 + seg * 16) = kv[rep]; }
        }
        const int col0 = cb + wid * 32; int s0, Ls; seq_of(col0, s0, Ls); const int l = Ls >> dsh, r = (col0 - s0) / l, i0 = (col0 - s0) - r * l;
        bf16x8 qf[2][4];
#pragma unroll
        for (int nq = 0; nq < 2; ++nq) { const size_t tq = (size_t)(s0 + (i0 + nq * 16 + fr) * D + r);
#pragma unroll
            for (int kb = 0; kb < 4; ++kb) qf[nq][kb] = *(const bf16x8*)(CQ + tq * 1536 + hc * 128 + kb * 32 + fq * 8); }
        __syncthreads();
        f32x4 st[10][2];
#pragma unroll
        for (int kt = 0; kt < 10; ++kt) { const unsigned char* kp = Ks + (wid * 32 + kt * 16 + fr) * 272 + fq * 16;
            st[kt][0] = (f32x4){0.f, 0.f, 0.f, 0.f}; st[kt][1] = (f32x4){0.f, 0.f, 0.f, 0.f};
#pragma unroll
            for (int kb = 0; kb < 4; ++kb) { const bf16x8 kfr = *(const bf16x8*)(kp + kb * 64);
                st[kt][0] = MFMA16(kfr, qf[0][kb], st[kt][0]); st[kt][1] = MFMA16(kfr, qf[1][kb], st[kt][1]); } }
        const float* bt_ = btab + hc * 129 + 64;
        float mx[2] = {-1e30f, -1e30f};
#pragma unroll
        for (int kt = 0; kt < 10; ++kt)
#pragma unroll
            for (int nq = 0; nq < 2; ++nq)
#pragma unroll
                for (int j = 0; j < 4; ++j) { const int rel = -64 + kt * 16 + fq * 4 + j - nq * 16 - fr, kidx = i0 - 64 + kt * 16 + fq * 4 + j;
                    const bool valid = (rel >= -64) && (rel <= 64) && (kidx >= 0) && (kidx < l);
                    const int rc = rel < -64 ? -64 : (rel > 64 ? 64 : rel);
                    const float sv = valid ? st[kt][nq][j] * 0.08838834764831845f + bt_[rc] : -1e30f;
                    st[kt][nq][j] = sv; mx[nq] = fmaxf(mx[nq], sv); }
        float sm[2];
#pragma unroll
        for (int nq = 0; nq < 2; ++nq) { mx[nq] = fmaxf(mx[nq], __shfl_xor(mx[nq], 16)); mx[nq] = fmaxf(mx[nq], __shfl_xor(mx[nq], 32)); sm[nq] = 0.f; }
#pragma unroll
        for (int kt = 0; kt < 10; ++kt)
#pragma unroll
            for (int nq = 0; nq < 2; ++nq)
#pragma unroll
                for (int j = 0; j < 4; ++j) { const float e = __expf(st[kt][nq][j] - mx[nq]); st[kt][nq][j] = e; sm[nq] += e; }
#pragma unroll
        for (int nq = 0; nq < 2; ++nq) { sm[nq] += __shfl_xor(sm[nq], 16); sm[nq] += __shfl_xor(sm[nq], 32); }
        bf16x8 Pb[5][2];
#pragma unroll
        for (int kb = 0; kb < 5; ++kb) { Pb[kb][0] = pack8(st[2 * kb][0], st[2 * kb + 1][0]); Pb[kb][1] = pack8(st[2 * kb][1], st[2 * kb + 1][1]); }
        __syncthreads();
        {
            u32x4 vv[12]; const bf16_t* vsrc = VT + (size_t)g * 512 * VTLD + (size_t)(hq * 128) * VTLD + 128 + cb - 64;
#pragma unroll
            for (int rep = 0; rep < 12; ++rep) { const int pid = tid + rep * 512, d = pid / 48, seg = pid - d * 48; vv[rep] = *(const u32x4*)(vsrc + (size_t)d * VTLD + seg * 8); }
#pragma unroll
            for (int rep = 0; rep < 12; ++rep) { const int pid = tid + rep * 512, d = pid / 48, seg = pid - d * 48; *(u32x4*)(Ks + d * 784 + seg * 16) = vv[rep]; }
        }
        __syncthreads();
        f32x4 ot[8][2];
#pragma unroll
        for (int dt = 0; dt < 8; ++dt) { ot[dt][0] = (f32x4){0.f, 0.f, 0.f, 0.f}; ot[dt][1] = (f32x4){0.f, 0.f, 0.f, 0.f}; }
#pragma unroll
        for (int kb = 0; kb < 5; ++kb) {
#pragma unroll
            for (int dt = 0; dt < 8; ++dt) { const unsigned char* vp = Ks + (dt * 16 + fr) * 784 + (wid * 32 + kb * 32 + fq * 4) * 2;
                const bf16x8 va = mk8(*(const u32x2*)vp, *(const u32x2*)(vp + 32));
                ot[dt][0] = MFMA16(va, Pb[kb][0], ot[dt][0]); ot[dt][1] = MFMA16(va, Pb[kb][1], ot[dt][1]); } }
#pragma unroll
        for (int nq = 0; nq < 2; ++nq) { const size_t tq = (size_t)(s0 + (i0 + nq * 16 + fr) * D + r); const float inv = 1.0f / sm[nq];
            bf16_t* op = OG + (size_t)g * T_ * 512 + tq * 512 + hq * 128 + fq * 4;
#pragma unroll
            for (int dt = 0; dt < 8; ++dt) { u32x2 o; o.x = pk2(ot[dt][nq][0] * inv, ot[dt][nq][1] * inv); o.y = pk2(ot[dt][nq][2] * inv, ot[dt][nq][3] * inv); *(u32x2*)(op + dt * 16) = o; }
            if (fq == 0) LSE[(size_t)g * T_ * 4 + tq * 4 + hq] = mx[nq] + __logf(sm[nq]); }
    }
}

__device__ void post_phase(const Params& p, int L) {
    const int tid = tid_l(), lane = tid & 63, gw = bid_l() * 8 + (tid >> 6), nw = gridDim.x * 8;
    unsigned char* ws = p.ws;
    const float* OF = (const float*)(ws + O_OFWD); const float* OB = (const float*)(ws + O_OBWD); const bf16_t* Z = (const bf16_t*)(ws + O_SZ);
    bf16_t* YA = (bf16_t*)(ws + O_YA); bf16_t* YC = (bf16_t*)(ws + O_YC); const bf16_t* OG = (const bf16_t*)(ws + O_OG); const float* LSE = (const float*)(ws + O_LSE);
    const f32x4 hn = *(const f32x4*)(p.head_norm + L * 128 + (lane & 31) * 4);
    for (int tp = gw * 2; tp < T_; tp += nw * 2) {
        f32x4 a[2][4], b[2][4]; u32x2 z[2][4]; float ls[2][3]; u32x4 og[2][3];
#pragma unroll
        for (int u = 0; u < 2; ++u) { const size_t t = (size_t)(tp + u);
#pragma unroll
            for (int i = 0; i < 4; ++i) { a[u][i] = *(const f32x4*)(OF + t * 1024 + i * 256 + lane * 4); b[u][i] = *(const f32x4*)(OB + t * 1024 + i * 256 + lane * 4);
                z[u][i] = *(const u32x2*)(Z + t * 1024 + i * 256 + lane * 4); }
#pragma unroll
            for (int g = 0; g < 3; ++g) { ls[u][g] = LSE[(size_t)g * T_ * 4 + t * 4 + (lane >> 4)]; og[u][g] = *(const u32x4*)(OG + (size_t)g * T_ * 512 + t * 512 + lane * 8); } }
#pragma unroll
        for (int u = 0; u < 2; ++u) { const size_t t = (size_t)(tp + u);
            float ss[4];
#pragma unroll
            for (int i = 0; i < 4; ++i) { a[u][i] = a[u][i] + b[u][i]; ss[i] = a[u][i][0] * a[u][i][0] + a[u][i][1] * a[u][i][1] + a[u][i][2] * a[u][i][2] + a[u][i][3] * a[u][i][3]; }
#pragma unroll
            for (int off = 16; off > 0; off >>= 1)
#pragma unroll
                for (int i = 0; i < 4; ++i) ss[i] += __shfl_xor(ss[i], off);
#pragma unroll
            for (int i = 0; i < 4; ++i) { const float rstd = rsqrtf(ss[i] * (1.0f / 128.0f) + 1e-6f);
                u32x2 o; o.x = pk2(a[u][i][0] * rstd * hn[0] * siluf_(bflo(z[u][i].x)), a[u][i][1] * rstd * hn[1] * siluf_(bfhi(z[u][i].x)));
                o.y = pk2(a[u][i][2] * rstd * hn[2] * siluf_(bflo(z[u][i].y)), a[u][i][3] * rstd * hn[3] * siluf_(bfhi(z[u][i].y)));
                *(u32x2*)(YA + t * 1024 + i * 256 + lane * 4) = o; }
            const float l0 = ls[u][0], l1 = ls[u][1], l2 = ls[u][2];
            const float m = fmaxf(l0, fmaxf(l1, l2)); float a0 = __expf(l0 - m), a1 = __expf(l1 - m), a2 = __expf(l2 - m); const float inv = 1.0f / (a0 + a1 + a2); a0 *= inv; a1 *= inv; a2 *= inv;
            const u32x4 g0 = og[u][0], g1 = og[u][1], g2 = og[u][2];
            u32x4 yo;
            yo.x = pk2(a0 * bflo(g0.x) + a1 * bflo(g1.x) + a2 * bflo(g2.x), a0 * bfhi(g0.x) + a1 * bfhi(g1.x) + a2 * bfhi(g2.x));
            yo.y = pk2(a0 * bflo(g0.y) + a1 * bflo(g1.y) + a2 * bflo(g2.y), a0 * bfhi(g0.y) + a1 * bfhi(g1.y) + a2 * bfhi(g2.y));
            yo.z = pk2(a0 * bflo(g0.z) + a1 * bflo(g1.z) + a2 * bflo(g2.z), a0 * bfhi(g0.z) + a1 * bfhi(g1.z) + a2 * bfhi(g2.z));
            yo.w = pk2(a0 * bflo(g0.w) + a1 * bflo(g1.w) + a2 * bflo(g2.w), a0 * bfhi(g0.w) + a1 * bfhi(g1.w) + a2 * bfhi(g2.w));
            *(u32x4*)(YC + t * 512 + lane * 8) = yo; }
    }
}

constexpr int NPHASE = 23;
__device__ __forceinline__ void do_phase(const Params& p, int ph, unsigned char* smem) {
    unsigned char* ws = p.ws;
    if (ph == 22) { norm_rows(p, 2, p.norm_final, nullptr); return; }
    const int L = ph / 11, k = ph - L * 11;
    switch (k) {
    case 0: {
        const float* tile = nullptr;
        conv_tiles(p.w_in + (size_t)L * DM * 17952, DM, 17952, 281, (bf16_t*)(ws + O_WT_IN), 1, p.norm_mix + L * DM);
        if (L == 0) { conv_tiles(p.w_up, DM, DFF, 128, (bf16_t*)(ws + O_WT_UP), 0, p.norm_mlp);
                      conv_tiles(p.w_down, DFF, DM, 32, (bf16_t*)(ws + O_WT_DOWN), 0, tile); }
        conv_tiles(p.w_out + (size_t)L * DM * DM, DM, DM, 32, (bf16_t*)(ws + O_WT_OUT), 0, tile);
        conv_tiles(p.w_br_a + (size_t)L * 1024 * DM, 1024, DM, 32, (bf16_t*)(ws + O_WT_BRA), 0, tile);
        conv_tiles(p.w_br_b + (size_t)L * 1024 * DM, 1024, DM, 32, (bf16_t*)(ws + O_WT_BRB), 0, tile);
        conv_tiles(p.w_br_c + (size_t)L * 512 * DM, 512, DM, 32, (bf16_t*)(ws + O_WT_BRC), 0, tile);
        if (L == 0) norm_rows(p, 0, nullptr, (bf16_t*)(ws + O_XN));
    } break;
    case 1: { EpiProj E; E.ws = ws; E.ssq = (const u64_t*)(ws + O_SSQ) + (size_t)(2 * L) * T_; run_gemm(smem, (L == 0) ? (const bf16_t*)(ws + O_XN) : (const bf16_t*)p.out, (const bf16_t*)(ws + O_WT_IN), T_, NPROJ, DM, E); } break;
    case 2: prep_phase(p, L, smem); break;
    case 3: gdn_local(p, smem); break;
    case 4: {
        const int bid = bid_l();
#ifndef SCAN_REP
#define SCAN_REP 1
#endif
        constexpr int NSCAN = 96 * (2 / SCAN_NT);
        if (bid < NSCAN) { int nr = SCAN_REP; asm volatile("" : "+s"(nr));
#pragma unroll 1
            for (int rr = 0; rr < nr; ++rr) { gdn_scan(p, smem, bid); __syncthreads(); } }
        attn_phase(p, smem, L);
        if (L == 0) { unsigned* qc = (unsigned*)(ws + O_QCTR);
            conv_queue(p.w_up + (size_t)DM * DFF, DM, DFF, 128, (bf16_t*)(ws + O_WT_UP1), p.norm_mlp + DM, qc + 16, smem);
            conv_queue(p.w_down + (size_t)DFF * DM, DFF, DM, 32, (bf16_t*)(ws + O_WT_DOWN1), nullptr, qc + 32, smem); }
    } break;
    case 5: post_phase(p, L); break;
    case 6: {
        EpiBranch E; E.merged = (bf16_t*)(ws + O_XN); E.gates = (const bf16_t*)(ws + O_GATES);
        for (int b = 0; b < 3; ++b) { E.goff = b * DM; E.mode = b;
            const bf16_t* A = (const bf16_t*)(ws + (b == 0 ? O_YA : (b == 1 ? O_YB : O_YC))); const bf16_t* Bt = (const bf16_t*)(ws + (b == 0 ? O_WT_BRA : (b == 1 ? O_WT_BRB : O_WT_BRC)));
            run_gemm(smem, A, Bt, T_, DM, b == 2 ? 512 : 1024, E); }
    } break;
    case 7: { EpiResid E; E.xp = (L == 0) ? p.x_prompt : nullptr; E.xs = p.x_sample; E.hin = (const bf16_t*)p.out; E.hout = (bf16_t*)(ws + O_HB2); E.ssq = (u64_t*)(ws + O_SSQ) + (size_t)(2 * L + 1) * T_;
              run_gemm(smem, (const bf16_t*)(ws + O_XN), (const bf16_t*)(ws + O_WT_OUT), T_, DM, DM, E); } break;
    case 8: break;
    case 9: { EpiUp E; E.O = (bf16_t*)(ws + O_HID); E.ssq = (const u64_t*)(ws + O_SSQ) + (size_t)(2 * L + 1) * T_; run_gemm(smem, (const bf16_t*)(ws + O_HB2), (const bf16_t*)(ws + (L == 0 ? O_WT_UP : O_WT_UP1)), T_, DFF, DM, E); } break;
    case 10: { EpiResid E; E.xp = nullptr; E.xs = nullptr; E.hin = (const bf16_t*)(ws + O_HB2); E.hout = (L == 0) ? (bf16_t*)p.out : (bf16_t*)(ws + O_XN); E.ssq = (u64_t*)(ws + O_SSQ) + (size_t)(2 * L + 2) * T_;
               run_gemm(smem, (const bf16_t*)(ws + O_HID), (const bf16_t*)(ws + (L == 0 ? O_WT_DOWN : O_WT_DOWN1)), T_, DM, DFF, E); } break;
    }
}

__device__ __forceinline__ Params load_params() {
    Params q{};
#if defined(__HIP_DEVICE_COMPILE__)
    typedef const __attribute__((address_space(4))) unsigned long long* KP;
    KP kp = (KP)__builtin_amdgcn_kernarg_segment_ptr(); asm volatile("" : "+s"(kp));
#define GPF(i) ((const float*)(const __attribute__((address_space(1))) float*)kp[i])
    q.x_prompt = GPF(0); q.x_sample = GPF(1); q.rel_bias = GPF(2); q.norm_mix = GPF(3); q.w_in = GPF(4);
    q.conv_a = GPF(5); q.a_log = GPF(6); q.dt_bias = GPF(7); q.head_norm = GPF(8); q.conv_b = GPF(9);
    q.w_br_a = GPF(10); q.w_br_b = GPF(11); q.w_br_c = GPF(12); q.w_out = GPF(13); q.norm_mlp = GPF(14);
    q.w_up = GPF(15); q.w_down = GPF(16); q.norm_final = GPF(17); q.out = (float*)(__attribute__((address_space(1))) float*)kp[18]; q.ws = (unsigned char*)(__attribute__((address_space(1))) unsigned char*)kp[19];
#undef GPF
#endif
    return q;
}
#ifndef DUP_MASK
#define DUP_MASK 0
#endif
__device__ __forceinline__ void grid_barrier(unsigned char* smem) {
    XcdBarrier b; { const Params q = load_params(); b.bar = (unsigned*)(q.ws + O_BAR); } b.x = xb_xcc_id(); b.st = (volatile LAS unsigned*)(smem + LDS_BAR_ST);
    xcd_barrier(b);
}
template <int PH> __device__ __forceinline__ void phase_sync(unsigned char* smem) {
    if (PH < 22 && PH % 11 == 8) return;
    if (PH < 22 && ((DUP_MASK >> (PH % 11)) & 1)) {
        int nrep = 2; asm volatile("" : "+s"(nrep));
#pragma unroll 1
        for (int rep = 0; rep < nrep; ++rep) { { const Params q = load_params(); do_phase(q, PH, smem); } grid_barrier(smem); }
    } else { { const Params q = load_params(); do_phase(q, PH, smem); } if (PH + 1 < NPHASE) grid_barrier(smem); } }
#if MEGA
__global__ __launch_bounds__(512, 2) void k_mega(Params p) {
    extern __shared__ __attribute__((aligned(16))) unsigned char smem[];
    cg::grid_group grid = cg::this_grid();
    {
        const Params q = load_params(); unsigned* bar = (unsigned*)(q.ws + O_BAR); const int tid = tid_l();
        if (bid_l() == 0) for (int i = tid; i < XCD_BAR_WORDS + 128; i += 512) bar[i] = 0u;
        if (tid < 4) ((volatile LAS unsigned*)(smem + LDS_BAR_ST))[tid] = 0u;
        __threadfence();
        grid.sync();
        (void)xcd_barrier_post(bar, (volatile LAS unsigned*)(smem + LDS_BAR_ST));
    }
#ifdef EXTRA_SYNCS
    { int ne = EXTRA_SYNCS; asm volatile("" : "+s"(ne));
#pragma unroll 1
      for (int i = 0; i < ne; ++i) grid_barrier(smem); }
#endif
    phase_sync<0>(smem); phase_sync<1>(smem); phase_sync<2>(smem); phase_sync<3>(smem); phase_sync<4>(smem); phase_sync<5>(smem);
    phase_sync<6>(smem); phase_sync<7>(smem); phase_sync<8>(smem); phase_sync<9>(smem); phase_sync<10>(smem); phase_sync<11>(smem);
    phase_sync<12>(smem); phase_sync<13>(smem); phase_sync<14>(smem); phase_sync<15>(smem); phase_sync<16>(smem); phase_sync<17>(smem);
    phase_sync<18>(smem); phase_sync<19>(smem); phase_sync<20>(smem); phase_sync<21>(smem); phase_sync<22>(smem);
}
#else
template <int PH> __global__ __launch_bounds__(512, 2) void k_ph(Params p) {
    extern __shared__ __attribute__((aligned(16))) unsigned char smem[];
    const Params q = load_params(); do_phase(q, PH, smem);
}
template <int PH> static void launch_ph(const Params& p, hipStream_t stream) {
    (void)hipFuncSetAttribute((const void*)k_ph<PH>, hipFuncAttributeMaxDynamicSharedMemorySize, (int)LDS_BYTES);
    k_ph<PH><<<256, 512, LDS_BYTES, stream>>>(p);
}
#endif

extern "C" void kernel_launch(void* const* d_in, const int* in_sizes, int n_in, void* d_out, int out_size, void* d_ws, size_t ws_size, hipStream_t stream) {
    Params p{};
    p.x_prompt = (const float*)d_in[0]; p.x_sample = (const float*)d_in[1]; p.rel_bias = (const float*)d_in[2]; p.norm_mix = (const float*)d_in[3]; p.w_in = (const float*)d_in[4];
    p.conv_a = (const float*)d_in[5]; p.a_log = (const float*)d_in[6]; p.dt_bias = (const float*)d_in[7]; p.head_norm = (const float*)d_in[8]; p.conv_b = (const float*)d_in[9];
    p.w_br_a = (const float*)d_in[10]; p.w_br_b = (const float*)d_in[11]; p.w_br_c = (const float*)d_in[12]; p.w_out = (const float*)d_in[13]; p.norm_mlp = (const float*)d_in[14];
    p.w_up = (const float*)d_in[15]; p.w_down = (const float*)d_in[16]; p.norm_final = (const float*)d_in[17]; p.out = (float*)d_out; p.ws = (unsigned char*)d_ws;
    if (ws_size < WS_NEED) { fprintf(stderr, "workspace too small: %zu < %zu\n", ws_size, (size_t)WS_NEED); return; }
#if MEGA
    static int grid_blocks = 0;
    if (!grid_blocks) { int dev = 0, cus = 0, per_cu = 0; (void)hipGetDevice(&dev); (void)hipDeviceGetAttribute(&cus, hipDeviceAttributeMultiprocessorCount, dev);
        (void)hipFuncSetAttribute((const void*)k_mega, hipFuncAttributeMaxDynamicSharedMemorySize, (int)LDS_BYTES);
        (void)hipOccupancyMaxActiveBlocksPerMultiprocessor(&per_cu, k_mega, 512, LDS_BYTES);
        if (per_cu < 1) per_cu = 1;
        grid_blocks = cus * per_cu; if (grid_blocks > 256) grid_blocks = 256; }
    void* args[] = {&p};
    hipError_t e = hipLaunchCooperativeKernel((const void*)k_mega, dim3(grid_blocks), dim3(512), args, LDS_BYTES, stream);
    if (e != hipSuccess) fprintf(stderr, "cooperative launch failed: %s (grid %d)\n", hipGetErrorString(e), grid_blocks);
#else
    launch_ph<0>(p, stream); launch_ph<1>(p, stream); launch_ph<2>(p, stream); launch_ph<3>(p, stream); launch_ph<4>(p, stream); launch_ph<5>(p, stream);
    launch_ph<6>(p, stream); launch_ph<7>(p, stream); launch_ph<8>(p, stream); launch_ph<9>(p, stream); launch_ph<10>(p, stream); launch_ph<11>(p, stream);
    launch_ph<12>(p, stream); launch_ph<13>(p, stream); launch_ph<14>(p, stream); launch_ph<15>(p, stream); launch_ph<16>(p, stream); launch_ph<17>(p, stream);
    launch_ph<18>(p, stream); launch_ph<19>(p, stream); launch_ph<20>(p, stream); launch_ph<21>(p, stream); launch_ph<22>(p, stream);
#endif
}
```

```cpp
#include <cstdio>
#define MEGA 1
#define DUP_MASK 0
#define SCAN_REP 1
#include <hip/hip_runtime.h>
namespace pg8 {
#define PG8_LAS __attribute__((address_space(3)))
typedef unsigned short bf16_t;
typedef short bf16x8 __attribute__((ext_vector_type(8)));
typedef float f32x4 __attribute__((ext_vector_type(4)));
typedef unsigned u32x4 __attribute__((ext_vector_type(4)));
constexpr int BM = 256, BK = 64, HALF = 128, HTB = HALF * BK * 2  , STAGE_BYTES = 8 * HTB, NXCD = 8, WGM = 8;

__host__ __device__ __forceinline__ int lds_byte(int r, int c) { const int st = (r >> 4) * 2 + (c >> 5), rr = r & 15, cc = c & 31, ob = rr * 64 + cc * 2; return st * 1024 + (ob ^ (((ob >> 9) & 1) << 5)); }
__host__ __device__ __forceinline__ void stage_rc(int b, int& R, int& C) { const int st = b / 1024, sb = b % 1024, swz = sb ^ (((sb >> 9) & 1) << 5); R = (st >> 1) * 16 + swz / 64; C = (st & 1) * 32 + (swz % 64) / 2; }
__host__ __device__ __forceinline__ int perm32(int rho) { const int n = rho >> 4, i = rho & 15; return 8 * (i >> 2) + 4 * n + (i & 3); }

struct Unit { int pm, pn; };
struct Gemm { const bf16_t* A; const bf16_t* Bt; int M, N, K; };
struct StaticOrder {
    int nM, nN, nwg, G, c;
    __host__ __device__ void init(int M, int N, int G_, int c_) { nM = M / BM; nN = N / BM; nwg = nM * nN; G = G_; c = c_; }
    __host__ __device__ bool next(int i, Unit& u) const {
        const long L = (long)i * G + c; if (L >= nwg) return false;
        int wgid = (int)L; { const int q = nwg / NXCD, r = nwg % NXCD, xcd = wgid % NXCD, off = wgid / NXCD; wgid = (xcd < r ? xcd * (q + 1) : r * (q + 1) + (xcd - r) * q) + off; }
        const int nig = WGM * nN, gid = wgid / nig, fm = gid * WGM, gsz = (nM - fm) < WGM ? (nM - fm) : WGM;
        u.pm = fm + ((wgid % nig) % gsz); u.pn = (wgid % nig) / gsz; return true;
    }
    __device__ __forceinline__ void a_ready(const Unit&) const {}
    __device__ __forceinline__ void done(const Unit&) const {}
};
__device__ __forceinline__ unsigned cvt_pk_bf16(float lo, float hi) { unsigned r; asm volatile("v_cvt_pk_bf16_f32 %0, %1, %2" : "=v"(r) : "v"(lo), "v"(hi)); return r; }

template <class Epi, class Sched, bool STAMP = false>
__device__ __forceinline__ void gemm_phase(PG8_LAS unsigned char* lds, const Gemm g, const Sched& S, const Epi& E, unsigned long long* stamps) {
    int tid_ = threadIdx.x; asm volatile("" : "+v"(tid_)); const int tid = tid_, wid = __builtin_amdgcn_readfirstlane(tid >> 6), lane = tid & 63, wr = wid >> 2, wc = wid & 3, fr = lane & 15, fq = lane >> 4;
    const int K = g.K, nt = K / BK;
    int ts_lo = 0, ts_hi = 0, nts = 0; const unsigned long long rt_entry = STAMP ? (unsigned long long)wall_clock64() : 0ull;
#define PG8_STAMP() do { if (STAMP && wid == 0 && nts < 64) { const unsigned long long _c = (unsigned long long)clock64(); \
        ts_lo = (lane == nts) ? (int)(unsigned)_c : ts_lo; ts_hi = (lane == nts) ? (int)(unsigned)(_c >> 32) : ts_hi; ++nts; } } while (0)
    PG8_STAMP();
    unsigned voffA[2], voffB[2];
#pragma unroll
    for (int i = 0; i < 2; ++i) { int R, C; stage_rc(tid * 16 + i * 8192, R, C); const int Rb = Epi::PERM ? ((R & ~31) + perm32(R & 31)) : R;
        voffA[i] = (unsigned)(R * K + C) * 2u; voffB[i] = (unsigned)(Rb * K + C) * 2u; }
    const size_t kstep = (size_t)(BK * 2);
    const size_t hstep = (size_t)HALF * K * 2;
    const size_t tstep = 2 * hstep;
    const unsigned ldsw = (unsigned)wid * 1024u;
    const int aoff = lds_byte(wr * 64 + fr, fq * 8), boff = lds_byte(wc * 32 + fr, fq * 8);
#define PG8_SA(b, h) (((b) * 2 + (h)) * HTB)
#define PG8_SB(b, h) ((4 + (b) * 2 + (h)) * HTB)
#define PG8_STAGE(bufoff, gbase, voff) do { _Pragma("unroll") for (int _i = 0; _i < 2; ++_i) \
        __builtin_amdgcn_global_load_lds((const unsigned*)((const char*)(gbase) + (voff)[_i]), (PG8_LAS unsigned*)(lds + (bufoff) + ldsw + _i * 8192), 16, 0, 0); } while (0)
#define PG8_LDA(dst, b, h) do { _Pragma("unroll") for (int m = 0; m < 4; ++m) _Pragma("unroll") for (int k = 0; k < 2; ++k) dst[m][k] = *(const PG8_LAS bf16x8*)(lds + PG8_SA(b, h) + aoff + m * 2048 + k * 1024); } while (0)
#define PG8_LDB(dst, b, h) do { _Pragma("unroll") for (int n = 0; n < 2; ++n) _Pragma("unroll") for (int k = 0; k < 2; ++k) dst[n][k] = *(const PG8_LAS bf16x8*)(lds + PG8_SB(b, h) + boff + n * 2048 + k * 1024); } while (0)
#define PG8_MMA(ai, bj, At, Bt) do { __builtin_amdgcn_s_setprio(1); _Pragma("unroll") for (int m = 0; m < 4; ++m) _Pragma("unroll") for (int n = 0; n < 2; ++n) _Pragma("unroll") for (int k = 0; k < 2; ++k) \
        acc[ai][bj][m][n] = __builtin_amdgcn_mfma_f32_16x16x32_bf16(Bt[n][k], At[m][k], acc[ai][bj][m][n], 0, 0, 0); __builtin_amdgcn_s_setprio(0); } while (0)
#define PG8_WAIT_V(n) asm volatile("s_waitcnt vmcnt(" #n ")" ::: "memory")
#define PG8_WAIT_L(n) asm volatile("s_waitcnt lgkmcnt(" #n ")" ::: "memory")
#define PG8_BAR __builtin_amdgcn_s_barrier()
#define PG8_SCHED __builtin_amdgcn_sched_barrier(0)
    Unit cur, nxt; int ui = 0;
    if (!S.next(0, cur)) return;
    f32x4 acc[2][2][4][2];
#pragma unroll
    for (int a = 0; a < 2; ++a)
#pragma unroll
        for (int b = 0; b < 2; ++b)
#pragma unroll
            for (int m = 0; m < 4; ++m)
#pragma unroll
                for (int n = 0; n < 2; ++n) acc[a][b][m][n] = (f32x4){0.f, 0.f, 0.f, 0.f};
    bf16x8 At[4][2], B0[2][2], B1[2][2];
    const char* cA = (const char*)g.A + (size_t)cur.pm * tstep; const char* cB = (const char*)g.Bt + (size_t)cur.pn * tstep;
    S.a_ready(cur);
    PG8_STAGE(PG8_SB(0, 0), cB, voffB); PG8_STAGE(PG8_SA(0, 0), cA, voffA); PG8_STAGE(PG8_SB(0, 1), cB + hstep, voffB); PG8_STAGE(PG8_SA(0, 1), cA + hstep, voffA);
    if (wr == 1) PG8_BAR;
    PG8_WAIT_V(4); PG8_BAR;
    PG8_STAGE(PG8_SB(1, 0), cB + kstep, voffB); PG8_STAGE(PG8_SA(1, 0), cA + kstep, voffA); PG8_STAGE(PG8_SB(1, 1), cB + hstep + kstep, voffB);
    PG8_WAIT_V(6); PG8_BAR;
    PG8_STAMP();
    for (;;) {
        const bool has_next = S.next(ui + 1, nxt);
        const char* nA = has_next ? (const char*)g.A + (size_t)nxt.pm * tstep : cA; const char* nB = has_next ? (const char*)g.Bt + (size_t)nxt.pn * tstep : cB;
        for (int t = 0; t < nt; t += 2) {
            const bool last = (t == nt - 2);
            const char* a1 = cA + (size_t)(t + 1) * kstep;
            const char* a2 = last ? nA : cA + (size_t)(t + 2) * kstep; const char* b2 = last ? nB : cB + (size_t)(t + 2) * kstep;
            const char* a3 = a2 + kstep; const char* b3 = b2 + kstep;
            if (last && has_next) S.a_ready(nxt);
            PG8_LDB(B0, 0, 0); PG8_SCHED; PG8_LDA(At, 0, 0); PG8_STAGE(PG8_SA(1, 1), a1 + hstep, voffA);
            PG8_WAIT_L(8); PG8_BAR; PG8_WAIT_L(0); PG8_MMA(0, 0, At, B0); PG8_BAR; PG8_SCHED;
            PG8_LDB(B1, 0, 1); PG8_STAGE(PG8_SB(0, 0), b2, voffB);
            PG8_BAR; PG8_WAIT_L(0); PG8_MMA(0, 1, At, B1); PG8_BAR;
            PG8_LDA(At, 0, 1); PG8_STAGE(PG8_SA(0, 0), a2, voffA);
            PG8_BAR; PG8_WAIT_L(0); PG8_MMA(1, 0, At, B0); PG8_BAR; PG8_SCHED;
            PG8_STAGE(PG8_SB(0, 1), b2 + hstep, voffB);
            PG8_WAIT_V(6); PG8_BAR; PG8_MMA(1, 1, At, B1); PG8_BAR;
            PG8_LDB(B0, 1, 0); PG8_SCHED; PG8_LDA(At, 1, 0); PG8_STAGE(PG8_SA(0, 1), a2 + hstep, voffA);
            PG8_WAIT_L(8); PG8_BAR; PG8_WAIT_L(0); PG8_MMA(0, 0, At, B0); PG8_BAR; PG8_SCHED;
            PG8_LDB(B1, 1, 1); PG8_STAGE(PG8_SB(1, 0), b3, voffB);
            PG8_BAR; PG8_WAIT_L(0); PG8_MMA(0, 1, At, B1); PG8_BAR;
            PG8_LDA(At, 1, 1); PG8_STAGE(PG8_SA(1, 0), a3, voffA);
            PG8_BAR; PG8_WAIT_L(0); PG8_MMA(1, 0, At, B0); PG8_BAR; PG8_SCHED;
            PG8_STAGE(PG8_SB(1, 1), b3 + hstep, voffB);
            PG8_WAIT_V(6); PG8_BAR; PG8_MMA(1, 1, At, B1); PG8_BAR;
        }
        PG8_STAMP();
        if constexpr (!Epi::AFTER_DRAIN) { E(acc, cur, wr, wc, fr, fq); S.done(cur); }
        PG8_STAMP();
        if (!has_next) break;
#pragma unroll
        for (int a = 0; a < 2; ++a)
#pragma unroll
            for (int b = 0; b < 2; ++b)
#pragma unroll
                for (int m = 0; m < 4; ++m)
#pragma unroll
                    for (int n = 0; n < 2; ++n) acc[a][b][m][n] = (f32x4){0.f, 0.f, 0.f, 0.f};
        cur = nxt; cA = nA; cB = nB; ++ui;
    }
    PG8_WAIT_V(0);
    if (wr == 0) PG8_BAR;
    PG8_BAR;
    if constexpr (Epi::AFTER_DRAIN) { E.fused(acc, cur, wr, wc, fr, fq, lds, wid, lane); S.done(cur); }
    PG8_STAMP();
    if (STAMP && wid == 0) { stamps[lane] = lane < nts ? (((unsigned long long)(unsigned)ts_hi << 32) | (unsigned)ts_lo) : 0ull;
        if (lane == 62) stamps[62] = rt_entry; if (lane == 63) stamps[63] = (unsigned long long)wall_clock64(); }
#undef PG8_STAMP
#undef PG8_SA
#undef PG8_SB
#undef PG8_STAGE
#undef PG8_LDA
#undef PG8_LDB
#undef PG8_MMA
#undef PG8_WAIT_V
#undef PG8_WAIT_L
#undef PG8_BAR
#undef PG8_SCHED
}
}

#define XB_TMO      128
#define XB_XCNT(j)  (256  + 64 * (j))
#define XB_XSUB(j)  (1280 + 64 * (j))
#define XB_XGEN(j)  (2304 + 64 * (j))
#define XB_TOP      3328
#define XB_TOPGEN   3392
#define XCD_BAR_WORDS 3456
#define XB_SPIN_CAP (1u << 18)
#define LAS __attribute__((address_space(3)))

__device__ __forceinline__ unsigned xb_ld(unsigned* p)              { return __hip_atomic_load(p, __ATOMIC_RELAXED, __HIP_MEMORY_SCOPE_AGENT); }
__device__ __forceinline__ unsigned xb_add(unsigned* p, unsigned v) { return __hip_atomic_fetch_add(p, v, __ATOMIC_RELAXED, __HIP_MEMORY_SCOPE_AGENT); }
__device__ __forceinline__ unsigned xb_xcc_id() { return (unsigned)__builtin_amdgcn_s_getreg((3 << 11) | 20) & 0xFu; }
#define XB_SPIN(cond, bar) do { unsigned _sp = 0; while (cond) { __builtin_amdgcn_s_sleep(1); \
    if ((++_sp & 255u) == 0u) { if (xb_ld(&(bar)[XB_TMO])) break; if (_sp > XB_SPIN_CAP) { atomicAdd(&(bar)[XB_TMO], 1u); break; } } } } while (0)

struct XcdBarrier {
    unsigned* bar; unsigned x;
    volatile LAS unsigned* st;
};

__device__ __forceinline__ XcdBarrier xcd_barrier_post(unsigned* bar, volatile LAS unsigned* st) {
    XcdBarrier b; b.bar = bar; b.x = xb_xcc_id(); b.st = st;
    if (threadIdx.x == 0) (void)xb_add(&bar[XB_XCNT(b.x)], 1u);
    return b;
}
__device__ __forceinline__ void xcd_barrier_complete(unsigned* bar, unsigned x, unsigned& nloc, unsigned& nx) {
    const unsigned G = gridDim.x * gridDim.y * gridDim.z;
    unsigned sum, cnt, mine, sp = 0u;
    for (;;) {
        sum = 0u; cnt = 0u; mine = 0u;
#pragma unroll
        for (unsigned j = 0; j < 16; ++j) { const unsigned c = xb_ld(&bar[XB_XCNT(j)]); sum += c; cnt += (c > 0u) ? 1u : 0u; mine = (j == x) ? c : mine; }
        if (sum == G) break;
        __builtin_amdgcn_s_sleep(1);
        if ((++sp & 255u) == 0u) { if (xb_ld(&bar[XB_TMO])) break; if (sp > XB_SPIN_CAP) { atomicAdd(&bar[XB_TMO], 1u); break; } }
    }
    nloc = mine > 0u ? mine : 1u; nx = cnt > 0u ? cnt : 1u;
}

__device__ __forceinline__ void xcd_barrier(const XcdBarrier& b) {
    asm volatile("s_waitcnt vmcnt(0)" ::: "memory");
    __syncthreads();
    if (threadIdx.x == 0) {
        unsigned* bar = b.bar;
        __builtin_amdgcn_s_waitcnt(0);
        unsigned nloc = b.st[0], nx = b.st[1];
        if (nloc == 0u) { xcd_barrier_complete(bar, b.x, nloc, nx); b.st[0] = nloc; b.st[1] = nx; }
        const unsigned old = xb_add(&bar[XB_XSUB(b.x)], 1u);
        const unsigned gen = old / nloc;
        if (old + 1u == (gen + 1u) * nloc) {
            __builtin_amdgcn_fence(__ATOMIC_RELEASE, "agent");
            asm volatile("s_waitcnt vmcnt(0)" ::: "memory");
            const unsigned og = xb_add(&bar[XB_TOP], 1u);
            const unsigned tg = og / nx;
            if (og + 1u == (tg + 1u) * nx) xb_add(&bar[XB_TOPGEN], 1u);
            else XB_SPIN(xb_ld(&bar[XB_TOPGEN]) == tg, bar);
            __builtin_amdgcn_fence(__ATOMIC_ACQUIRE, "agent");
            xb_add(&bar[XB_XGEN(b.x)], 1u);
            asm volatile("s_waitcnt vmcnt(0)" ::: "memory");
        } else {
            XB_SPIN(xb_ld(&bar[XB_XGEN(b.x)]) == gen, bar);
            __builtin_amdgcn_fence(__ATOMIC_ACQUIRE, "agent");
            asm volatile("s_waitcnt vmcnt(0)" ::: "memory");
        }
    }
    __syncthreads();
}

#include <hip/hip_cooperative_groups.h>
namespace cg = cooperative_groups;
using pg8::bf16_t; using pg8::bf16x8; using pg8::f32x4; using pg8::u32x4;
typedef unsigned u32x2 __attribute__((ext_vector_type(2)));
typedef unsigned long long u64_t;
#define SSQ_SCALE 16777216.0f
#define SSQ_INV (1.0f / 16777216.0f)

#ifndef MEGA
#define MEGA 1
#endif

constexpr int T_ = 16384, DM = 2048, NPROJ = 18176, DFF = 8192, VTLD = T_ + 256;
constexpr size_t LDS_BYTES = 139264 + 16;
constexpr size_t LDS_BAR_ST = 139264;

constexpr size_t SZ_WT_IN = (size_t)NPROJ * DM * 2, SZ_WT_UP = (size_t)DFF * DM * 2, SZ_WT_DOWN = SZ_WT_UP, SZ_WT_OUT = (size_t)DM * DM * 2,
                 SZ_WT_BRA = (size_t)DM * 1024 * 2, SZ_WT_BRC = (size_t)DM * 512 * 2;
constexpr size_t O_WT_IN = 0, O_WT_UP = O_WT_IN + SZ_WT_IN, O_WT_DOWN = O_WT_UP + SZ_WT_UP, O_WT_OUT = O_WT_DOWN + SZ_WT_DOWN, O_WT_BRA = O_WT_OUT + SZ_WT_OUT,
                 O_WT_BRB = O_WT_BRA + SZ_WT_BRA, O_WT_BRC = O_WT_BRB + SZ_WT_BRA, O_XN = O_WT_BRC + SZ_WT_BRC;
constexpr size_t O_VT = O_XN;
constexpr size_t O_AQKV = O_XN + (size_t)T_ * DM * 2;
constexpr size_t O_SB = O_AQKV + (size_t)T_ * 3072 * 2;
constexpr size_t O_OFWD = O_AQKV, O_OBWD = O_OFWD + (size_t)T_ * 1024 * 4, O_TINV = O_OBWD + (size_t)T_ * 1024 * 4, O_AIN = O_TINV + (size_t)4096 * 4096 * 2;
constexpr size_t O_MACC = O_OFWD;
constexpr size_t O_SZ = O_SB + (size_t)T_ * 3072 * 2;
constexpr size_t O_CQ = O_SZ + (size_t)T_ * 1024 * 2;
constexpr size_t O_CK = O_CQ + (size_t)T_ * 1536 * 2, O_CV = O_CK + (size_t)T_ * 1536 * 2;
constexpr size_t O_GATES = O_CV + (size_t)T_ * 1536 * 2;
constexpr size_t O_HID = O_CQ;
constexpr size_t O_AB = O_GATES + (size_t)T_ * 6144 * 2;
constexpr size_t O_QKV = O_AB + (size_t)T_ * 32 * 4;
constexpr size_t O_KT = O_QKV + (size_t)T_ * 3072 * 2;
constexpr size_t O_G = O_KT + (size_t)T_ * 1024 * 2;
constexpr size_t O_BETA = O_G + (size_t)T_ * 16 * 4;
constexpr size_t O_YA = O_BETA + (size_t)T_ * 16 * 4;
constexpr size_t O_YB = O_YA + (size_t)T_ * 1024 * 2;
constexpr size_t O_YC = O_YB + (size_t)T_ * 1024 * 2;
constexpr size_t O_GCP = O_YC + (size_t)T_ * 512 * 2;
constexpr size_t O_OG = O_GCP + (size_t)4096 * 64 * 4;
constexpr size_t O_LSE = O_OG + (size_t)3 * T_ * 512 * 2;
constexpr size_t O_BAR = O_LSE + (size_t)3 * T_ * 4 * 4;
constexpr size_t O_QCTR = O_BAR + (size_t)XCD_BAR_WORDS * 4;
constexpr size_t O_SSQ = O_QCTR + 512;
constexpr size_t O_WT_UP1 = O_SSQ + (size_t)5 * T_ * 8, O_WT_DOWN1 = O_WT_UP1 + SZ_WT_UP;
constexpr size_t WS_NEED = O_WT_DOWN1 + SZ_WT_DOWN;
constexpr size_t O_HB2 = O_AQKV;
static_assert((size_t)3 * 512 * VTLD * 2 <= (size_t)T_ * DM * 2, "vT alias");
static_assert(O_AIN + (size_t)4096 * 4096 * 2 <= O_SZ, "alias AQKV|SB");
static_assert(O_HID + (size_t)T_ * DFF * 2 <= O_AB, "alias hidden");
static_assert(WS_NEED < (size_t)1176000000, "workspace");

struct Params {
    const float* x_prompt; const float* x_sample; const float* rel_bias; const float* norm_mix; const float* w_in; const float* conv_a; const float* a_log; const float* dt_bias;
    const float* head_norm; const float* conv_b; const float* w_br_a; const float* w_br_b; const float* w_br_c; const float* w_out; const float* norm_mlp; const float* w_up;
    const float* w_down; const float* norm_final; float* out; unsigned char* ws;
};

__device__ __forceinline__ float bf2f(unsigned short b) { return __uint_as_float(((unsigned)b) << 16); }
__device__ __forceinline__ float bflo(unsigned u) { return __uint_as_float(u << 16); }
__device__ __forceinline__ float bfhi(unsigned u) { return __uint_as_float(u & 0xffff0000u); }
__device__ __forceinline__ unsigned pk2(float lo, float hi) { return pg8::cvt_pk_bf16(lo, hi); }
__device__ __forceinline__ unsigned short f2bf(float f) { return (unsigned short)(pk2(f, 0.f) & 0xffffu); }
__device__ __forceinline__ float sigmoidf_(float x) { return __builtin_amdgcn_rcpf(1.0f + __expf(-x)); }
__device__ __forceinline__ float siluf_(float x) { return x * __builtin_amdgcn_rcpf(1.0f + __expf(-x)); }
__device__ __forceinline__ void seq_of(int t, int& s0, int& L) { if (t < 8192) { s0 = t & ~4095; L = 4096; } else { s0 = t & ~2047; L = 2048; } }
__device__ __forceinline__ bf16x8 mk8(u32x2 a, u32x2 b) { u32x4 w; w.x = a.x; w.y = a.y; w.z = b.x; w.w = b.y; return __builtin_bit_cast(bf16x8, w); }
__device__ __forceinline__ bf16x8 pack8(f32x4 a, f32x4 b) { u32x4 w; w.x = pk2(a[0], a[1]); w.y = pk2(a[2], a[3]); w.z = pk2(b[0], b[1]); w.w = pk2(b[2], b[3]); return __builtin_bit_cast(bf16x8, w); }
__device__ __forceinline__ int tid_l() { int t = threadIdx.x; asm volatile("" : "+v"(t)); return t; }
__device__ __forceinline__ int bid_l() { int b = blockIdx.x; asm volatile("" : "+s"(b)); return b; }
#define MFMA16(a, b, c) __builtin_amdgcn_mfma_f32_16x16x32_bf16((a), (b), (c), 0, 0, 0)
#define LDS_WAIT() asm volatile("s_waitcnt lgkmcnt(0)" ::: "memory")

__device__ void conv_tiles(const float* __restrict__ W, int K, int ldn, int ntn, bf16_t* __restrict__ Wt, int mode, const float* __restrict__ kscale) {
    const int nkt = K >> 5, total = ntn * nkt, tid = tid_l(), lane = tid & 63;
    for (int it = bid_l() * 8 + (tid >> 6); it < total; it += gridDim.x * 8) {
        const int tn = it / nkt, tk = it - tn * nkt, n0 = tn * 64, k0 = tk * 32;
        int src0 = n0, nvalid = 64;
        if (mode == 1) { if (n0 >= 17920) { src0 = 4096; nvalid = 32; } else if (n0 >= 4096) src0 = n0 + 32; }
        if (lane < nvalid) {
            const float* src = W + (size_t)k0 * ldn + src0 + lane;
            float v[32];
#pragma unroll
            for (int j = 0; j < 32; ++j) v[j] = src[(size_t)j * ldn];
            if (kscale) {
#pragma unroll
                for (int j = 0; j < 32; ++j) v[j] *= kscale[k0 + j]; }
            bf16_t* dst = Wt + (size_t)(n0 + lane) * K + k0;
#pragma unroll
            for (int q = 0; q < 4; ++q) { u32x4 w; w.x = pk2(v[8 * q], v[8 * q + 1]); w.y = pk2(v[8 * q + 2], v[8 * q + 3]); w.z = pk2(v[8 * q + 4], v[8 * q + 5]); w.w = pk2(v[8 * q + 6], v[8 * q + 7]);
                *(u32x4*)(dst + 8 * q) = w; }
        }
    }
}

__device__ void conv_queue(const float* __restrict__ W, int K, int ldn, int ntn, bf16_t* __restrict__ Wt, const float* __restrict__ kscale, unsigned* qctr, unsigned char* smem) {
    const int nkt = K >> 5, total = ntn * nkt, nbatch = (total + 63) >> 6, tid = tid_l(), lane = tid & 63, wid = tid >> 6;
    volatile LAS unsigned* slot = (volatile LAS unsigned*)(smem + LDS_BAR_ST) + 2;
    for (;;) {
        __syncthreads();
        if (tid == 0) *slot = __hip_atomic_fetch_add(qctr, 1u, __ATOMIC_RELAXED, __HIP_MEMORY_SCOPE_AGENT);
        __syncthreads();
        const int bi = (int)*slot;
        if (bi >= nbatch) break;
#pragma unroll 1
        for (int sub = 0; sub < 8; ++sub) {
            const int it = bi * 64 + sub * 8 + wid; if (it >= total) break;
            const int tn = it / nkt, tk = it - tn * nkt, n0 = tn * 64, k0 = tk * 32;
            const float* src = W + (size_t)k0 * ldn + n0 + lane;
            float v[32];
#pragma unroll
            for (int j = 0; j < 32; ++j) v[j] = src[(size_t)j * ldn];
            if (kscale) {
#pragma unroll
                for (int j = 0; j < 32; ++j) v[j] *= kscale[k0 + j]; }
            bf16_t* dst = Wt + (size_t)(n0 + lane) * K + k0;
#pragma unroll
            for (int q = 0; q < 4; ++q) { u32x4 w; w.x = pk2(v[8 * q], v[8 * q + 1]); w.y = pk2(v[8 * q + 2], v[8 * q + 3]); w.z = pk2(v[8 * q + 4], v[8 * q + 5]); w.w = pk2(v[8 * q + 6], v[8 * q + 7]);
                *(u32x4*)(dst + 8 * q) = w; }
        }
    }
}

__device__ void norm_rows(const Params& p, int mode, const float* __restrict__ w, bf16_t* __restrict__ hb) {
    const int tid = tid_l(), lane = tid & 63, gw = bid_l() * 8 + (tid >> 6), nw = gridDim.x * 8;
    u64_t* ssq = (u64_t*)(p.ws + O_SSQ);
    for (int t = gw; t < T_; t += nw) {
        float4 v[8];
        if (mode == 0) { const float* src = (t < 8192 ? p.x_prompt + (size_t)t * DM : p.x_sample + (size_t)(t - 8192) * DM);
#pragma unroll
            for (int i = 0; i < 8; ++i) v[i] = *(const float4*)(src + i * 256 + lane * 4);
        } else { const bf16_t* hsrc = (const bf16_t*)(p.ws + O_XN) + (size_t)t * DM;
#pragma unroll
            for (int i = 0; i < 8; ++i) { const u32x2 w = *(const u32x2*)(hsrc + i * 256 + lane * 4); v[i] = make_float4(bflo(w.x), bfhi(w.x), bflo(w.y), bfhi(w.y)); } }
        if (mode == 0) {
            float ss = 0.f;
#pragma unroll
            for (int i = 0; i < 8; ++i) ss += v[i].x * v[i].x + v[i].y * v[i].y + v[i].z * v[i].z + v[i].w * v[i].w;
#pragma unroll
            for (int off = 32; off > 0; off >>= 1) ss += __shfl_xor(ss, off);
            if (lane < 5) ssq[(size_t)lane * T_ + t] = (lane == 0) ? (u64_t)(ss * SSQ_SCALE) : 0ull;
#pragma unroll
            for (int i = 0; i < 8; ++i) { u32x2 o; o.x = pk2(v[i].x, v[i].y); o.y = pk2(v[i].z, v[i].w); *(u32x2*)(hb + (size_t)t * DM + i * 256 + lane * 4) = o;
 }
        } else {
            const float rstd = rsqrtf((float)ssq[(size_t)4 * T_ + t] * SSQ_INV * (1.0f / DM) + 1e-6f);
#pragma unroll
            for (int i = 0; i < 8; ++i) { const float4 wv = *(const float4*)(w + i * 256 + lane * 4);
                *(float4*)(p.out + (size_t)t * DM + i * 256 + lane * 4) = make_float4(v[i].x * rstd * wv.x, v[i].y * rstd * wv.y, v[i].z * rstd * wv.z, v[i].w * rstd * wv.w); }
        }
    }
}

struct EpiProj {
    static constexpr bool PERM = true, AFTER_DRAIN = false;
    unsigned char* ws; const u64_t* ssq;
    __device__ __forceinline__ void operator()(const f32x4 (&acc)[2][2][4][2], const pg8::Unit& u, int wr, int wc, int fr, int fq) const {
        const int pn = u.pn, row0 = u.pm * 256 + wr * 64 + fr;
        float rs[2][4];
#pragma unroll
        for (int ai = 0; ai < 2; ++ai)
#pragma unroll
            for (int m = 0; m < 4; ++m) rs[ai][m] = rsqrtf((float)ssq[row0 + ai * 128 + m * 16] * SSQ_INV * (1.0f / DM) + 1e-6f);
        if (pn == 70) {
            if (wc == 0) { float* ab = (float*)(ws + O_AB);
#pragma unroll
                for (int ai = 0; ai < 2; ++ai)
#pragma unroll
                    for (int m = 0; m < 4; ++m) { float* rp = ab + (size_t)(row0 + ai * 128 + m * 16) * 32 + 8 * fq; *(f32x4*)rp = acc[ai][0][m][0] * rs[ai][m]; *(f32x4*)(rp + 4) = acc[ai][0][m][1] * rs[ai][m]; } }
            return;
        }
        bf16_t* base; int ldc, colt;
        if (pn < 12) { base = (bf16_t*)(ws + O_AQKV); ldc = 3072; colt = pn * 256; }
        else if (pn < 16) { base = (bf16_t*)(ws + O_SZ); ldc = 1024; colt = (pn - 12) * 256; }
        else if (pn < 28) { base = (bf16_t*)(ws + O_SB); ldc = 3072; colt = (pn - 16) * 256; }
        else if (pn < 46) { const int s = (pn - 28) / 6; base = (bf16_t*)(ws + O_CQ) + (size_t)s * T_ * 1536; ldc = 1536; colt = ((pn - 28) - s * 6) * 256; }
        else { base = (bf16_t*)(ws + O_GATES); ldc = 6144; colt = (pn - 46) * 256; }
        const int col0 = colt + wc * 32 + 8 * fq;
#pragma unroll
        for (int ai = 0; ai < 2; ++ai)
#pragma unroll
            for (int m = 0; m < 4; ++m) { bf16_t* rowp = base + (size_t)(row0 + ai * 128 + m * 16) * ldc + col0;
#pragma unroll
                for (int bj = 0; bj < 2; ++bj) { const f32x4 v0 = acc[ai][bj][m][0] * rs[ai][m], v1 = acc[ai][bj][m][1] * rs[ai][m];
                    u32x4 w; w.x = pk2(v0[0], v0[1]); w.y = pk2(v0[2], v0[3]); w.z = pk2(v1[0], v1[1]); w.w = pk2(v1[2], v1[3]);
                    *(u32x4*)(rowp + bj * 128) = w; } }
    }
};
struct EpiUp {
    static constexpr bool PERM = true, AFTER_DRAIN = false;
    bf16_t* O; const u64_t* ssq;
    __device__ __forceinline__ void operator()(const f32x4 (&acc)[2][2][4][2], const pg8::Unit& u, int wr, int wc, int fr, int fq) const {
        const int row0 = u.pm * 256 + wr * 64 + fr, col0 = u.pn * 256 + wc * 32 + 8 * fq;
        float rs[2][4];
#pragma unroll
        for (int ai = 0; ai < 2; ++ai)
#pragma unroll
            for (int m = 0; m < 4; ++m) rs[ai][m] = rsqrtf((float)ssq[row0 + ai * 128 + m * 16] * SSQ_INV * (1.0f / DM) + 1e-6f);
#pragma unroll
        for (int ai = 0; ai < 2; ++ai)
#pragma unroll
            for (int m = 0; m < 4; ++m) { bf16_t* rowp = O + (size_t)(row0 + ai * 128 + m * 16) * DFF + col0;
#pragma unroll
                for (int bj = 0; bj < 2; ++bj) { f32x4 v0 = acc[ai][bj][m][0], v1 = acc[ai][bj][m][1];
#pragma unroll
                    for (int j = 0; j < 4; ++j) { const float a = fmaxf(v0[j] * rs[ai][m], 0.f), b = fmaxf(v1[j] * rs[ai][m], 0.f); v0[j] = a * a; v1[j] = b * b; }
                    u32x4 w; w.x = pk2(v0[0], v0[1]); w.y = pk2(v0[2], v0[3]); w.z = pk2(v1[0], v1[1]); w.w = pk2(v1[2], v1[3]);
                    *(u32x4*)(rowp + bj * 128) = w; } }
    }
};
struct EpiResid {
    static constexpr bool PERM = true, AFTER_DRAIN = false;
    const float* xp; const float* xs; const bf16_t* hin; bf16_t* hout; u64_t* ssq;
    __device__ __forceinline__ void operator()(const f32x4 (&acc)[2][2][4][2], const pg8::Unit& u, int wr, int wc, int fr, int fq) const {
        const int row0 = u.pm * 256 + wr * 64 + fr, col0 = u.pn * 256 + wc * 32 + 8 * fq;
        const float* src = xp ? (u.pm < 32 ? xp : xs - (size_t)8192 * DM) : nullptr;
#pragma unroll
        for (int ai = 0; ai < 2; ++ai) {
            f32x4 old[4][2][2];
            if (src) {
#pragma unroll
                for (int m = 0; m < 4; ++m)
#pragma unroll
                    for (int bj = 0; bj < 2; ++bj)
#pragma unroll
                        for (int n = 0; n < 2; ++n) old[m][bj][n] = *(const f32x4*)(src + (size_t)(row0 + ai * 128 + m * 16) * DM + col0 + bj * 128 + n * 4);
            } else {
                u32x4 ob[4][2];
#pragma unroll
                for (int m = 0; m < 4; ++m)
#pragma unroll
                    for (int bj = 0; bj < 2; ++bj) ob[m][bj] = *(const u32x4*)(hin + (size_t)(row0 + ai * 128 + m * 16) * DM + col0 + bj * 128);
#pragma unroll
                for (int m = 0; m < 4; ++m)
#pragma unroll
                    for (int bj = 0; bj < 2; ++bj) { const u32x4 w = ob[m][bj];
                        old[m][bj][0] = (f32x4){bflo(w.x), bfhi(w.x), bflo(w.y), bfhi(w.y)}; old[m][bj][1] = (f32x4){bflo(w.z), bfhi(w.z), bflo(w.w), bfhi(w.w)}; }
            }
            asm volatile("" ::: "memory");
#pragma unroll
            for (int m = 0; m < 4; ++m) { const size_t row = (size_t)(row0 + ai * 128 + m * 16); bf16_t* hrow = hout + row * DM + col0; float part = 0.f;
#pragma unroll
                for (int bj = 0; bj < 2; ++bj) { const f32x4 v0 = old[m][bj][0] + acc[ai][bj][m][0], v1 = old[m][bj][1] + acc[ai][bj][m][1];
                    u32x4 o; o.x = pk2(v0[0], v0[1]); o.y = pk2(v0[2], v0[3]); o.z = pk2(v1[0], v1[1]); o.w = pk2(v1[2], v1[3]); *(u32x4*)(hrow + bj * 128) = o;
                    part += v0[0] * v0[0] + v0[1] * v0[1] + v0[2] * v0[2] + v0[3] * v0[3] + v1[0] * v1[0] + v1[1] * v1[1] + v1[2] * v1[2] + v1[3] * v1[3]; }
                part += __shfl_xor(part, 16); part += __shfl_xor(part, 32);
                if (fq == 0) (void)__hip_atomic_fetch_add(ssq + row, (u64_t)(part * SSQ_SCALE), __ATOMIC_RELAXED, __HIP_MEMORY_SCOPE_AGENT); }
        }
    }
};
struct EpiBranch {
    static constexpr bool PERM = true, AFTER_DRAIN = false;
    bf16_t* merged; const bf16_t* gates; int goff, mode;
    __device__ __forceinline__ void operator()(const f32x4 (&acc)[2][2][4][2], const pg8::Unit& u, int wr, int wc, int fr, int fq) const {
        const int row0 = u.pm * 256 + wr * 64 + fr, col0 = u.pn * 256 + wc * 32 + 8 * fq;
#pragma unroll
        for (int ai = 0; ai < 2; ++ai) {
            u32x4 gw[4][2], old[4][2];
#pragma unroll
            for (int m = 0; m < 4; ++m)
#pragma unroll
                for (int bj = 0; bj < 2; ++bj) { const size_t row = (size_t)(row0 + ai * 128 + m * 16); const int col = col0 + bj * 128;
                    gw[m][bj] = *(const u32x4*)(gates + row * 6144 + goff + col);
                    old[m][bj] = (mode != 0) ? *(const u32x4*)(merged + row * DM + col) : (u32x4){0u, 0u, 0u, 0u}; }
            asm volatile("" ::: "memory");
#pragma unroll
            for (int m = 0; m < 4; ++m)
#pragma unroll
                for (int bj = 0; bj < 2; ++bj) { const size_t row = (size_t)(row0 + ai * 128 + m * 16); const int col = col0 + bj * 128;
                    const u32x4 g = gw[m][bj], od = old[m][bj];
                    const f32x4 v0 = acc[ai][bj][m][0], v1 = acc[ai][bj][m][1];
                    u32x4 o;
                    o.x = pk2(v0[0] * sigmoidf_(bflo(g.x)) + bflo(od.x), v0[1] * sigmoidf_(bfhi(g.x)) + bfhi(od.x));
                    o.y = pk2(v0[2] * sigmoidf_(bflo(g.y)) + bflo(od.y), v0[3] * sigmoidf_(bfhi(g.y)) + bfhi(od.y));
                    o.z = pk2(v1[0] * sigmoidf_(bflo(g.z)) + bflo(od.z), v1[1] * sigmoidf_(bfhi(g.z)) + bfhi(od.z));
                    o.w = pk2(v1[2] * sigmoidf_(bflo(g.w)) + bflo(od.w), v1[3] * sigmoidf_(bfhi(g.w)) + bfhi(od.w));
                    *(u32x4*)(merged + row * DM + col) = o; }
        }
    }
};

template <class Epi> __device__ __forceinline__ void run_gemm(unsigned char* smem, const bf16_t* A, const bf16_t* Bt, int M, int N, int K, const Epi& E) {
    pg8::Gemm g; g.A = A; g.Bt = Bt; g.M = M; g.N = N; g.K = K;
    pg8::StaticOrder S; S.init(M, N, (int)gridDim.x, bid_l());
    pg8::gemm_phase<Epi, pg8::StaticOrder, false>((PG8_LAS unsigned char*)smem, g, S, E, nullptr);
}

__device__ void prep_phase(const Params& p, int L, unsigned char* smem) {
    const int tid = tid_l(), wid = tid >> 6, lane = tid & 63, gw = bid_l() * 8 + wid, nw = gridDim.x * 8;
    unsigned char* ws = p.ws;
    const bf16_t* AQ = (const bf16_t*)(ws + O_AQKV); const bf16_t* SB = (const bf16_t*)(ws + O_SB);
    bf16_t* QKV = (bf16_t*)(ws + O_QKV); bf16_t* KT = (bf16_t*)(ws + O_KT); bf16_t* YB = (bf16_t*)(ws + O_YB);
    const float* ca = p.conv_a + (size_t)L * 3 * 3072; const float* cb = p.conv_b + (size_t)L * 3 * 1024;
    for (int it = gw; it < 16384; it += nw) {
        const int h = it & 7, oct = it >> 3, tw = oct * 8, ch = tw >> 6, cloc = tw & 63;
        int s0, Ls; seq_of(tw, s0, Ls);
        const bool v0 = tw - 1 >= s0, v9 = tw + 8 < s0 + Ls;
        float qv[3][8][2];
#pragma unroll
        for (int part = 0; part < 3; ++part) {
            const int col = part * 1024 + h * 128 + 2 * lane;
            const float2 w0 = *(const float2*)(ca + col), w1 = *(const float2*)(ca + 3072 + col), w2 = *(const float2*)(ca + 6144 + col);
            unsigned x[10];
#pragma unroll
            for (int j = 0; j < 10; ++j) { const bool ok = (j == 0) ? v0 : ((j == 9) ? v9 : true); x[j] = ok ? *(const unsigned*)(AQ + (size_t)(tw - 1 + j) * 3072 + col) : 0u; }
#pragma unroll
            for (int i = 0; i < 8; ++i) {
                qv[part][i][0] = siluf_(w0.x * bflo(x[i]) + w1.x * bflo(x[i + 1]) + w2.x * bflo(x[i + 2]));
                qv[part][i][1] = siluf_(w0.y * bfhi(x[i]) + w1.y * bfhi(x[i + 1]) + w2.y * bfhi(x[i + 2])); }
        }
        const int cbn = h * 128 + 2 * lane;
        unsigned sc[10], sh[10], sg[8];
#pragma unroll
        for (int j = 0; j < 10; ++j) { const bool ok = (j == 0) ? v0 : ((j == 9) ? v9 : true);
            const bf16_t* rp = SB + (size_t)(tw - 1 + j) * 3072 + cbn;
            sc[j] = ok ? *(const unsigned*)(rp + 1024) : 0u; sh[j] = ok ? *(const unsigned*)(rp + 2048) : 0u; }
#pragma unroll
        for (int i = 0; i < 8; ++i) sg[i] = *(const unsigned*)(SB + (size_t)(tw + i) * 3072 + cbn);
        float sq[8], sk[8];
#pragma unroll
        for (int i = 0; i < 8; ++i) { sq[i] = qv[0][i][0] * qv[0][i][0] + qv[0][i][1] * qv[0][i][1]; sk[i] = qv[1][i][0] * qv[1][i][0] + qv[1][i][1] * qv[1][i][1]; }
#pragma unroll
        for (int off = 32; off > 0; off >>= 1)
#pragma unroll
            for (int i = 0; i < 8; ++i) { sq[i] += __shfl_xor(sq[i], off); sk[i] += __shfl_xor(sk[i], off); }
        unsigned klo[8], khi[8];
#pragma unroll
        for (int i = 0; i < 8; ++i) {
            const int t = tw + i;
            const float rq = rsqrtf(sq[i] + 1e-6f) * 0.08838834764831845f, rk = rsqrtf(sk[i] + 1e-6f);
            const unsigned qo = pk2(qv[0][i][0] * rq, qv[0][i][1] * rq), ko = pk2(qv[1][i][0] * rk, qv[1][i][1] * rk), vo = pk2(qv[2][i][0], qv[2][i][1]);
            bf16_t* orow = QKV + (size_t)t * 3072 + h * 128 + 2 * lane;
            *(unsigned*)(orow) = qo; *(unsigned*)(orow + 1024) = ko; *(unsigned*)(orow + 2048) = vo;
            klo[i] = ko & 0xffffu; khi[i] = ko >> 16; }
        { u32x4 a, b; a.x = klo[0] | (klo[1] << 16); a.y = klo[2] | (klo[3] << 16); a.z = klo[4] | (klo[5] << 16); a.w = klo[6] | (klo[7] << 16);
          b.x = khi[0] | (khi[1] << 16); b.y = khi[2] | (khi[3] << 16); b.z = khi[4] | (khi[5] << 16); b.w = khi[6] | (khi[7] << 16);
          bf16_t* dst = KT + ((size_t)(ch * 8 + h) * 128 + 2 * lane) * 64 + cloc;
          *(u32x4*)dst = a; *(u32x4*)(dst + 64) = b; }
        { const float2 w0 = *(const float2*)(cb + cbn), w1 = *(const float2*)(cb + 1024 + cbn), w2 = *(const float2*)(cb + 2048 + cbn);
          float u[10][2];
#pragma unroll
          for (int j = 0; j < 10; ++j) { u[j][0] = bflo(sc[j]) * bflo(sh[j]); u[j][1] = bfhi(sc[j]) * bfhi(sh[j]); }
#pragma unroll
          for (int i = 0; i < 8; ++i) {
              const float ya = bflo(sg[i]) * (w0.x * u[i][0] + w1.x * u[i + 1][0] + w2.x * u[i + 2][0]);
              const float yb = bfhi(sg[i]) * (w0.y * u[i][1] + w1.y * u[i + 1][1] + w2.y * u[i + 2][1]);
              *(unsigned*)(YB + (size_t)(tw + i) * 1024 + cbn) = pk2(ya, yb); } }
        if (h == 0 && lane < 8) {
            const float* AB = (const float*)(ws + O_AB); float* G = (float*)(ws + O_G); float* BT = (float*)(ws + O_BETA); const int tok = tw + lane;
#pragma unroll
            for (int q4 = 0; q4 < 4; ++q4) { const f32x4 a4 = *(const f32x4*)(AB + (size_t)tok * 32 + q4 * 4), b4 = *(const f32x4*)(AB + (size_t)tok * 32 + 16 + q4 * 4); f32x4 go, bo;
#pragma unroll
                for (int j = 0; j < 4; ++j) { const int dh = q4 * 4 + j; const float a = a4[j] + p.dt_bias[L * 16 + dh];
                    const float sp = fmaxf(a, 0.f) + log1pf(__expf(-fabsf(a)));
                    go[j] = -__expf(p.a_log[L * 16 + dh]) * sp; bo[j] = sigmoidf_(b4[j]); }
                *(f32x4*)(G + (size_t)tok * 16 + q4 * 4) = go; *(f32x4*)(BT + (size_t)tok * 16 + q4 * 4) = bo; }
        }
    }
    const bf16_t* CV = (const bf16_t*)(ws + O_CV); bf16_t* VT = (bf16_t*)(ws + O_VT);
    for (int it = gw; it < 6144; it += nw) {
        const int hc = it % 12, hf = it / 12, g = hc >> 2, hq = hc & 3, t0 = hf * 32, dsh = g * 2, D = 1 << dsh;
        int s0, Ls; seq_of(t0, s0, Ls); const int l = Ls >> dsh;
        unsigned xv[32];
#pragma unroll
        for (int j = 0; j < 32; ++j) xv[j] = *(const unsigned*)(CV + (size_t)(t0 + j) * 1536 + hc * 128 + 2 * lane);
        bf16_t* vrow = VT + (size_t)g * 512 * VTLD + (size_t)(hq * 128 + 2 * lane) * VTLD + 128;
        if (g == 0) {
#pragma unroll
            for (int u = 0; u < 8; ++u) { const int col = t0 + 4 * u; u32x2 lo, hi;
                lo.x = (xv[4 * u] & 0xffffu) | (xv[4 * u + 1] << 16); lo.y = (xv[4 * u + 2] & 0xffffu) | (xv[4 * u + 3] << 16);
                hi.x = (xv[4 * u] >> 16) | (xv[4 * u + 1] & 0xffff0000u); hi.y = (xv[4 * u + 2] >> 16) | (xv[4 * u + 3] & 0xffff0000u);
                *(u32x2*)(vrow + col) = lo; *(u32x2*)(vrow + VTLD + col) = hi; }
        } else if (g == 1) {
#pragma unroll
            for (int r = 0; r < 4; ++r)
#pragma unroll
                for (int m0 = 0; m0 < 8; m0 += 4) { const int col = s0 + r * l + ((t0 - s0) >> 2) + m0; u32x2 lo, hi;
                    const unsigned e0 = xv[(m0 + 0) * 4 + r], e1 = xv[(m0 + 1) * 4 + r], e2 = xv[(m0 + 2) * 4 + r], e3 = xv[(m0 + 3) * 4 + r];
                    lo.x = (e0 & 0xffffu) | (e1 << 16); lo.y = (e2 & 0xffffu) | (e3 << 16); hi.x = (e0 >> 16) | (e1 & 0xffff0000u); hi.y = (e2 >> 16) | (e3 & 0xffff0000u);
                    *(u32x2*)(vrow + col) = lo; *(u32x2*)(vrow + VTLD + col) = hi; }
        } else {
#pragma unroll
            for (int r = 0; r < 16; ++r) { const int col = s0 + r * l + ((t0 - s0) >> 4);
                const unsigned e0 = xv[r], e1 = xv[16 + r];
                *(unsigned*)(vrow + col) = (e0 & 0xffffu) | (e1 << 16); *(unsigned*)(vrow + VTLD + col) = (e0 >> 16) | (e1 & 0xffff0000u); }
        }
        if (hf == 0) {
            bf16_t* rowp = VT + (size_t)g * 512 * VTLD + (size_t)(hq * 128) * VTLD; const u32x4 z = {0u, 0u, 0u, 0u};
            for (int q = lane; q < 128 * 32; q += 64) { const int d = q >> 5, piece = q & 31; const int coff = piece < 16 ? piece * 8 : 128 + T_ + (piece - 16) * 8;
                *(u32x4*)(rowp + (size_t)d * VTLD + coff) = z; }
        }
    }
}

__device__ void gdn_local(const Params& p, unsigned char* smem) {
    const int tid = tid_l(), wid = tid >> 6, lane = tid & 63, fr = lane & 15, fq = lane >> 4;
    unsigned char* ws = p.ws;
    float* Lm = (float*)(smem + wid * 16384);
    float* gcs = (float*)(smem + 131072 + wid * 512); float* bts = gcs + 64;
    const float* G = (const float*)(ws + O_G); const float* BT = (const float*)(ws + O_BETA); const bf16_t* QKV = (const bf16_t*)(ws + O_QKV);
    float* GCP = (float*)(ws + O_GCP); bf16_t* TG = (bf16_t*)(ws + O_TINV); bf16_t* AG = (bf16_t*)(ws + O_AIN);
    for (int item = bid_l() * 8 + wid; item < 4096; item += gridDim.x * 8) {
        const int dir = item & 1, h = (item >> 1) & 7, ch = item >> 4, t0 = ch * 64;
        const int pl = dir ? 63 - lane : lane;
        float gc = G[(size_t)(t0 + pl) * 16 + dir * 8 + h];
        const float bt = BT[(size_t)(t0 + pl) * 16 + dir * 8 + h];
#pragma unroll
        for (int off = 1; off < 64; off <<= 1) { const float v = __shfl_up(gc, off); if (lane >= off) gc += v; }
        LDS_WAIT();
        gcs[lane] = gc; bts[lane] = bt;
        GCP[(size_t)item * 64 + pl] = gc;
        LDS_WAIT();
        {
            bf16x8 kf[4][4];
#pragma unroll
            for (int mt = 0; mt < 4; ++mt) { const int a = mt * 16 + fr, pp = dir ? 63 - a : a;
#pragma unroll
                for (int kb = 0; kb < 4; ++kb) kf[mt][kb] = *(const bf16x8*)(QKV + (size_t)(t0 + pp) * 3072 + 1024 + h * 128 + kb * 32 + fq * 8); }
#pragma unroll
            for (int mt = 0; mt < 4; ++mt)
#pragma unroll
                for (int nt = 0; nt <= mt; ++nt) { f32x4 acc = {0.f, 0.f, 0.f, 0.f};
#pragma unroll
                    for (int kb = 0; kb < 4; ++kb) acc = MFMA16(kf[mt][kb], kf[nt][kb], acc);
                    const int b = nt * 16 + fr; const float gb = gcs[b];
#pragma unroll
                    for (int j = 0; j < 4; ++j) { const int a = mt * 16 + fq * 4 + j;
                        Lm[a * 64 + b] = (a > b) ? acc[j] * bts[a] * __expf(gcs[a] - gb) : 0.f; } }
        }
        LDS_WAIT();
        float x[64];
#pragma unroll
        for (int i = 0; i < 64; ++i) { int ln = lane; asm volatile("" : "+v"(ln)); float s = (i == ln) ? 1.f : 0.f;
#pragma unroll
            for (int j = 0; j < i; ++j) s -= Lm[i * 64 + j] * x[j];
            x[i] = s; asm volatile("" ::: "memory"); }
        LDS_WAIT();
        {
            unsigned short* Xs = (unsigned short*)Lm; const int idx0 = dir ? 4095 - lane : lane, st = dir ? -64 : 64;
#pragma unroll
            for (int a = 0; a < 64; a += 2) { const unsigned w = pk2(x[a], x[a + 1]); Xs[idx0 + a * st] = (unsigned short)(w & 0xffffu); Xs[idx0 + (a + 1) * st] = (unsigned short)(w >> 16); }
            LDS_WAIT();
            u32x4* dst = (u32x4*)(TG + (size_t)item * 4096);
#pragma unroll
            for (int k = 0; k < 8; ++k) dst[k * 64 + lane] = ((const u32x4*)Xs)[k * 64 + lane];
            LDS_WAIT();
        }
        {
            bf16x8 kf[4][4];
#pragma unroll
            for (int mt = 0; mt < 4; ++mt) { const int a = mt * 16 + fr, pp = dir ? 63 - a : a;
#pragma unroll
                for (int kb = 0; kb < 4; ++kb) kf[mt][kb] = *(const bf16x8*)(QKV + (size_t)(t0 + pp) * 3072 + 1024 + h * 128 + kb * 32 + fq * 8); }
            unsigned short* As = (unsigned short*)Lm;
#pragma unroll 1
            for (int mt = 0; mt < 4; ++mt) { bf16x8 qf[4]; const int aq = mt * 16 + fr, pq = dir ? 63 - aq : aq;
#pragma unroll
                for (int kb = 0; kb < 4; ++kb) qf[kb] = *(const bf16x8*)(QKV + (size_t)(t0 + pq) * 3072 + h * 128 + kb * 32 + fq * 8);
#pragma unroll
                for (int nt = 0; nt < 4; ++nt) { f32x4 acc = {0.f, 0.f, 0.f, 0.f};
                    if (nt <= mt) {
#pragma unroll
                        for (int kb = 0; kb < 4; ++kb) acc = MFMA16(qf[kb], kf[nt][kb], acc); }
                    const int b = nt * 16 + fr; const float gb = gcs[b];
#pragma unroll
                    for (int j = 0; j < 4; ++j) { const int a = mt * 16 + fq * 4 + j, n = a * 64 + b;
                        const float v = (a >= b) ? acc[j] * __expf(gcs[a] - gb) : 0.f;
                        As[dir ? 4095 - n : n] = f2bf(v); } } }
            LDS_WAIT();
            u32x4* dst = (u32x4*)(AG + (size_t)item * 4096);
#pragma unroll
            for (int k = 0; k < 8; ++k) dst[k * 64 + lane] = ((const u32x4*)As)[k * 64 + lane];
            LDS_WAIT();
        }
    }
}

#ifndef SCAN_DUPLOAD
#define SCAN_DUPLOAD 0
#endif
constexpr int SCAN_NT = 1;
__device__ void gdn_scan(const Params& p, unsigned char* smem, int chain_half) {
    constexpr int NT = SCAN_NT; static_assert(NT == 1, "block map below assumes two workgroups per chain");
    const int chain = (chain_half >> 4) * 8 + (chain_half & 7), dvh = (chain_half >> 3) & 1;
    const int tid = tid_l(), wid = tid >> 6, lane = tid & 63, fr = lane & 15, fq = lane >> 4;
    unsigned char* ws = p.ws;
    int seq, h, dir, nch, c0;
    if (chain < 32) { seq = chain >> 4; h = (chain >> 1) & 7; dir = chain & 1; nch = 64; c0 = seq * 64; }
    else { const int b = chain - 32; seq = b >> 4; h = (b >> 1) & 7; dir = b & 1; nch = 32; c0 = 128 + seq * 32; }
    unsigned char* kS = smem; unsigned char* qS = smem + 17408; unsigned char* vS = smem + 34816; unsigned char* kTS = smem + 52224;
    unsigned char* TiS = smem + 70656; unsigned char* AS = smem + 79872; float* gS = (float*)(smem + 89088); float* bS = (float*)(smem + 89344);
    const bf16_t* QKV = (const bf16_t*)(ws + O_QKV); const bf16_t* KT = (const bf16_t*)(ws + O_KT); const bf16_t* TG = (const bf16_t*)(ws + O_TINV); const bf16_t* AG = (const bf16_t*)(ws + O_AIN);
    const float* GCP = (const float*)(ws + O_GCP); const float* BT = (const float*)(ws + O_BETA);
    float* of = (float*)(ws + (dir ? O_OBWD : O_OFWD));
    const bool loader = wid >= 4; const int lt = tid - 256;
#define RAW_BAR() do { asm volatile("" ::: "memory"); __builtin_amdgcn_s_barrier(); asm volatile("" ::: "memory"); } while (0)
    u32x4 pq[2][4], pk[2][4], pv[2][4], pt[2][4], pti[2][2], pa[2][2]; float pgb[2] = {0.f, 0.f};
#define SCAN_LOAD(s_, ci_) do { const int cgl = c0 + (dir ? nch - 1 - (ci_) : (ci_)), tl = cgl * 64, iteml = (cgl * 8 + h) * 2 + dir; \
        _Pragma("unroll") for (int rep = 0; rep < 4; ++rep) { const int pid = lt + rep * 256, row = pid >> 4, seg = pid & 15; \
            const bf16_t* src = QKV + (size_t)(tl + row) * 3072 + h * 128 + seg * 8; \
            pq[s_][rep] = *(const u32x4*)(src); pk[s_][rep] = *(const u32x4*)(src + 1024); pv[s_][rep] = *(const u32x4*)(src + 2048); \
            if (SCAN_DUPLOAD) { asm volatile("" : "+v"(pq[s_][rep]), "+v"(pk[s_][rep]), "+v"(pv[s_][rep])); pq[s_][rep] = *(const volatile u32x4*)(src); pk[s_][rep] = *(const volatile u32x4*)(src + 1024); pv[s_][rep] = *(const volatile u32x4*)(src + 2048); } \
            const int rowt = pid >> 3, segt = pid & 7; \
            pt[s_][rep] = *(const u32x4*)(KT + ((size_t)(cgl * 8 + h) * 128 + rowt) * 64 + segt * 8); } \
        _Pragma("unroll") for (int rep = 0; rep < 2; ++rep) { const int pid = lt + rep * 256, row = pid >> 3, seg = pid & 7; \
          pti[s_][rep] = *(const u32x4*)(TG + (size_t)iteml * 4096 + row * 64 + seg * 8); pa[s_][rep] = *(const u32x4*)(AG + (size_t)iteml * 4096 + row * 64 + seg * 8); } \
        { const float* gp_ = (lt < 64) ? (GCP + (size_t)iteml * 64 + lt) : (BT + (size_t)(tl + (lt & 63)) * 16 + dir * 8 + h); pgb[s_] = *gp_; } } while (0)
#define SCAN_STORE(s_) do { \
        _Pragma("unroll") for (int rep = 0; rep < 4; ++rep) { const int pid = lt + rep * 256, row = pid >> 4, seg = pid & 15; \
            *(u32x4*)(qS + row * 272 + seg * 16) = pq[s_][rep]; *(u32x4*)(kS + row * 272 + seg * 16) = pk[s_][rep]; *(u32x4*)(vS + row * 272 + seg * 16) = pv[s_][rep]; \
            const int rowt = pid >> 3, segt = pid & 7; \
            *(u32x4*)(kTS + rowt * 144 + segt * 16) = pt[s_][rep]; } \
        _Pragma("unroll") for (int rep = 0; rep < 2; ++rep) { const int pid = lt + rep * 256, row = pid >> 3, seg = pid & 7; \
            *(u32x4*)(TiS + row * 144 + seg * 16) = pti[s_][rep]; *(u32x4*)(AS + row * 144 + seg * 16) = pa[s_][rep]; } \
        if (lt < 64) gS[lt] = pgb[s_]; else if (lt < 128) bS[lt - 64] = pgb[s_]; } while (0)
    f32x4 S[NT][8];
#pragma unroll
    for (int nt = 0; nt < NT; ++nt)
#pragma unroll
        for (int i = 0; i < 8; ++i) S[nt][i] = (f32x4){0.f, 0.f, 0.f, 0.f};
    const int e0 = dvh * 64 + (wid & 3) * 16 * NT;
    if (loader) {
        SCAN_LOAD(0, 0); SCAN_LOAD(1, 1);
        for (int ci = 0; ci < nch; ci += 2) {
            RAW_BAR();
            SCAN_STORE(0);
            asm volatile("s_waitcnt lgkmcnt(0)" ::: "memory"); RAW_BAR();
            SCAN_LOAD(0, (ci + 2 < nch ? ci + 2 : nch - 1));
            RAW_BAR();
            SCAN_STORE(1);
            asm volatile("s_waitcnt lgkmcnt(0)" ::: "memory"); RAW_BAR();
            SCAN_LOAD(1, (ci + 3 < nch ? ci + 3 : nch - 1));
        }
    } else {
    for (int ci = 0; ci < nch; ++ci) {
        const int cg_ = c0 + (dir ? nch - 1 - ci : ci), t0 = cg_ * 64;
        asm volatile("s_waitcnt lgkmcnt(0)" ::: "memory"); RAW_BAR();
        RAW_BAR();
        {
#define SCHED_FENCE() __builtin_amdgcn_sched_barrier(0)
#define LD272(base, mt_, f) do { _Pragma("unroll") for (int kb = 0; kb < 4; ++kb) { const int off = ((mt_) * 16 + fr) * 272 + (kb * 32 + fq * 4) * 2; \
                (f)[kb] = mk8(*(const u32x2*)((base) + off), *(const u32x2*)((base) + off + 32)); } } while (0)
#define LD144(base, mt_, f) do { _Pragma("unroll") for (int kb = 0; kb < 2; ++kb) { const int off = ((mt_) * 16 + fr) * 144 + (kb * 32 + fq * 4) * 2; \
                (f)[kb] = mk8(*(const u32x2*)((base) + off), *(const u32x2*)((base) + off + 32)); } } while (0)
#define MMA4(ACC, mt_, f) do { _Pragma("unroll") for (int kb = 0; kb < 4; ++kb) _Pragma("unroll") for (int nt = 0; nt < NT; ++nt) ACC[nt][mt_] = MFMA16((f)[kb], Sb[nt][kb], ACC[nt][mt_]); } while (0)
            bf16x8 Sb[NT][4];
#pragma unroll
            for (int nt = 0; nt < NT; ++nt)
#pragma unroll
                for (int kb = 0; kb < 4; ++kb) Sb[nt][kb] = pack8(S[nt][2 * kb], S[nt][2 * kb + 1]);
            f32x4 KS[NT][4], QS[NT][4];
#pragma unroll
            for (int mt = 0; mt < 4; ++mt)
#pragma unroll
                for (int nt = 0; nt < NT; ++nt) { KS[nt][mt] = (f32x4){0.f, 0.f, 0.f, 0.f}; QS[nt][mt] = (f32x4){0.f, 0.f, 0.f, 0.f}; }
            bf16x8 fa[4], fb[4];
            LD272(kS, 0, fa);
            LD272(kS, 1, fb); SCHED_FENCE(); MMA4(KS, 0, fa); SCHED_FENCE();
            LD272(kS, 2, fa); SCHED_FENCE(); MMA4(KS, 1, fb); SCHED_FENCE();
            LD272(kS, 3, fb); SCHED_FENCE(); MMA4(KS, 2, fa); SCHED_FENCE();
            LD272(qS, 0, fa); SCHED_FENCE(); MMA4(KS, 3, fb); SCHED_FENCE();
            LD272(qS, 1, fb); SCHED_FENCE(); MMA4(QS, 0, fa); SCHED_FENCE();
            LD272(qS, 2, fa); SCHED_FENCE(); MMA4(QS, 1, fb); SCHED_FENCE();
            LD272(qS, 3, fb); SCHED_FENCE(); MMA4(QS, 2, fa); SCHED_FENCE();
            f32x4 gv[4], bv[4]; unsigned short vraw[NT][4][4];
#pragma unroll
            for (int mt = 0; mt < 4; ++mt) { gv[mt] = *(const f32x4*)(gS + mt * 16 + fq * 4); bv[mt] = *(const f32x4*)(bS + mt * 16 + fq * 4); }
            SCHED_FENCE(); MMA4(QS, 3, fb); SCHED_FENCE();
#pragma unroll
            for (int mt = 0; mt < 4; ++mt)
#pragma unroll
                for (int j = 0; j < 4; ++j)
#pragma unroll
                    for (int nt = 0; nt < NT; ++nt) vraw[nt][mt][j] = *(const unsigned short*)(vS + (mt * 16 + fq * 4 + j) * 272 + (e0 + nt * 16 + fr) * 2);
            f32x4 eg4[4];
            bf16x8 Rb[NT][2];
            {
                f32x4 R[NT][4];
#pragma unroll
                for (int mt = 0; mt < 4; ++mt)
#pragma unroll
                    for (int j = 0; j < 4; ++j) { eg4[mt][j] = __expf(gv[mt][j]);
#pragma unroll
                        for (int nt = 0; nt < NT; ++nt) R[nt][mt][j] = bv[mt][j] * (bf2f(vraw[nt][mt][j]) - eg4[mt][j] * KS[nt][mt][j]); }
#pragma unroll
                for (int nt = 0; nt < NT; ++nt) { Rb[nt][0] = pack8(R[nt][0], R[nt][1]); Rb[nt][1] = pack8(R[nt][2], R[nt][3]); }
            }
            SCHED_FENCE();
            bf16x8 ti[4][2];
#pragma unroll
            for (int mt = 0; mt < 4; ++mt) LD144(TiS, mt, ti[mt]);
            f32x4 VN[NT][4];
#pragma unroll
            for (int mt = 0; mt < 4; ++mt) {
#pragma unroll
                for (int nt = 0; nt < NT; ++nt) VN[nt][mt] = (f32x4){0.f, 0.f, 0.f, 0.f};
#pragma unroll
                for (int kb = 0; kb < 2; ++kb)
#pragma unroll
                    for (int nt = 0; nt < NT; ++nt) VN[nt][mt] = MFMA16(ti[mt][kb], Rb[nt][kb], VN[nt][mt]); }
            SCHED_FENCE();
            bf16x8 VNb[NT][2];
#pragma unroll
            for (int nt = 0; nt < NT; ++nt) { VNb[nt][0] = pack8(VN[nt][0], VN[nt][1]); VNb[nt][1] = pack8(VN[nt][2], VN[nt][3]); }
            bf16x8 af[4][2];
#pragma unroll
            for (int mt = 0; mt < 4; ++mt) LD144(AS, mt, af[mt]);
            const float glast = gS[dir ? 0 : 63];
            SCHED_FENCE();
#pragma unroll
            for (int mt = 0; mt < 4; ++mt) { f32x4 oa[NT]; _Pragma("unroll") for (int nt = 0; nt < NT; ++nt) oa[nt] = (f32x4){0.f, 0.f, 0.f, 0.f};
#pragma unroll
                for (int kb = 0; kb < 2; ++kb)
#pragma unroll
                    for (int nt = 0; nt < NT; ++nt) oa[nt] = MFMA16(af[mt][kb], VNb[nt][kb], oa[nt]);
#pragma unroll
                for (int j = 0; j < 4; ++j) { const int c = mt * 16 + fq * 4 + j;
#pragma unroll
                    for (int nt = 0; nt < NT; ++nt) of[(size_t)(t0 + c) * 1024 + h * 128 + e0 + nt * 16 + fr] = eg4[mt][j] * QS[nt][mt][j] + oa[nt][j]; } }
            SCHED_FENCE();
            const float eg = __expf(glast);
            bf16x8 VDb[NT][2];
#pragma unroll
            for (int mt = 0; mt < 4; ++mt)
#pragma unroll
                for (int j = 0; j < 4; ++j) { const float sc = __expf(glast - gv[mt][j]); _Pragma("unroll") for (int nt = 0; nt < NT; ++nt) VN[nt][mt][j] *= sc; }
#pragma unroll
            for (int nt = 0; nt < NT; ++nt) { VDb[nt][0] = pack8(VN[nt][0], VN[nt][1]); VDb[nt][1] = pack8(VN[nt][2], VN[nt][3]); }
            bf16x8 kt0[4][2], kt1[4][2];
#pragma unroll
            for (int dt = 0; dt < 4; ++dt) { LD144(kTS, dt, kt0[dt]); LD144(kTS, 4 + dt, kt1[dt]); }
            SCHED_FENCE();
#pragma unroll
            for (int dt = 0; dt < 4; ++dt) {
#pragma unroll
                for (int nt = 0; nt < NT; ++nt) S[nt][dt] = S[nt][dt] * eg;
#pragma unroll
                for (int kb = 0; kb < 2; ++kb)
#pragma unroll
                    for (int nt = 0; nt < NT; ++nt) S[nt][dt] = MFMA16(kt0[dt][kb], VDb[nt][kb], S[nt][dt]); }
            SCHED_FENCE();
#pragma unroll
            for (int dt = 0; dt < 4; ++dt) {
#pragma unroll
                for (int nt = 0; nt < NT; ++nt) S[nt][4 + dt] = S[nt][4 + dt] * eg;
#pragma unroll
                for (int kb = 0; kb < 2; ++kb)
#pragma unroll
                    for (int nt = 0; nt < NT; ++nt) S[nt][4 + dt] = MFMA16(kt1[dt][kb], VDb[nt][kb], S[nt][4 + dt]); }
#undef SCHED_FENCE
#undef LD272
#undef LD144
#undef MMA4
        }
    }
    }
#undef SCAN_LOAD
#undef SCAN_STORE
#undef RAW_BAR
}

__device__ void attn_phase(const Params& p, unsigned char* smem, int L) {
    const int tid = tid_l(), wid = tid >> 6, lane = tid & 63, fr = lane & 15, fq = lane >> 4;
    unsigned char* ws = p.ws;
    float* btab = (float*)(smem + 131072);
    for (int idx = tid; idx < 3 * 4 * 129; idx += 512) { const int g = idx / 516, hq = (idx / 129) & 3, rr = idx % 129 - 64, D = (g == 0) ? 1 : (g == 1 ? 4 : 16);
        const int rel = rr * D, n = rel < 0 ? -rel : rel;
        int bk = (n < 8) ? n : min(15, 5 + (31 - __clz(n)));
        if (rel > 0) bk += 16;
        btab[idx] = p.rel_bias[bk * 12 + g * 4 + hq]; }
    const bf16_t* CQ = (const bf16_t*)(ws + O_CQ); const bf16_t* CK = (const bf16_t*)(ws + O_CK); const bf16_t* VT = (const bf16_t*)(ws + O_VT);
    bf16_t* OG = (bf16_t*)(ws + O_OG); float* LSE = (float*)(ws + O_LSE);
    unsigned char* Ks = smem;
    unsigned* qctr = (unsigned*)(ws + O_QCTR) + L * 64;
    volatile LAS unsigned* slot = (volatile LAS unsigned*)(smem + LDS_BAR_ST) + 2;
    for (;;) {
        __syncthreads();
        if (tid == 0) *slot = __hip_atomic_fetch_add(qctr, 1u, __ATOMIC_RELAXED, __HIP_MEMORY_SCOPE_AGENT);
        __syncthreads();
        const int bi = (int)*slot;
        if (bi >= 768) break;
        const int g = bi >> 8, rem = bi & 255, hq = rem >> 6, bt = rem & 63, dsh = g * 2, D = 1 << dsh, hc = g * 4 + hq, cb = bt * 256;
        __syncthreads();
        {
            u32x4 kv[12];
#pragma unroll
            for (int rep = 0; rep < 12; ++rep) { const int pid = tid + rep * 512, row = pid >> 4, seg = pid & 15;
                int c = cb - 64 + row; c = c < 0 ? 0 : (c > T_ - 1 ? T_ - 1 : c);
                int s0, Ls; seq_of(c, s0, Ls); const int lsh = (Ls == 4096 ? 12 : 11) - dsh, rr = (c - s0) >> lsh, ii = (c - s0) & ((1 << lsh) - 1);
                kv[rep] = *(const u32x4*)(CK + (size_t)(s0 + ii * D + rr) * 1536 + hc * 128 + seg * 8); }
#pragma unroll
            for (int rep = 0; rep < 12; ++rep) { const int pid = tid + rep * 512, row = pid >> 4, seg = pid & 15; *(u32x4*)(Ks + row * 272 + seg * 16) = kv[rep]; }
        }
        const int col0 = cb + wid * 32; int s0, Ls; seq_of(col0, s0, Ls); const int l = Ls >> dsh, r = (col0 - s0) / l, i0 = (col0 - s0) - r * l;
        bf16x8 qf[2][4];
#pragma unroll
        for (int nq = 0; nq < 2; ++nq) { const size_t tq = (size_t)(s0 + (i0 + nq * 16 + fr) * D + r);
#pragma unroll
            for (int kb = 0; kb < 4; ++kb) qf[nq][kb] = *(const bf16x8*)(CQ + tq * 1536 + hc * 128 + kb * 32 + fq * 8); }
        __syncthreads();
        f32x4 st[10][2];
#pragma unroll
        for (int kt = 0; kt < 10; ++kt) { const unsigned char* kp = Ks + (wid * 32 + kt * 16 + fr) * 272 + fq * 16;
            st[kt][0] = (f32x4){0.f, 0.f, 0.f, 0.f}; st[kt][1] = (f32x4){0.f, 0.f, 0.f, 0.f};
#pragma unroll
            for (int kb = 0; kb < 4; ++kb) { const bf16x8 kfr = *(const bf16x8*)(kp + kb * 64);
                st[kt][0] = MFMA16(kfr, qf[0][kb], st[kt][0]); st[kt][1] = MFMA16(kfr, qf[1][kb], st[kt][1]); } }
        const float* bt_ = btab + hc * 129 + 64;
        float mx[2] = {-1e30f, -1e30f};
#pragma unroll
        for (int kt = 0; kt < 10; ++kt)
#pragma unroll
            for (int nq = 0; nq < 2; ++nq)
#pragma unroll
                for (int j = 0; j < 4; ++j) { const int rel = -64 + kt * 16 + fq * 4 + j - nq * 16 - fr, kidx = i0 - 64 + kt * 16 + fq * 4 + j;
                    const bool valid = (rel >= -64) && (rel <= 64) && (kidx >= 0) && (kidx < l);
                    const int rc = rel < -64 ? -64 : (rel > 64 ? 64 : rel);
                    const float sv = valid ? st[kt][nq][j] * 0.08838834764831845f + bt_[rc] : -1e30f;
                    st[kt][nq][j] = sv; mx[nq] = fmaxf(mx[nq], sv); }
        float sm[2];
#pragma unroll
        for (int nq = 0; nq < 2; ++nq) { mx[nq] = fmaxf(mx[nq], __shfl_xor(mx[nq], 16)); mx[nq] = fmaxf(mx[nq], __shfl_xor(mx[nq], 32)); sm[nq] = 0.f; }
#pragma unroll
        for (int kt = 0; kt < 10; ++kt)
#pragma unroll
            for (int nq = 0; nq < 2; ++nq)
#pragma unroll
                for (int j = 0; j < 4; ++j) { const float e = __expf(st[kt][nq][j] - mx[nq]); st[kt][nq][j] = e; sm[nq] += e; }
#pragma unroll
        for (int nq = 0; nq < 2; ++nq) { sm[nq] += __shfl_xor(sm[nq], 16); sm[nq] += __shfl_xor(sm[nq], 32); }
        bf16x8 Pb[5][2];
#pragma unroll
        for (int kb = 0; kb < 5; ++kb) { Pb[kb][0] = pack8(st[2 * kb][0], st[2 * kb + 1][0]); Pb[kb][1] = pack8(st[2 * kb][1], st[2 * kb + 1][1]); }
        __syncthreads();
        {
            u32x4 vv[12]; const bf16_t* vsrc = VT + (size_t)g * 512 * VTLD + (size_t)(hq * 128) * VTLD + 128 + cb - 64;
#pragma unroll
            for (int rep = 0; rep < 12; ++rep) { const int pid = tid + rep * 512, d = pid / 48, seg = pid - d * 48; vv[rep] = *(const u32x4*)(vsrc + (size_t)d * VTLD + seg * 8); }
#pragma unroll
            for (int rep = 0; rep < 12; ++rep) { const int pid = tid + rep * 512, d = pid / 48, seg = pid - d * 48; *(u32x4*)(Ks + d * 784 + seg * 16) = vv[rep]; }
        }
        __syncthreads();
        f32x4 ot[8][2];
#pragma unroll
        for (int dt = 0; dt < 8; ++dt) { ot[dt][0] = (f32x4){0.f, 0.f, 0.f, 0.f}; ot[dt][1] = (f32x4){0.f, 0.f, 0.f, 0.f}; }
#pragma unroll
        for (int kb = 0; kb < 5; ++kb) {
#pragma unroll
            for (int dt = 0; dt < 8; ++dt) { const unsigned char* vp = Ks + (dt * 16 + fr) * 784 + (wid * 32 + kb * 32 + fq * 4) * 2;
                const bf16x8 va = mk8(*(const u32x2*)vp, *(const u32x2*)(vp + 32));
                ot[dt][0] = MFMA16(va, Pb[kb][0], ot[dt][0]); ot[dt][1] = MFMA16(va, Pb[kb][1], ot[dt][1]); } }
#pragma unroll
        for (int nq = 0; nq < 2; ++nq) { const size_t tq = (size_t)(s0 + (i0 + nq * 16 + fr) * D + r); const float inv = 1.0f / sm[nq];
            bf16_t* op = OG + (size_t)g * T_ * 512 + tq * 512 + hq * 128 + fq * 4;
#pragma unroll
            for (int dt = 0; dt < 8; ++dt) { u32x2 o; o.x = pk2(ot[dt][nq][0] * inv, ot[dt][nq][1] * inv); o.y = pk2(ot[dt][nq][2] * inv, ot[dt][nq][3] * inv); *(u32x2*)(op + dt * 16) = o; }
            if (fq == 0) LSE[(size_t)g * T_ * 4 + tq * 4 + hq] = mx[nq] + __logf(sm[nq]); }
    }
}

__device__ void post_phase(const Params& p, int L) {
    const int tid = tid_l(), lane = tid & 63, gw = bid_l() * 8 + (tid >> 6), nw = gridDim.x * 8;
    unsigned char* ws = p.ws;
    const float* OF = (const float*)(ws + O_OFWD); const float* OB = (const float*)(ws + O_OBWD); const bf16_t* Z = (const bf16_t*)(ws + O_SZ);
    bf16_t* YA = (bf16_t*)(ws + O_YA); bf16_t* YC = (bf16_t*)(ws + O_YC); const bf16_t* OG = (const bf16_t*)(ws + O_OG); const float* LSE = (const float*)(ws + O_LSE);
    const f32x4 hn = *(const f32x4*)(p.head_norm + L * 128 + (lane & 31) * 4);
    for (int tp = gw * 2; tp < T_; tp += nw * 2) {
        f32x4 a[2][4], b[2][4]; u32x2 z[2][4]; float ls[2][3]; u32x4 og[2][3];
#pragma unroll
        for (int u = 0; u < 2; ++u) { const size_t t = (size_t)(tp + u);
#pragma unroll
            for (int i = 0; i < 4; ++i) { a[u][i] = *(const f32x4*)(OF + t * 1024 + i * 256 + lane * 4); b[u][i] = *(const f32x4*)(OB + t * 1024 + i * 256 + lane * 4);
                z[u][i] = *(const u32x2*)(Z + t * 1024 + i * 256 + lane * 4); }
#pragma unroll
            for (int g = 0; g < 3; ++g) { ls[u][g] = LSE[(size_t)g * T_ * 4 + t * 4 + (lane >> 4)]; og[u][g] = *(const u32x4*)(OG + (size_t)g * T_ * 512 + t * 512 + lane * 8); } }
#pragma unroll
        for (int u = 0; u < 2; ++u) { const size_t t = (size_t)(tp + u);
            float ss[4];
#pragma unroll
            for (int i = 0; i < 4; ++i) { a[u][i] = a[u][i] + b[u][i]; ss[i] = a[u][i][0] * a[u][i][0] + a[u][i][1] * a[u][i][1] + a[u][i][2] * a[u][i][2] + a[u][i][3] * a[u][i][3]; }
#pragma unroll
            for (int off = 16; off > 0; off >>= 1)
#pragma unroll
                for (int i = 0; i < 4; ++i) ss[i] += __shfl_xor(ss[i], off);
#pragma unroll
            for (int i = 0; i < 4; ++i) { const float rstd = rsqrtf(ss[i] * (1.0f / 128.0f) + 1e-6f);
                u32x2 o; o.x = pk2(a[u][i][0] * rstd * hn[0] * siluf_(bflo(z[u][i].x)), a[u][i][1] * rstd * hn[1] * siluf_(bfhi(z[u][i].x)));
                o.y = pk2(a[u][i][2] * rstd * hn[2] * siluf_(bflo(z[u][i].y)), a[u][i][3] * rstd * hn[3] * siluf_(bfhi(z[u][i].y)));
                *(u32x2*)(YA + t * 1024 + i * 256 + lane * 4) = o; }
            const float l0 = ls[u][0], l1 = ls[u][1], l2 = ls[u][2];
            const float m = fmaxf(l0, fmaxf(l1, l2)); float a0 = __expf(l0 - m), a1 = __expf(l1 - m), a2 = __expf(l2 - m); const float inv = 1.0f / (a0 + a1 + a2); a0 *= inv; a1 *= inv; a2 *= inv;
            const u32x4 g0 = og[u][0], g1 = og[u][1], g2 = og[u][2];
            u32x4 yo;
            yo.x = pk2(a0 * bflo(g0.x) + a1 * bflo(g1.x) + a2 * bflo(g2.x), a0 * bfhi(g0.x) + a1 * bfhi(g1.x) + a2 * bfhi(g2.x));
            yo.y = pk2(a0 * bflo(g0.y) + a1 * bflo(g1.y) + a2 * bflo(g2.y), a0 * bfhi(g0.y) + a1 * bfhi(g1.y) + a2 * bfhi(g2.y));
            yo.z = pk2(a0 * bflo(g0.z) + a1 * bflo(g1.z) + a2 * bflo(g2.z), a0 * bfhi(g0.z) + a1 * bfhi(g1.z) + a2 * bfhi(g2.z));
            yo.w = pk2(a0 * bflo(g0.w) + a1 * bflo(g1.w) + a2 * bflo(g2.w), a0 * bfhi(g0.w) + a1 * bfhi(g1.w) + a2 * bfhi(g2.w));
            *(u32x4*)(YC + t * 512 + lane * 8) = yo; }
    }
}

constexpr int NPHASE = 23;
__device__ __forceinline__ void do_phase(const Params& p, int ph, unsigned char* smem) {
    unsigned char* ws = p.ws;
    if (ph == 22) { norm_rows(p, 2, p.norm_final, nullptr); return; }
    const int L = ph / 11, k = ph - L * 11;
    switch (k) {
    case 0: {
        const float* tile = nullptr;
        conv_tiles(p.w_in + (size_t)L * DM * 17952, DM, 17952, 281, (bf16_t*)(ws + O_WT_IN), 1, p.norm_mix + L * DM);
        if (L == 0) { conv_tiles(p.w_up, DM, DFF, 128, (bf16_t*)(ws + O_WT_UP), 0, p.norm_mlp);
                      conv_tiles(p.w_down, DFF, DM, 32, (bf16_t*)(ws + O_WT_DOWN), 0, tile); }
        conv_tiles(p.w_out + (size_t)L * DM * DM, DM, DM, 32, (bf16_t*)(ws + O_WT_OUT), 0, tile);
        conv_tiles(p.w_br_a + (size_t)L * 1024 * DM, 1024, DM, 32, (bf16_t*)(ws + O_WT_BRA), 0, tile);
        conv_tiles(p.w_br_b + (size_t)L * 1024 * DM, 1024, DM, 32, (bf16_t*)(ws + O_WT_BRB), 0, tile);
        conv_tiles(p.w_br_c + (size_t)L * 512 * DM, 512, DM, 32, (bf16_t*)(ws + O_WT_BRC), 0, tile);
        if (L == 0) norm_rows(p, 0, nullptr, (bf16_t*)p.out);
    } break;
    case 1: { EpiProj E; E.ws = ws; E.ssq = (const u64_t*)(ws + O_SSQ) + (size_t)(2 * L) * T_; run_gemm(smem, (const bf16_t*)p.out, (const bf16_t*)(ws + O_WT_IN), T_, NPROJ, DM, E); } break;
    case 2: prep_phase(p, L, smem); break;
    case 3: gdn_local(p, smem); break;
    case 4: {
        const int bid = bid_l();
#ifndef SCAN_REP
#define SCAN_REP 1
#endif
        constexpr int NSCAN = 96 * (2 / SCAN_NT);
        if (bid < NSCAN) { int nr = SCAN_REP; asm volatile("" : "+s"(nr));
#pragma unroll 1
            for (int rr = 0; rr < nr; ++rr) { gdn_scan(p, smem, bid); __syncthreads(); } }
        attn_phase(p, smem, L);
        if (L == 0) { unsigned* qc = (unsigned*)(ws + O_QCTR);
            conv_queue(p.w_up + (size_t)DM * DFF, DM, DFF, 128, (bf16_t*)(ws + O_WT_UP1), p.norm_mlp + DM, qc + 16, smem);
            conv_queue(p.w_down + (size_t)DFF * DM, DFF, DM, 32, (bf16_t*)(ws + O_WT_DOWN1), nullptr, qc + 32, smem); }
    } break;
    case 5: post_phase(p, L); break;
    case 6: {
        EpiBranch E; E.merged = (bf16_t*)(ws + O_XN); E.gates = (const bf16_t*)(ws + O_GATES);
        for (int b = 0; b < 3; ++b) { E.goff = b * DM; E.mode = b;
            const bf16_t* A = (const bf16_t*)(ws + (b == 0 ? O_YA : (b == 1 ? O_YB : O_YC))); const bf16_t* Bt = (const bf16_t*)(ws + (b == 0 ? O_WT_BRA : (b == 1 ? O_WT_BRB : O_WT_BRC)));
            run_gemm(smem, A, Bt, T_, DM, b == 2 ? 512 : 1024, E); }
    } break;
    case 7: { EpiResid E; E.xp = nullptr; E.xs = nullptr; E.hin = (const bf16_t*)p.out; E.hout = (bf16_t*)(ws + O_HB2); E.ssq = (u64_t*)(ws + O_SSQ) + (size_t)(2 * L + 1) * T_;
              run_gemm(smem, (const bf16_t*)(ws + O_XN), (const bf16_t*)(ws + O_WT_OUT), T_, DM, DM, E); } break;
    case 8: break;
    case 9: { EpiUp E; E.O = (bf16_t*)(ws + O_HID); E.ssq = (const u64_t*)(ws + O_SSQ) + (size_t)(2 * L + 1) * T_; run_gemm(smem, (const bf16_t*)(ws + O_HB2), (const bf16_t*)(ws + (L == 0 ? O_WT_UP : O_WT_UP1)), T_, DFF, DM, E); } break;
    case 10: { EpiResid E; E.xp = nullptr; E.xs = nullptr; E.hin = (const bf16_t*)(ws + O_HB2); E.hout = (L == 0) ? (bf16_t*)p.out : (bf16_t*)(ws + O_XN); E.ssq = (u64_t*)(ws + O_SSQ) + (size_t)(2 * L + 2) * T_;
               run_gemm(smem, (const bf16_t*)(ws + O_HID), (const bf16_t*)(ws + (L == 0 ? O_WT_DOWN : O_WT_DOWN1)), T_, DM, DFF, E); } break;
    }
}

__device__ __forceinline__ Params load_params() {
    Params q{};
#if defined(__HIP_DEVICE_COMPILE__)
    typedef const __attribute__((address_space(4))) unsigned long long* KP;
    KP kp = (KP)__builtin_amdgcn_kernarg_segment_ptr(); asm volatile("" : "+s"(kp));
#define GPF(i) ((const float*)(const __attribute__((address_space(1))) float*)kp[i])
    q.x_prompt = GPF(0); q.x_sample = GPF(1); q.rel_bias = GPF(2); q.norm_mix = GPF(3); q.w_in = GPF(4);
    q.conv_a = GPF(5); q.a_log = GPF(6); q.dt_bias = GPF(7); q.head_norm = GPF(8); q.conv_b = GPF(9);
    q.w_br_a = GPF(10); q.w_br_b = GPF(11); q.w_br_c = GPF(12); q.w_out = GPF(13); q.norm_mlp = GPF(14);
    q.w_up = GPF(15); q.w_down = GPF(16); q.norm_final = GPF(17); q.out = (float*)(__attribute__((address_space(1))) float*)kp[18]; q.ws = (unsigned char*)(__attribute__((address_space(1))) unsigned char*)kp[19];
#undef GPF
#endif
    return q;
}
#ifndef DUP_MASK
#define DUP_MASK 0
#endif
__device__ __forceinline__ void grid_barrier(unsigned char* smem) {
    XcdBarrier b; { const Params q = load_params(); b.bar = (unsigned*)(q.ws + O_BAR); } b.x = xb_xcc_id(); b.st = (volatile LAS unsigned*)(smem + LDS_BAR_ST);
    xcd_barrier(b);
}
template <int PH> __device__ __forceinline__ void phase_sync(unsigned char* smem) {
    if (PH < 22 && PH % 11 == 8) return;
    if (PH < 22 && ((DUP_MASK >> (PH % 11)) & 1)) {
        int nrep = 2; asm volatile("" : "+s"(nrep));
#pragma unroll 1
        for (int rep = 0; rep < nrep; ++rep) { { const Params q = load_params(); do_phase(q, PH, smem); } grid_barrier(smem); }
    } else { { const Params q = load_params(); do_phase(q, PH, smem); } if (PH + 1 < NPHASE) grid_barrier(smem); } }
#if MEGA
__global__ __launch_bounds__(512, 2) void k_mega(Params p) {
    extern __shared__ __attribute__((aligned(16))) unsigned char smem[];
    cg::grid_group grid = cg::this_grid();
    {
        const Params q = load_params(); unsigned* bar = (unsigned*)(q.ws + O_BAR); const int tid = tid_l();
        if (bid_l() == 0) for (int i = tid; i < XCD_BAR_WORDS + 128; i += 512) bar[i] = 0u;
        if (tid < 4) ((volatile LAS unsigned*)(smem + LDS_BAR_ST))[tid] = 0u;
        __threadfence();
        grid.sync();
        (void)xcd_barrier_post(bar, (volatile LAS unsigned*)(smem + LDS_BAR_ST));
    }
#ifdef EXTRA_SYNCS
    { int ne = EXTRA_SYNCS; asm volatile("" : "+s"(ne));
#pragma unroll 1
      for (int i = 0; i < ne; ++i) grid_barrier(smem); }
#endif
    phase_sync<0>(smem); phase_sync<1>(smem); phase_sync<2>(smem); phase_sync<3>(smem); phase_sync<4>(smem); phase_sync<5>(smem);
    phase_sync<6>(smem); phase_sync<7>(smem); phase_sync<8>(smem); phase_sync<9>(smem); phase_sync<10>(smem); phase_sync<11>(smem);
    phase_sync<12>(smem); phase_sync<13>(smem); phase_sync<14>(smem); phase_sync<15>(smem); phase_sync<16>(smem); phase_sync<17>(smem);
    phase_sync<18>(smem); phase_sync<19>(smem); phase_sync<20>(smem); phase_sync<21>(smem); phase_sync<22>(smem);
}
#else
template <int PH> __global__ __launch_bounds__(512, 2) void k_ph(Params p) {
    extern __shared__ __attribute__((aligned(16))) unsigned char smem[];
    const Params q = load_params(); do_phase(q, PH, smem);
}
template <int PH> static void launch_ph(const Params& p, hipStream_t stream) {
    (void)hipFuncSetAttribute((const void*)k_ph<PH>, hipFuncAttributeMaxDynamicSharedMemorySize, (int)LDS_BYTES);
    k_ph<PH><<<256, 512, LDS_BYTES, stream>>>(p);
}
#endif

extern "C" void kernel_launch(void* const* d_in, const int* in_sizes, int n_in, void* d_out, int out_size, void* d_ws, size_t ws_size, hipStream_t stream) {
    Params p{};
    p.x_prompt = (const float*)d_in[0]; p.x_sample = (const float*)d_in[1]; p.rel_bias = (const float*)d_in[2]; p.norm_mix = (const float*)d_in[3]; p.w_in = (const float*)d_in[4];
    p.conv_a = (const float*)d_in[5]; p.a_log = (const float*)d_in[6]; p.dt_bias = (const float*)d_in[7]; p.head_norm = (const float*)d_in[8]; p.conv_b = (const float*)d_in[9];
    p.w_br_a = (const float*)d_in[10]; p.w_br_b = (const float*)d_in[11]; p.w_br_c = (const float*)d_in[12]; p.w_out = (const float*)d_in[13]; p.norm_mlp = (const float*)d_in[14];
    p.w_up = (const float*)d_in[15]; p.w_down = (const float*)d_in[16]; p.norm_final = (const float*)d_in[17]; p.out = (float*)d_out; p.ws = (unsigned char*)d_ws;
    if (ws_size < WS_NEED) { fprintf(stderr, "workspace too small: %zu < %zu\n", ws_size, (size_t)WS_NEED); return; }
#if MEGA
    static int grid_blocks = 0;
    if (!grid_blocks) { int dev = 0, cus = 0, per_cu = 0; (void)hipGetDevice(&dev); (void)hipDeviceGetAttribute(&cus, hipDeviceAttributeMultiprocessorCount, dev);
        (void)hipFuncSetAttribute((const void*)k_mega, hipFuncAttributeMaxDynamicSharedMemorySize, (int)LDS_BYTES);
        (void)hipOccupancyMaxActiveBlocksPerMultiprocessor(&per_cu, k_mega, 512, LDS_BYTES);
        if (per_cu < 1) per_cu = 1;
        grid_blocks = cus * per_cu; if (grid_blocks > 256) grid_blocks = 256; }
    void* args[] = {&p};
    hipError_t e = hipLaunchCooperativeKernel((const void*)k_mega, dim3(grid_blocks), dim3(512), args, LDS_BYTES, stream);
    if (e != hipSuccess) fprintf(stderr, "cooperative launch failed: %s (grid %d)\n", hipGetErrorString(e), grid_blocks);
#else
    launch_ph<0>(p, stream); launch_ph<1>(p, stream); launch_ph<2>(p, stream); launch_ph<3>(p, stream); launch_ph<4>(p, stream); launch_ph<5>(p, stream);
    launch_ph<6>(p, stream); launch_ph<7>(p, stream); launch_ph<8>(p, stream); launch_ph<9>(p, stream); launch_ph<10>(p, stream); launch_ph<11>(p, stream);
    launch_ph<12>(p, stream); launch_ph<13>(p, stream); launch_ph<14>(p, stream); launch_ph<15>(p, stream); launch_ph<16>(p, stream); launch_ph<17>(p, stream);
    launch_ph<18>(p, stream); launch_ph<19>(p, stream); launch_ph<20>(p, stream); launch_ph<21>(p, stream); launch_ph<22>(p, stream);
#endif
}
```
